# Optimizing an MI355X kernel written in HIP

```python
import math
import jax
import jax.numpy as jnp
from jax import lax
import numpy as np

D_MODEL = 1024
BATCH = 4
SEQ = 4096
DEPTH = 4

N_MIXERS = 3
Q_BLOCK = 128
NORM_EPS = 1e-6
FFN_HIDDEN = -(-(8 * D_MODEL) // (3 * 256)) * 256

DN_HEAD_DIM = 128
DN_HEADS = D_MODEL // DN_HEAD_DIM
DN_WIDTH = DN_HEADS * DN_HEAD_DIM
DN_CONV = 4
DN_CHUNK = 64

SB_HEAD_DIM = 128
SB_HEADS = D_MODEL // SB_HEAD_DIM

MLA_HEADS = D_MODEL // 128
MLA_NOPE = 128
MLA_ROPE = 64
MLA_QK = MLA_NOPE + MLA_ROPE
MLA_V = 128
MLA_Q_RANK = 256
MLA_KV_RANK = 128
ROPE_THETA = 10000.0

kernel_name = 'hybrid_deltanet_stickbreak_mla_trunk'


def _rmsnorm(x, g):
    xf = x.astype(jnp.float32)
    y = xf * lax.rsqrt(jnp.mean(xf * xf, axis=-1, keepdims=True) + NORM_EPS)
    return (y * g.astype(jnp.float32)).astype(x.dtype)


def _l2norm(x):
    return x * lax.rsqrt(jnp.sum(x * x, axis=-1, keepdims=True) + NORM_EPS)


def _heads_first(x):
    return x.transpose(0, 2, 1, 3)


def _swiglu(h, w_gate_up, w_down):
    gate, up = jnp.split(h @ w_gate_up, 2, axis=-1)
    return (jax.nn.silu(gate) * up) @ w_down


def _causal_dwconv(u, w):
    k_width, t = w.shape[0], u.shape[1]
    up = jnp.pad(u, ((0, 0), (k_width - 1, 0), (0, 0)))
    y = up[:, 0:t] * w[0]
    for j in range(1, k_width):
        y = y + up[:, j:j + t] * w[j]
    return y


def _to_chunks(x):
    b, t, h = x.shape[:3]
    return jnp.moveaxis(x.reshape(b, t // DN_CHUNK, DN_CHUNK, h, *x.shape[3:]), 3, 1)


def _chunk_gated_delta_rule(q, k, v, g, beta):
    b, t, h, dk = q.shape
    dv = v.shape[-1]
    qc, kc, vc = _to_chunks(q), _to_chunks(k), _to_chunks(v)
    gc = jnp.cumsum(_to_chunks(g), axis=-1)
    bc = _to_chunks(beta)[..., None]
    idx = jnp.arange(DN_CHUNK)
    causal = idx[:, None] >= idx[None, :]
    strict = idx[:, None] > idx[None, :]
    diff = gc[..., :, None] - gc[..., None, :]
    decay = jnp.where(causal, jnp.exp(jnp.where(causal, diff, 0.0)), 0.0)
    k_beta = kc * bc
    lower = jnp.where(strict, jnp.einsum('bhncd,bhnsd->bhncs', k_beta, kc) * decay, 0.0)
    tmat = lower + jnp.eye(DN_CHUNK, dtype=lower.dtype)
    u = lax.linalg.triangular_solve(tmat, vc * bc, left_side=True, lower=True, unit_diagonal=True)
    w = lax.linalg.triangular_solve(tmat, k_beta * jnp.exp(gc)[..., None], left_side=True, lower=True, unit_diagonal=True)
    attn = jnp.einsum('bhncd,bhnsd->bhncs', qc, kc) * decay
    q_dec = qc * jnp.exp(gc)[..., None]
    k_dec = kc * jnp.exp(gc[..., -1:] - gc)[..., None]
    chunk_decay = jnp.exp(gc[..., -1])[..., None, None]

    def step(state, inp):
        u_i, w_i, q_i, k_i, a_i, d_i = inp
        v_new = u_i - jnp.einsum('bhcd,bhde->bhce', w_i, state)
        o_i = jnp.einsum('bhcd,bhde->bhce', q_i, state) + jnp.einsum('bhcs,bhse->bhce', a_i, v_new)
        state = state * d_i + jnp.einsum('bhcd,bhce->bhde', k_i, v_new)
        return state, o_i

    xs = tuple(jnp.moveaxis(a, 2, 0) for a in (u, w, q_dec, k_dec, attn, chunk_decay))
    state0 = jnp.zeros((b, h, dk, dv), q.dtype)
    _, o = lax.scan(step, state0, xs)
    return jnp.moveaxis(o, 0, 2).reshape(b, h, t, dv).transpose(0, 2, 1, 3)


def _gated_deltanet_mixer(h, w_in, conv_w, a_log, dt_bias, out_norm, w_out):
    b, t, _ = h.shape
    proj = h @ w_in
    qkv = jax.nn.silu(_causal_dwconv(proj[..., :3 * DN_WIDTH], conv_w))
    z = proj[..., 3 * DN_WIDTH:4 * DN_WIDTH].reshape(b, t, DN_HEADS, DN_HEAD_DIM).astype(jnp.float32)
    a = proj[..., 4 * DN_WIDTH:4 * DN_WIDTH + DN_HEADS].astype(jnp.float32)
    bl = proj[..., 4 * DN_WIDTH + DN_HEADS:].astype(jnp.float32)
    q, k, v = (y.reshape(b, t, DN_HEADS, DN_HEAD_DIM).astype(jnp.float32) for y in jnp.split(qkv, 3, axis=-1))
    q = _l2norm(q) * (DN_HEAD_DIM ** -0.5)
    k = _l2norm(k)
    g = -jnp.exp(a_log.astype(jnp.float32)) * jax.nn.softplus(a + dt_bias.astype(jnp.float32))
    beta = jax.nn.sigmoid(bl)
    o = _chunk_gated_delta_rule(q, k, v, g, beta)
    o = _rmsnorm(o, out_norm) * jax.nn.silu(z)
    return o.reshape(b, t, DN_WIDTH).astype(h.dtype) @ w_out


def _stick_breaking_weights(z, tpos, spos):
    past = spos < tpos
    log_stay = jnp.where(past, jax.nn.log_sigmoid(-z), 0.0)
    log_after = lax.cumsum(log_stay, axis=z.ndim - 1, reverse=True) - log_stay
    return jnp.where(past, jnp.exp(jax.nn.log_sigmoid(z) + log_after), 0.0)


def _softmax_weights(z, tpos, spos):
    return jax.nn.softmax(jnp.where(spos <= tpos, z, -jnp.inf), axis=-1)


def _causal_block_sweep(q, k, v, weight_fn):
    t = q.shape[2]
    local = jnp.arange(Q_BLOCK)
    outs = []
    for blk in range(t // Q_BLOCK):
        start, end = blk * Q_BLOCK, (blk + 1) * Q_BLOCK
        z = jnp.einsum('bhqd,bhkd->bhqk', q[:, :, start:end], k[:, :, :end])
        tpos = (start + local)[:, None]
        spos = jnp.arange(end)[None, :]
        wts = weight_fn(z, tpos, spos)
        outs.append(jnp.einsum('bhqk,bhkd->bhqd', wts, v[:, :, :end]))
    return jnp.concatenate(outs, axis=2)


def _stick_breaking_mixer(h, w_qkv, q_norm, k_norm, w_out):
    b, t, _ = h.shape
    q, k, v = (y.reshape(b, t, SB_HEADS, SB_HEAD_DIM) for y in jnp.split(h @ w_qkv, 3, axis=-1))
    q = _rmsnorm(q, q_norm).astype(jnp.float32) * (SB_HEAD_DIM ** -0.5)
    k = _rmsnorm(k, k_norm).astype(jnp.float32)
    o = _causal_block_sweep(_heads_first(q), _heads_first(k), _heads_first(v.astype(jnp.float32)), _stick_breaking_weights)
    return _heads_first(o).reshape(b, t, SB_HEADS * SB_HEAD_DIM).astype(h.dtype) @ w_out


def _rope_tables(t):
    inv_freq = ROPE_THETA ** (-jnp.arange(0, MLA_ROPE, 2, dtype=jnp.float32) / MLA_ROPE)
    ang = jnp.arange(t, dtype=jnp.float32)[:, None] * inv_freq[None, :]
    return jnp.cos(ang), jnp.sin(ang)


def _apply_rope(x, cos, sin):
    x1, x2 = jnp.split(x.astype(jnp.float32), 2, axis=-1)
    c, s = cos[None, :, None, :], sin[None, :, None, :]
    return jnp.concatenate([x1 * c - x2 * s, x2 * c + x1 * s], axis=-1)


def _mla_mixer(h, w_down, q_a_norm, kv_a_norm, w_uq, w_ukv, q_nope_norm, q_rope_norm, k_nope_norm, k_rope_norm, w_out):
    b, t, _ = h.shape
    c_q, c_kv, k_rope = jnp.split(h @ w_down, [MLA_Q_RANK, MLA_Q_RANK + MLA_KV_RANK], axis=-1)
    q = (_rmsnorm(c_q, q_a_norm) @ w_uq).reshape(b, t, MLA_HEADS, MLA_QK)
    kv = (_rmsnorm(c_kv, kv_a_norm) @ w_ukv).reshape(b, t, MLA_HEADS, MLA_NOPE + MLA_V)
    v = kv[..., MLA_NOPE:]
    cos, sin = _rope_tables(t)
    q_nope = _rmsnorm(q[..., :MLA_NOPE], q_nope_norm).astype(jnp.float32)
    q_rot = _apply_rope(_rmsnorm(q[..., MLA_NOPE:], q_rope_norm), cos, sin)
    q = jnp.concatenate([q_nope, q_rot], axis=-1) * (MLA_QK ** -0.5)
    k_nope = _rmsnorm(kv[..., :MLA_NOPE], k_nope_norm).astype(jnp.float32)
    k_rot = _apply_rope(_rmsnorm(k_rope, k_rope_norm)[:, :, None, :], cos, sin)
    k = jnp.concatenate([k_nope, jnp.broadcast_to(k_rot, (b, t, MLA_HEADS, MLA_ROPE))], axis=-1)
    o = _causal_block_sweep(_heads_first(q), _heads_first(k), _heads_first(v.astype(jnp.float32)), _softmax_weights)
    return _heads_first(o).reshape(b, t, MLA_HEADS * MLA_V).astype(h.dtype) @ w_out


def _dense(key, fan_in, fan_out):
    return jax.random.normal(key, (fan_in, fan_out), jnp.float32) * (fan_in ** -0.5)


def _gain(key, n):
    return 1.0 + 0.02 * jax.random.normal(key, (n,), jnp.float32)


def _deltanet_params(key, p):
    ks = jax.random.split(key, 6)
    dt = jnp.exp(jax.random.uniform(ks[3], (DN_HEADS,), jnp.float32, math.log(1e-3), math.log(1e-1)))
    return {
        p + 'dn_w_in': _dense(ks[0], D_MODEL, 4 * DN_WIDTH + 2 * DN_HEADS),
        p + 'dn_conv_w': jax.random.normal(ks[1], (DN_CONV, 3 * DN_WIDTH), jnp.float32) * (DN_CONV ** -0.5),
        p + 'dn_a_log': jnp.log(jax.random.uniform(ks[2], (DN_HEADS,), jnp.float32, 1.0, 16.0)),
        p + 'dn_dt_bias': dt + jnp.log(-jnp.expm1(-dt)),
        p + 'dn_out_norm': _gain(ks[4], DN_HEAD_DIM),
        p + 'dn_w_out': _dense(ks[5], DN_WIDTH, D_MODEL),
    }


def _stick_breaking_params(key, p):
    ks = jax.random.split(key, 4)
    return {
        p + 'sb_w_qkv': _dense(ks[0], D_MODEL, 3 * SB_HEADS * SB_HEAD_DIM),
        p + 'sb_q_norm': _gain(ks[1], SB_HEAD_DIM),
        p + 'sb_k_norm': _gain(ks[2], SB_HEAD_DIM),
        p + 'sb_w_out': _dense(ks[3], SB_HEADS * SB_HEAD_DIM, D_MODEL),
    }


def _mla_params(key, p):
    ks = jax.random.split(key, 10)
    return {
        p + 'mla_w_down': _dense(ks[0], D_MODEL, MLA_Q_RANK + MLA_KV_RANK + MLA_ROPE),
        p + 'mla_q_a_norm': _gain(ks[1], MLA_Q_RANK),
        p + 'mla_kv_a_norm': _gain(ks[2], MLA_KV_RANK),
        p + 'mla_w_uq': _dense(ks[3], MLA_Q_RANK, MLA_HEADS * MLA_QK),
        p + 'mla_w_ukv': _dense(ks[4], MLA_KV_RANK, MLA_HEADS * (MLA_NOPE + MLA_V)),
        p + 'mla_q_nope_norm': _gain(ks[5], MLA_NOPE),
        p + 'mla_q_rope_norm': _gain(ks[6], MLA_ROPE),
        p + 'mla_k_nope_norm': _gain(ks[7], MLA_NOPE),
        p + 'mla_k_rope_norm': _gain(ks[8], MLA_ROPE),
        p + 'mla_w_out': _dense(ks[9], MLA_HEADS * MLA_V, D_MODEL),
    }


def setup_inputs(seed: int = 0) -> dict:
    key = jax.random.key(seed)
    k_x, k_layers = jax.random.split(key)
    inputs = {'x': jax.random.normal(k_x, (BATCH, SEQ, D_MODEL), jnp.float32)}
    builders = (_deltanet_params, _stick_breaking_params, _mla_params)
    layer_keys = jax.random.split(k_layers, DEPTH)
    for i in range(DEPTH):
        ks = jax.random.split(layer_keys[i], 5)
        p = 'l' + str(i) + '_'
        inputs[p + 'mix_norm'] = _gain(ks[0], D_MODEL)
        inputs.update(builders[i % N_MIXERS](ks[1], p))
        inputs[p + 'ffn_norm'] = _gain(ks[2], D_MODEL)
        inputs[p + 'ffn_w_gate_up'] = _dense(ks[3], D_MODEL, 2 * FFN_HIDDEN)
        inputs[p + 'ffn_w_down'] = _dense(ks[4], FFN_HIDDEN, D_MODEL)
    return inputs


def reference(x,
              l0_mix_norm, l0_dn_w_in, l0_dn_conv_w, l0_dn_a_log, l0_dn_dt_bias, l0_dn_out_norm, l0_dn_w_out,
              l0_ffn_norm, l0_ffn_w_gate_up, l0_ffn_w_down,
              l1_mix_norm, l1_sb_w_qkv, l1_sb_q_norm, l1_sb_k_norm, l1_sb_w_out,
              l1_ffn_norm, l1_ffn_w_gate_up, l1_ffn_w_down,
              l2_mix_norm, l2_mla_w_down, l2_mla_q_a_norm, l2_mla_kv_a_norm, l2_mla_w_uq, l2_mla_w_ukv,
              l2_mla_q_nope_norm, l2_mla_q_rope_norm, l2_mla_k_nope_norm, l2_mla_k_rope_norm, l2_mla_w_out,
              l2_ffn_norm, l2_ffn_w_gate_up, l2_ffn_w_down,
              l3_mix_norm, l3_dn_w_in, l3_dn_conv_w, l3_dn_a_log, l3_dn_dt_bias, l3_dn_out_norm, l3_dn_w_out,
              l3_ffn_norm, l3_ffn_w_gate_up, l3_ffn_w_down):
    mixers = (_gated_deltanet_mixer, _stick_breaking_mixer, _mla_mixer)
    layers = (
        (l0_mix_norm, (l0_dn_w_in, l0_dn_conv_w, l0_dn_a_log, l0_dn_dt_bias, l0_dn_out_norm, l0_dn_w_out),
         l0_ffn_norm, l0_ffn_w_gate_up, l0_ffn_w_down),
        (l1_mix_norm, (l1_sb_w_qkv, l1_sb_q_norm, l1_sb_k_norm, l1_sb_w_out),
         l1_ffn_norm, l1_ffn_w_gate_up, l1_ffn_w_down),
        (l2_mix_norm, (l2_mla_w_down, l2_mla_q_a_norm, l2_mla_kv_a_norm, l2_mla_w_uq, l2_mla_w_ukv,
                       l2_mla_q_nope_norm, l2_mla_q_rope_norm, l2_mla_k_nope_norm, l2_mla_k_rope_norm, l2_mla_w_out),
         l2_ffn_norm, l2_ffn_w_gate_up, l2_ffn_w_down),
        (l3_mix_norm, (l3_dn_w_in, l3_dn_conv_w, l3_dn_a_log, l3_dn_dt_bias, l3_dn_out_norm, l3_dn_w_out),
         l3_ffn_norm, l3_ffn_w_gate_up, l3_ffn_w_down),
    )
    for i in range(DEPTH):
        mix_norm, mix_params, ffn_norm, w_gate_up, w_down = layers[i]
        x = x + mixers[i % N_MIXERS](_rmsnorm(x, mix_norm), *mix_params)
        x = x + _swiglu(_rmsnorm(x, ffn_norm), w_gate_up, w_down)
    return x
```

```cpp
#include <hip/hip_runtime.h>
#include <hip/hip_cooperative_groups.h>
#include <cstdio>
#include <cstdint>
namespace cg = cooperative_groups;

#ifndef MK_PER_PHASE
#define MK_PER_PHASE 0
#endif
#ifndef MK_XCD_BAR
#define MK_XCD_BAR 1
#endif

#ifndef EN_MASK
#define EN_MASK 0xFFFFFFFFu
#endif
#define EN(b) ((EN_MASK >> (b)) & 1u)
#define LAS __attribute__((address_space(3)))
typedef unsigned short bf16_t;
typedef short bf16x8 __attribute__((ext_vector_type(8)));
typedef short bf16x4 __attribute__((ext_vector_type(4)));
typedef float f32x4 __attribute__((ext_vector_type(4)));
typedef float f32x2 __attribute__((ext_vector_type(2)));
typedef unsigned u32x4 __attribute__((ext_vector_type(4)));
typedef unsigned u32x2 __attribute__((ext_vector_type(2)));

constexpr int BATCH = 4, SEQ = 4096, D = 1024, M = BATCH * SEQ, FH = 2816, NH = 8;
constexpr float EPS = 1e-6f;
constexpr int NWAVES = 8, NTHR = 512;

constexpr size_t MiB = 1u << 20;
constexpr size_t WS_BAR = 0;
constexpr size_t WS_SS = 1 * MiB;
constexpr size_t WS_SS2 = 2 * MiB;
constexpr size_t WS_AB = 3 * MiB;
constexpr size_t WS_RS = 4 * MiB;
constexpr size_t WS_GC = 5 * MiB;
constexpr size_t WS_HALO = 6 * MiB;
constexpr size_t WS_WMIX = 8 * MiB;
constexpr size_t WS_WMIX_OUT = WS_WMIX + 9 * MiB;
constexpr size_t WS_WFFN = 20 * MiB;
constexpr size_t WS_WFFN_DN = WS_WFFN + 11 * MiB;
constexpr size_t WS_R1 = 40 * MiB;
constexpr size_t WS_R2 = 72 * MiB;
constexpr size_t WS_R3 = 168 * MiB;
constexpr size_t WS_R4 = 200 * MiB;
constexpr size_t WS_R5 = 232 * MiB;
constexpr size_t WS_END = 248 * MiB;

constexpr int LDS_BYTES = 147456;
constexpr int LDS_MISC = 131072;

__device__ __forceinline__ unsigned f2bf(float f) { unsigned u = __builtin_bit_cast(unsigned, f); return (u + 0x7fffu + ((u >> 16) & 1u)) >> 16; }
__device__ __forceinline__ unsigned pk2(float lo, float hi) { unsigned r; asm volatile("v_cvt_pk_bf16_f32 %0, %1, %2" : "=v"(r) : "v"(lo), "v"(hi)); return r; }
__device__ __forceinline__ float bf2f(unsigned b) { return __builtin_bit_cast(float, b << 16); }
__device__ __forceinline__ float bflo(unsigned w) { return __builtin_bit_cast(float, w << 16); }
__device__ __forceinline__ float bfhi(unsigned w) { return __builtin_bit_cast(float, w & 0xffff0000u); }
__device__ __forceinline__ float wave_sum(float v) {
#pragma unroll
    for (int o = 1; o < 64; o <<= 1) v += __shfl_xor(v, o);
    return v;
}
__device__ __forceinline__ float fexp(float x) { return __builtin_amdgcn_exp2f(x * 1.4426950408889634f); }
__device__ __forceinline__ float flog(float x) { return __builtin_amdgcn_logf(x) * 0.6931471805599453f; }
__device__ __forceinline__ float softplus_f(float z) { return fmaxf(z, 0.f) + flog(1.f + fexp(-fabsf(z))); }
__device__ __forceinline__ float silu_f(float y) { return y / (1.f + fexp(-y)); }
__device__ __forceinline__ float rowscale(const float* ss, int row, int lo, int n, float inv_dim) {
    float s = 0.f;
    for (int i = 0; i < n; i += 4) { const f32x4 v = *(const f32x4*)(ss + (size_t)row * 16 + lo + i); s += (v[0] + v[1]) + (v[2] + v[3]); }
    return 1.0f / sqrtf(s * inv_dim + EPS);
}

namespace pg8 {
#define PG8_LAS __attribute__((address_space(3)))
constexpr int BM = 256, BK = 64, HALF = 128, HTB = HALF * BK * 2, STAGE_BYTES = 8 * HTB, NXCD = 8, WGM = 8;
__host__ __device__ __forceinline__ int lds_byte(int r, int c) { const int st = (r >> 4) * 2 + (c >> 5), rr = r & 15, cc = c & 31, ob = rr * 64 + cc * 2; return st * 1024 + (ob ^ (((ob >> 9) & 1) << 5)); }
__host__ __device__ __forceinline__ void stage_rc(int b, int& R, int& C) { const int st = b / 1024, sb = b % 1024, swz = sb ^ (((sb >> 9) & 1) << 5); R = (st >> 1) * 16 + swz / 64; C = (st & 1) * 32 + (swz % 64) / 2; }
__host__ __device__ __forceinline__ int perm32(int rho) { const int n = rho >> 4, i = rho & 15; return 8 * (i >> 2) + 4 * n + (i & 3); }
struct Unit { int pm, pn; };
struct Gemm { const bf16_t* A; const bf16_t* Bt; int M, N, K, lda; };
struct StaticOrder {
    int nM, nN, nwg, G, c;
    __host__ __device__ void init(int M_, int N_, int G_, int c_) { nM = M_ / BM; nN = N_ / BM; nwg = nM * nN; G = G_; c = c_; }
    __host__ __device__ bool next(int i, Unit& u) const {
        const long L = (long)i * G + c; if (L >= nwg) return false;
        int wgid = (int)L; { const int q = nwg / NXCD, r = nwg % NXCD, xcd = wgid % NXCD, off = wgid / NXCD; wgid = (xcd < r ? xcd * (q + 1) : r * (q + 1) + (xcd - r) * q) + off; }
        const int nig = WGM * nN, gid = wgid / nig, fm = gid * WGM, gsz = (nM - fm) < WGM ? (nM - fm) : WGM;
        u.pm = fm + ((wgid % nig) % gsz); u.pn = (wgid % nig) / gsz; return true;
    }
};
template <class Epi, bool ALIGN_EPI = true>
__device__ __forceinline__ void gemm_phase(PG8_LAS unsigned char* lds, const Gemm g, const StaticOrder& S, const Epi& E) {
    int tid_ = threadIdx.x; asm volatile("" : "+v"(tid_));
    const int tid = tid_, wid = __builtin_amdgcn_readfirstlane(tid >> 6), lane = tid & 63, wr = wid >> 2, wc = wid & 3, fr = lane & 15, fq = lane >> 4;
    const int K = g.K, nt = K / BK, lda = g.lda;
    unsigned voffA[2], voffB[2];
#pragma unroll
    for (int i = 0; i < 2; ++i) { int R, C; stage_rc(tid * 16 + i * 8192, R, C); const int Rb = Epi::PERM ? ((R & ~31) + perm32(R & 31)) : R;
        voffA[i] = (unsigned)(R * lda + C) * 2u; voffB[i] = (unsigned)(Rb * K + C) * 2u; }
    const size_t kstep = (size_t)(BK * 2);
    const size_t hstepA = (size_t)HALF * lda * 2, hstepB = (size_t)HALF * K * 2;
    const size_t tstepA = 2 * hstepA, tstepB = 2 * hstepB;
    const unsigned ldsw = (unsigned)wid * 1024u;
    const int aoff = lds_byte(wr * 64 + fr, fq * 8), boff = lds_byte(wc * 32 + fr, fq * 8);
#define PG8_SA(b, h) (((b) * 2 + (h)) * HTB)
#define PG8_SB(b, h) ((4 + (b) * 2 + (h)) * HTB)
#define PG8_STAGE(bufoff, gbase, voff) do { _Pragma("unroll") for (int _i = 0; _i < 2; ++_i) \
        __builtin_amdgcn_global_load_lds((const unsigned*)((const char*)(gbase) + (voff)[_i]), (PG8_LAS unsigned*)(lds + (bufoff) + ldsw + _i * 8192), 16, 0, 0); } while (0)
#define PG8_LDA(dst, b, h) do { _Pragma("unroll") for (int m = 0; m < 4; ++m) _Pragma("unroll") for (int k = 0; k < 2; ++k) dst[m][k] = *(const PG8_LAS bf16x8*)(lds + PG8_SA(b, h) + aoff + m * 2048 + k * 1024); } while (0)
#define PG8_LDB(dst, b, h) do { _Pragma("unroll") for (int n = 0; n < 2; ++n) _Pragma("unroll") for (int k = 0; k < 2; ++k) dst[n][k] = *(const PG8_LAS bf16x8*)(lds + PG8_SB(b, h) + boff + n * 2048 + k * 1024); } while (0)
#define PG8_MMA(ai, bj, At, Bt) do { __builtin_amdgcn_s_setprio(1); _Pragma("unroll") for (int m = 0; m < 4; ++m) _Pragma("unroll") for (int n = 0; n < 2; ++n) _Pragma("unroll") for (int k = 0; k < 2; ++k) \
        acc[ai][bj][m][n] = __builtin_amdgcn_mfma_f32_16x16x32_bf16(Bt[n][k], At[m][k], acc[ai][bj][m][n], 0, 0, 0); __builtin_amdgcn_s_setprio(0); } while (0)
#define PG8_WAIT_V(n) asm volatile("s_waitcnt vmcnt(" #n ")" ::: "memory")
#define PG8_WAIT_L(n) asm volatile("s_waitcnt lgkmcnt(" #n ")" ::: "memory")
#define PG8_BAR __builtin_amdgcn_s_barrier()
#define PG8_SCHED __builtin_amdgcn_sched_barrier(0)
    Unit cur, nxt; int ui = 0;
    if (!S.next(0, cur)) return;
    f32x4 acc[2][2][4][2];
#pragma unroll
    for (int a = 0; a < 2; ++a)
#pragma unroll
        for (int b = 0; b < 2; ++b)
#pragma unroll
            for (int m = 0; m < 4; ++m)
#pragma unroll
                for (int n = 0; n < 2; ++n) acc[a][b][m][n] = (f32x4){0.f, 0.f, 0.f, 0.f};
    bf16x8 At[4][2], B0[2][2], B1[2][2];
    const char* cA = (const char*)g.A + (size_t)cur.pm * tstepA; const char* cB = (const char*)g.Bt + (size_t)cur.pn * tstepB;
    PG8_STAGE(PG8_SB(0, 0), cB, voffB); PG8_STAGE(PG8_SB(0, 1), cB + hstepB, voffB); PG8_STAGE(PG8_SA(0, 0), cA, voffA); PG8_STAGE(PG8_SA(0, 1), cA + hstepA, voffA);
    if (wr == 1) PG8_BAR;
    PG8_WAIT_V(2); PG8_BAR;
    PG8_STAGE(PG8_SB(1, 0), cB + kstep, voffB); PG8_STAGE(PG8_SA(1, 0), cA + kstep, voffA); PG8_STAGE(PG8_SB(1, 1), cB + hstepB + kstep, voffB);
    PG8_WAIT_V(6); PG8_BAR;
    for (;;) {
        const bool has_next = S.next(ui + 1, nxt);
        const char* nA = has_next ? (const char*)g.A + (size_t)nxt.pm * tstepA : cA; const char* nB = has_next ? (const char*)g.Bt + (size_t)nxt.pn * tstepB : cB;
        for (int t = 0; t < nt; t += 2) {
            const bool last = (t == nt - 2);
            const char* a1 = cA + (size_t)(t + 1) * kstep;
            const char* a2 = last ? nA : cA + (size_t)(t + 2) * kstep; const char* b2 = last ? nB : cB + (size_t)(t + 2) * kstep;
            const char* a3 = a2 + kstep; const char* b3 = b2 + kstep;
            PG8_LDB(B0, 0, 0); PG8_LDB(B1, 0, 1); PG8_SCHED; PG8_LDA(At, 0, 0); PG8_STAGE(PG8_SA(1, 1), a1 + hstepA, voffA);
            PG8_WAIT_V(8); PG8_WAIT_L(0); PG8_BAR; PG8_MMA(0, 0, At, B0); PG8_MMA(0, 1, At, B1); PG8_BAR; PG8_SCHED;
            PG8_LDA(At, 0, 1); PG8_STAGE(PG8_SB(0, 0), b2, voffB); PG8_STAGE(PG8_SB(0, 1), b2 + hstepB, voffB); PG8_STAGE(PG8_SA(0, 0), a2, voffA);
            PG8_WAIT_V(8); PG8_WAIT_L(0); PG8_BAR; PG8_MMA(1, 0, At, B0); PG8_MMA(1, 1, At, B1); PG8_BAR; PG8_SCHED;
            PG8_LDB(B0, 1, 0); PG8_LDB(B1, 1, 1); PG8_SCHED; PG8_LDA(At, 1, 0); PG8_STAGE(PG8_SA(0, 1), a2 + hstepA, voffA);
            PG8_WAIT_V(8); PG8_WAIT_L(0); PG8_BAR; PG8_MMA(0, 0, At, B0); PG8_MMA(0, 1, At, B1); PG8_BAR; PG8_SCHED;
            PG8_LDA(At, 1, 1); PG8_STAGE(PG8_SB(1, 0), b3, voffB); PG8_STAGE(PG8_SB(1, 1), b3 + hstepB, voffB); PG8_STAGE(PG8_SA(1, 0), a3, voffA);
            PG8_WAIT_V(8); PG8_WAIT_L(0); PG8_BAR; PG8_MMA(1, 0, At, B0); PG8_MMA(1, 1, At, B1); PG8_BAR; PG8_SCHED;
        }
        if constexpr (ALIGN_EPI) { if (wr == 0) PG8_BAR; }
        E(acc, cur, wr, wc, fr, fq);
        if (!has_next) break;
#pragma unroll
        for (int a = 0; a < 2; ++a)
#pragma unroll
            for (int b = 0; b < 2; ++b)
#pragma unroll
                for (int m = 0; m < 4; ++m)
#pragma unroll
                    for (int n = 0; n < 2; ++n) acc[a][b][m][n] = (f32x4){0.f, 0.f, 0.f, 0.f};
        cur = nxt; cA = nA; cB = nB; ++ui;
        if constexpr (ALIGN_EPI) { if (wr == 1) PG8_BAR; }
    }
    PG8_WAIT_V(0);
    if constexpr (!ALIGN_EPI) { if (wr == 0) PG8_BAR; }
    PG8_BAR;
#undef PG8_SA
#undef PG8_SB
#undef PG8_STAGE
#undef PG8_LDA
#undef PG8_LDB
#undef PG8_MMA
#undef PG8_WAIT_V
#undef PG8_WAIT_L
#undef PG8_BAR
#undef PG8_SCHED
}

struct EpiStore {
    static constexpr bool PERM = true;
    bf16_t* O; int ldc; const float* ss; int ss_lo, ss_n; float inv_dim;
    __device__ __forceinline__ void operator()(const f32x4 (&acc)[2][2][4][2], const Unit& u, int wr, int wc, int fr, int fq) const {
#pragma unroll
        for (int ai = 0; ai < 2; ++ai)
#pragma unroll
            for (int m = 0; m < 4; ++m) {
                const int row = u.pm * BM + ai * HALF + wr * 64 + m * 16 + fr;
                const float sc = ss ? rowscale(ss, row, ss_lo, ss_n, inv_dim) : 1.f;
#pragma unroll
                for (int bj = 0; bj < 2; ++bj) {
                    const int col = u.pn * BM + bj * HALF + wc * 32 + 8 * fq;
                    const f32x4 v0 = acc[ai][bj][m][0] * sc, v1 = acc[ai][bj][m][1] * sc;
                    u32x4 w; w.x = pk2(v0[0], v0[1]); w.y = pk2(v0[2], v0[3]); w.z = pk2(v1[0], v1[1]); w.w = pk2(v1[2], v1[3]);
                    *(u32x4*)(O + (size_t)row * ldc + col) = w;
                }
                asm volatile("" ::: "memory");
            }
    }
};
struct EpiDN {
    static constexpr bool PERM = true;
    bf16_t* QKV; bf16_t* Z; float* AB; bf16_t* HALO; const float* ss;
    __device__ __forceinline__ void operator()(const f32x4 (&acc)[2][2][4][2], const Unit& u, int wr, int wc, int fr, int fq) const {
#pragma unroll
        for (int ai = 0; ai < 2; ++ai)
#pragma unroll
            for (int m = 0; m < 4; ++m) {
                const int row = u.pm * BM + ai * HALF + wr * 64 + m * 16 + fr;
                const float sc = rowscale(ss, row, 0, 16, 1.0f / D);
#pragma unroll
                for (int bj = 0; bj < 2; ++bj) {
                    const int col = u.pn * BM + bj * HALF + wc * 32 + 8 * fq;
                    const f32x4 v0 = acc[ai][bj][m][0] * sc, v1 = acc[ai][bj][m][1] * sc;
                    u32x4 w; w.x = pk2(v0[0], v0[1]); w.y = pk2(v0[2], v0[3]); w.z = pk2(v1[0], v1[1]); w.w = pk2(v1[2], v1[3]);
                    if (u.pn < 12) {
                        *(u32x4*)(QKV + (size_t)row * 3072 + col) = w;
                        const int rl = row & 255;
                        if (rl >= 253 && u.pm + 1 < 64) *(u32x4*)(HALO + ((size_t)(u.pm + 1) * 3 + (rl - 253)) * 3072 + col) = w;
                    } else if (u.pn < 16) {
                        *(u32x4*)(Z + (size_t)row * 1024 + (col - 3072)) = w;
                    } else if (bj == 0 && wc == 0 && fq < 2) {
                        *(f32x4*)(AB + (size_t)row * 16 + 8 * fq) = v0; *(f32x4*)(AB + (size_t)row * 16 + 8 * fq + 4) = v1;
                    }
                }
                asm volatile("" ::: "memory");
            }
    }
};
struct EpiSwiglu {
    static constexpr bool PERM = true;
    bf16_t* H; const float* ss;
    __device__ __forceinline__ void operator()(const f32x4 (&acc)[2][2][4][2], const Unit& u, int wr, int wc, int fr, int fq) const {
#pragma unroll
        for (int ai = 0; ai < 2; ++ai)
#pragma unroll
            for (int m = 0; m < 4; ++m) {
                const int row = u.pm * BM + ai * HALF + wr * 64 + m * 16 + fr;
                const float sc = rowscale(ss, row, 0, 16, 1.0f / D);
                const int col = u.pn * HALF + wc * 32 + 8 * fq;
                float h[8];
#pragma unroll
                for (int n = 0; n < 2; ++n)
#pragma unroll
                    for (int i = 0; i < 4; ++i) { const float gt = acc[ai][0][m][n][i] * sc, up = acc[ai][1][m][n][i] * sc; h[4 * n + i] = silu_f(gt) * up; }
                u32x4 w; w.x = pk2(h[0], h[1]); w.y = pk2(h[2], h[3]); w.z = pk2(h[4], h[5]); w.w = pk2(h[6], h[7]);
                *(u32x4*)(H + (size_t)row * FH + col) = w;
                asm volatile("" ::: "memory");
            }
    }
};
struct EpiResidual {
    static constexpr bool PERM = false;
    const float* base; float* out; bf16_t* xb; float* ss;
    __device__ __forceinline__ void operator()(const f32x4 (&acc)[2][2][4][2], const Unit& u, int wr, int wc, int fr, int fq) const {
#pragma unroll
        for (int ai = 0; ai < 2; ++ai)
#pragma unroll
            for (int m = 0; m < 4; ++m) {
                const int row = u.pm * BM + ai * HALF + wr * 64 + m * 16 + fr;
                float s = 0.f;
#pragma unroll
                for (int bj = 0; bj < 2; ++bj)
#pragma unroll
                    for (int n = 0; n < 2; ++n) {
                        const int col = u.pn * BM + bj * HALF + wc * 32 + n * 16 + 4 * fq;
                        const size_t off = (size_t)row * D + col;
                        const f32x4 v = *(const f32x4*)(base + off) + acc[ai][bj][m][n];
                        *(f32x4*)(out + off) = v;
                        u32x2 w; w.x = pk2(v[0], v[1]); w.y = pk2(v[2], v[3]);
                        *(u32x2*)(xb + off) = w;
                        s += (v[0] * v[0] + v[1] * v[1]) + (v[2] * v[2] + v[3] * v[3]);
                    }
                s += __shfl_xor(s, 16); s += __shfl_xor(s, 32);
                if (fq == 0) ss[(size_t)row * 16 + u.pn * 4 + wc] = s;
                asm volatile("" ::: "memory");
            }
    }
};
struct EpiMlaDown {
    static constexpr bool PERM = true;
    bf16_t* C; float* ss2; const float* ss;
    __device__ __forceinline__ void operator()(const f32x4 (&acc)[2][2][4][2], const Unit& u, int wr, int wc, int fr, int fq) const {
#pragma unroll
        for (int ai = 0; ai < 2; ++ai)
#pragma unroll
            for (int m = 0; m < 4; ++m) {
                const int row = u.pm * BM + ai * HALF + wr * 64 + m * 16 + fr;
                const float sc = rowscale(ss, row, 0, 16, 1.0f / D);
#pragma unroll
                for (int bj = 0; bj < 2; ++bj) {
                    const int col = u.pn * BM + bj * HALF + wc * 32 + 8 * fq;
                    const f32x4 v0 = acc[ai][bj][m][0] * sc, v1 = acc[ai][bj][m][1] * sc;
                    u32x4 w; w.x = pk2(v0[0], v0[1]); w.y = pk2(v0[2], v0[3]); w.z = pk2(v1[0], v1[1]); w.w = pk2(v1[2], v1[3]);
                    *(u32x4*)(C + (size_t)row * 512 + col) = w;
                    float s = (v0[0] * v0[0] + v0[1] * v0[1]) + (v0[2] * v0[2] + v0[3] * v0[3]) + (v1[0] * v1[0] + v1[1] * v1[1]) + (v1[2] * v1[2] + v1[3] * v1[3]);
                    s += __shfl_xor(s, 16); s += __shfl_xor(s, 32);
                    if (fq == 0) ss2[(size_t)row * 16 + u.pn * 8 + bj * 4 + wc] = s;
                }
                asm volatile("" ::: "memory");
            }
    }
};
}

#define XB_TMO      128
#define XB_XCNT(j)  (256  + 64 * (j))
#define XB_XSUB(j)  (1280 + 64 * (j))
#define XB_XGEN(j)  (2304 + 64 * (j))
#define XB_TOP      3328
#define XB_TOPGEN   3392
#define XCD_BAR_WORDS 3456
#define XB_SPIN_CAP (1u << 20)
__device__ __forceinline__ unsigned xb_ld(unsigned* p)              { return __hip_atomic_load(p, __ATOMIC_RELAXED, __HIP_MEMORY_SCOPE_AGENT); }
__device__ __forceinline__ unsigned xb_add(unsigned* p, unsigned v) { return __hip_atomic_fetch_add(p, v, __ATOMIC_RELAXED, __HIP_MEMORY_SCOPE_AGENT); }
__device__ __forceinline__ unsigned xb_xcc_id() { return (unsigned)__builtin_amdgcn_s_getreg((3 << 11) | 20) & 0xFu; }
#define XB_SPIN(cond, bar) do { unsigned _sp = 0; while (cond) { __builtin_amdgcn_s_sleep(1); \
    if ((++_sp & 255u) == 0u) { if (xb_ld(&(bar)[XB_TMO])) break; if (_sp > XB_SPIN_CAP) { atomicAdd(&(bar)[XB_TMO], 1u); break; } } } } while (0)
struct XcdBarrier { unsigned* bar; unsigned x; volatile LAS unsigned* st; };
__device__ __forceinline__ XcdBarrier xcd_barrier_post(unsigned* bar, volatile LAS unsigned* st) {
    XcdBarrier b; b.bar = bar; b.x = xb_xcc_id(); b.st = st;
    if (threadIdx.x == 0) (void)xb_add(&bar[XB_XCNT(b.x)], 1u);
    return b;
}
__device__ __forceinline__ void xcd_barrier_complete(unsigned* bar, unsigned x, unsigned& nloc, unsigned& nx) {
    const unsigned G = gridDim.x * gridDim.y * gridDim.z;
    unsigned sum, cnt, mine, sp = 0u;
    for (;;) {
        sum = 0u; cnt = 0u; mine = 0u;
#pragma unroll
        for (unsigned j = 0; j < 16; ++j) { const unsigned c = xb_ld(&bar[XB_XCNT(j)]); sum += c; cnt += (c > 0u) ? 1u : 0u; mine = (j == x) ? c : mine; }
        if (sum == G) break;
        __builtin_amdgcn_s_sleep(1);
        if ((++sp & 255u) == 0u) { if (xb_ld(&bar[XB_TMO])) break; if (sp > XB_SPIN_CAP) { atomicAdd(&bar[XB_TMO], 1u); break; } }
    }
    nloc = mine > 0u ? mine : 1u; nx = cnt > 0u ? cnt : 1u;
}
__device__ __forceinline__ void xcd_barrier(const XcdBarrier& b) {
    asm volatile("s_waitcnt vmcnt(0)" ::: "memory");
    __syncthreads();
    if (threadIdx.x == 0) {
        unsigned* bar = b.bar;
        __builtin_amdgcn_s_waitcnt(0);
        unsigned nloc = b.st[0], nx = b.st[1];
        if (nloc == 0u) { xcd_barrier_complete(bar, b.x, nloc, nx); b.st[0] = nloc; b.st[1] = nx; }
        const unsigned old = xb_add(&bar[XB_XSUB(b.x)], 1u);
        const unsigned gen = old / nloc;
        if (old + 1u == (gen + 1u) * nloc) {
            __builtin_amdgcn_fence(__ATOMIC_RELEASE, "agent");
            asm volatile("s_waitcnt vmcnt(0)" ::: "memory");
            const unsigned og = xb_add(&bar[XB_TOP], 1u);
            const unsigned tg = og / nx;
            if (og + 1u == (tg + 1u) * nx) xb_add(&bar[XB_TOPGEN], 1u);
            else XB_SPIN(xb_ld(&bar[XB_TOPGEN]) == tg, bar);
            __builtin_amdgcn_fence(__ATOMIC_ACQUIRE, "agent");
            xb_add(&bar[XB_XGEN(b.x)], 1u);
            asm volatile("s_waitcnt vmcnt(0)" ::: "memory");
        } else {
            XB_SPIN(xb_ld(&bar[XB_XGEN(b.x)]) == gen, bar);
            __builtin_amdgcn_fence(__ATOMIC_ACQUIRE, "agent");
            asm volatile("s_waitcnt vmcnt(0)" ::: "memory");
        }
    }
    __syncthreads();
}

__device__ __forceinline__ void cvt_item(const float* W, int K, int N, bf16_t* WT, const float* gain, int swiglu, LAS float* scr, int item, int lane) {
    const int nblk = (N + 31) / 32, kb = item / nblk, nb = item % nblk, k0 = 64 * kb, n0 = 32 * nb;
    const int nn = n0 + (lane & 31);
#pragma unroll 8
    for (int i = 0; i < 32; ++i) { const int kk = 2 * i + (lane >> 5);
        float v = (nn < N) ? W[(size_t)(k0 + kk) * N + nn] : 0.f;
        if (gain) v *= gain[k0 + kk];
        scr[kk * 33 + (lane & 31)] = v; }
    asm volatile("s_waitcnt lgkmcnt(0)" ::: "memory");
    const int c = lane & 7;
#pragma unroll
    for (int j = 0; j < 4; ++j) { const int n = (lane >> 3) + 8 * j; const LAS float* s = scr + (8 * c) * 33 + n;
        u32x4 o; o.x = pk2(s[0 * 33], s[1 * 33]); o.y = pk2(s[2 * 33], s[3 * 33]); o.z = pk2(s[4 * 33], s[5 * 33]); o.w = pk2(s[6 * 33], s[7 * 33]);
        int dn = n0 + n;
        if (swiglu) { const int isup = dn >= FH; const int jj = isup ? dn - FH : dn; dn = (jj >> 7) * 256 + isup * 128 + (jj & 127); }
        *(u32x4*)(WT + (size_t)dn * K + k0 + 8 * c) = o; }
    asm volatile("s_waitcnt lgkmcnt(0)" ::: "memory");
}
__device__ __forceinline__ void cvt_weight(const float* W, int K, int N, int Npad, bf16_t* WT, const float* gain, int swiglu, LAS unsigned char* lds, int gw, int ngw, int wave, int lane) {
    LAS float* scr = (LAS float*)(lds + wave * 8704);
    const int nblk = (N + 31) / 32, nitems = (K / 64) * nblk;
    for (int it = gw; it < nitems; it += ngw) cvt_item(W, K, N, WT, gain, swiglu, scr, it, lane);
    const int zr0 = nblk * 32; const int nz = (Npad - zr0) * (K / 8);
    unsigned z0 = 0u; asm volatile("" : "+v"(z0));
    for (int i = gw * 64 + lane; i < nz; i += ngw * 64) *(u32x4*)(WT + (size_t)zr0 * K + (size_t)i * 8) = (u32x4){z0, z0, z0, z0};
}

struct Args { const float* in[43]; float* out; unsigned char* ws; int ph_lo, ph_hi; };

struct Ctx {
    LAS unsigned char* lds; unsigned char* ws; int tid, lane, wave, gw, ngw;
};

__device__ __forceinline__ void convert_mixer(const Args& a, const Ctx& c, int L) {
    unsigned char* ws = c.ws;
    if (L == 0 || L == 3) {
        const int b = (L == 0) ? 1 : 33;
        cvt_weight(a.in[b + 1], D, 4112, 4352, (bf16_t*)(ws + WS_WMIX), a.in[b], 0, c.lds, c.gw, c.ngw, c.wave, c.lane);
        cvt_weight(a.in[b + 6], D, D, D, (bf16_t*)(ws + WS_WMIX_OUT), nullptr, 0, c.lds, c.gw, c.ngw, c.wave, c.lane);
    } else if (L == 1) {
        cvt_weight(a.in[12], D, 3072, 3072, (bf16_t*)(ws + WS_WMIX), a.in[11], 0, c.lds, c.gw, c.ngw, c.wave, c.lane);
        cvt_weight(a.in[15], D, D, D, (bf16_t*)(ws + WS_WMIX_OUT), nullptr, 0, c.lds, c.gw, c.ngw, c.wave, c.lane);
    } else {
        cvt_weight(a.in[20], D, 448, 512, (bf16_t*)(ws + WS_WMIX), a.in[19], 0, c.lds, c.gw, c.ngw, c.wave, c.lane);
        cvt_weight(a.in[23], 256, 1536, 1536, (bf16_t*)(ws + WS_WMIX + 1 * MiB), a.in[21], 0, c.lds, c.gw, c.ngw, c.wave, c.lane);
        cvt_weight(a.in[24], 128, 2048, 2048, (bf16_t*)(ws + WS_WMIX + 2 * MiB), a.in[22], 0, c.lds, c.gw, c.ngw, c.wave, c.lane);
        cvt_weight(a.in[29], D, D, D, (bf16_t*)(ws + WS_WMIX_OUT), nullptr, 0, c.lds, c.gw, c.ngw, c.wave, c.lane);
    }
}
__device__ __forceinline__ void convert_ffn(const Args& a, const Ctx& c, int L) {
    const int b = (L == 0) ? 8 : (L == 1) ? 16 : (L == 2) ? 30 : 40;
    cvt_weight(a.in[b + 1], D, 2 * FH, 2 * FH, (bf16_t*)(c.ws + WS_WFFN), a.in[b], 1, c.lds, c.gw, c.ngw, c.wave, c.lane);
    cvt_weight(a.in[b + 2], FH, D, D, (bf16_t*)(c.ws + WS_WFFN_DN), nullptr, 0, c.lds, c.gw, c.ngw, c.wave, c.lane);
}

__device__ __forceinline__ void prologue_rows(const Args& a, const Ctx& c) {
    const float* x = a.in[0]; bf16_t* xb = (bf16_t*)(c.ws + WS_R1); float* ss = (float*)(c.ws + WS_SS);
    for (int m = c.gw; m < M; m += c.ngw) {
        const f32x4* xr = (const f32x4*)(x + (size_t)m * D) + c.lane;
        f32x4 v[4]; float s = 0.f;
#pragma unroll
        for (int j = 0; j < 4; ++j) { v[j] = xr[64 * j]; s += (v[j][0] * v[j][0] + v[j][1] * v[j][1]) + (v[j][2] * v[j][2] + v[j][3] * v[j][3]); }
        s = wave_sum(s);
        u32x2* o = (u32x2*)(xb + (size_t)m * D) + c.lane;
#pragma unroll
        for (int j = 0; j < 4; ++j) { u32x2 w; w.x = pk2(v[j][0], v[j][1]); w.y = pk2(v[j][2], v[j][3]); o[64 * j] = w; }
        if (c.lane < 16) ss[(size_t)m * 16 + c.lane] = (c.lane == 0) ? s : 0.f;
    }
}

__device__ __forceinline__ void dn_conv(const Args& a, const Ctx& c, const float* conv_w) {
    bf16_t* QKV = (bf16_t*)(c.ws + WS_R2); const bf16_t* HALO = (const bf16_t*)(c.ws + WS_HALO); float* RS = (float*)(c.ws + WS_RS);
    LAS float* psum = (LAS float*)c.lds;
    const int col = c.tid & 127, seg = c.tid >> 7;
    for (int item = blockIdx.x; item < 64 * 24; item += gridDim.x) {
        const int pm = item / 24, slab = item % 24, which = slab >> 3, h = slab & 7;
        const int gcol = slab * 128 + col; const int row0 = pm * 256 + seg * 64;
        float h0, h1, h2;
        if (seg == 0) {
            if ((pm & 15) == 0) { h0 = h1 = h2 = 0.f; }
            else { const bf16_t* hp = HALO + (size_t)pm * 3 * 3072 + gcol; h0 = bf2f(hp[0]); h1 = bf2f(hp[3072]); h2 = bf2f(hp[2 * 3072]); }
        } else { const bf16_t* hp = QKV + (size_t)(row0 - 3) * 3072 + gcol; h0 = bf2f(hp[0]); h1 = bf2f(hp[3072]); h2 = bf2f(hp[2 * 3072]); }
        const float w0 = conv_w[gcol], w1 = conv_w[3072 + gcol], w2 = conv_w[2 * 3072 + gcol], w3 = conv_w[3 * 3072 + gcol];
        __syncthreads();
        bf16_t* p = QKV + (size_t)row0 * 3072 + gcol;
#pragma unroll 8
        for (int r = 0; r < 64; ++r) {
            const float uu = bf2f(p[(size_t)r * 3072]);
            const float y = w0 * h0 + w1 * h1 + w2 * h2 + w3 * uu;
            const unsigned sb = f2bf(silu_f(y));
            p[(size_t)r * 3072] = (bf16_t)sb;
            h0 = h1; h1 = h2; h2 = uu;
            if (which < 2) { const float sv = bf2f(sb); const float t = wave_sum(sv * sv); if (c.lane == 0) psum[(seg * 64 + r) * 2 + (c.wave & 1)] = t; }
        }
        __syncthreads();
        if (which < 2 && c.tid < 256) {
            const float tot = psum[c.tid * 2] + psum[c.tid * 2 + 1];
            RS[(size_t)(pm * 256 + c.tid) * 16 + which * 8 + h] = (1.0f / sqrtf(tot + EPS)) * (which == 0 ? 0.08838834764831845f : 1.f);
        }
        __syncthreads();
    }
}

constexpr int DB_LM = 0, DB_GC = 17408, DB_BETA = 17664, DB_KB = 17920, DB_QB = 35328, DB_K32 = 52736, DB_V32 = 86528;
__device__ __forceinline__ void dn_chunk(const Args& a, const Ctx& c, const float* a_log, const float* dt_bias) {
    bf16_t* QKV = (bf16_t*)(c.ws + WS_R2); bf16_t* KT = (bf16_t*)(c.ws + WS_R1); bf16_t* ATT = (bf16_t*)(c.ws + WS_R5);
    const float* AB = (const float*)(c.ws + WS_AB); const float* RS = (const float*)(c.ws + WS_RS); float* GC = (float*)(c.ws + WS_GC);
    LAS bf16_t* kb = (LAS bf16_t*)(c.lds + DB_KB); LAS bf16_t* qb = (LAS bf16_t*)(c.lds + DB_QB);
    LAS float* K32 = (LAS float*)(c.lds + DB_K32); LAS float* V32 = (LAS float*)(c.lds + DB_V32); LAS float* Lm = (LAS float*)(c.lds + DB_LM);
    LAS float* gcs = (LAS float*)(c.lds + DB_GC); LAS float* betas = (LAS float*)(c.lds + DB_BETA);
    const int lane = c.lane, wave = c.wave, quad = lane >> 4, l15 = lane & 15;
    for (int item = blockIdx.x; item < BATCH * 64 * NH; item += gridDim.x) {
        const int h = item & 7, n = (item >> 3) & 63, b = item >> 9;
        const int t0 = b * SEQ + n * 64;
        if (wave == 0) {
            const float av = AB[(size_t)(t0 + lane) * 16 + h], bl = AB[(size_t)(t0 + lane) * 16 + 8 + h];
            float g = -fexp(a_log[h]) * softplus_f(av + dt_bias[h]);
#pragma unroll
            for (int o = 1; o < 64; o <<= 1) { const float t = __shfl_up(g, o); if (lane >= o) g += t; }
            gcs[lane] = g; betas[lane] = 1.f / (1.f + fexp(-bl));
            GC[(size_t)(t0 + lane) * 8 + h] = g;
        }
        __syncthreads();
        {
            const int r = c.tid >> 3, cc = (c.tid & 7) * 16;
            const size_t rowoff = (size_t)(t0 + r) * 3072 + h * 128 + cc;
            const float rsq = RS[(size_t)(t0 + r) * 16 + h], rsk = RS[(size_t)(t0 + r) * 16 + 8 + h];
            const float be = betas[r], eg = fexp(gcs[r]);
            u32x4 qw[2], kw[2], vw[2];
#pragma unroll
            for (int i = 0; i < 2; ++i) { qw[i] = *(const u32x4*)(QKV + rowoff + 8 * i); kw[i] = *(const u32x4*)(QKV + rowoff + 1024 + 8 * i); vw[i] = *(const u32x4*)(QKV + rowoff + 2048 + 8 * i); }
#pragma unroll
            for (int i = 0; i < 2; ++i) {
                u32x4 qo, ko;
#pragma unroll
                for (int j = 0; j < 4; ++j) {
                    const float q0 = bflo(qw[i][j]) * rsq, q1 = bfhi(qw[i][j]) * rsq;
                    const float k0 = bflo(kw[i][j]) * rsk, k1 = bfhi(kw[i][j]) * rsk;
                    const float v0 = bflo(vw[i][j]), v1 = bfhi(vw[i][j]);
                    qo[j] = pk2(q0, q1); ko[j] = pk2(k0, k1);
                    const int cidx = cc + 8 * i + 2 * j;
                    K32[r * 132 + cidx] = k0 * be * eg; K32[r * 132 + cidx + 1] = k1 * be * eg;
                    V32[r * 132 + cidx] = v0 * be; V32[r * 132 + cidx + 1] = v1 * be;
                }
                *(LAS u32x4*)(qb + r * 136 + cc + 8 * i) = qo; *(LAS u32x4*)(kb + r * 136 + cc + 8 * i) = ko;
            }
        }
        __syncthreads();
        {
            const int wm = wave & 3; const LAS bf16_t* Asrc = (wave < 4) ? kb : qb;
            f32x4 acc[4];
#pragma unroll
            for (int nt = 0; nt < 4; ++nt) acc[nt] = (f32x4){0.f, 0.f, 0.f, 0.f};
#pragma unroll
            for (int ks = 0; ks < 4; ++ks) {
                const bf16x8 af = *(const LAS bf16x8*)(Asrc + (16 * wm + l15) * 136 + 32 * ks + 8 * quad);
#pragma unroll
                for (int nt = 0; nt < 4; ++nt) {
                    const bf16x8 bfr = *(const LAS bf16x8*)(kb + (16 * nt + l15) * 136 + 32 * ks + 8 * quad);
                    acc[nt] = __builtin_amdgcn_mfma_f32_16x16x32_bf16(af, bfr, acc[nt], 0, 0, 0);
                }
            }
            bf16_t* att = ATT + (size_t)((b * NH + h) * 64 + n) * 4096;
#pragma unroll
            for (int nt = 0; nt < 4; ++nt)
#pragma unroll
                for (int r = 0; r < 4; ++r) {
                    const int cr = 16 * wm + 4 * quad + r, cs = 16 * nt + l15;
                    const float dec = fexp(fminf(gcs[cr] - gcs[cs], 0.f));
                    if (wave < 4) Lm[cr * 68 + cs] = (cr > cs) ? betas[cr] * acc[nt][r] * dec : 0.f;
                    else att[cr * 64 + cs] = (bf16_t)f2bf((cr >= cs) ? acc[nt][r] * dec : 0.f);
                }
        }
        __syncthreads();
        if (wave < 4) {
            const int j = wave * 64 + lane;
            const LAS float* rhs = (j < 128) ? (V32 + j) : (K32 + (j - 128));
            float sol[64];
#pragma unroll
            for (int i = 0; i < 64; ++i) {
                float a0 = rhs[i * 132], a1 = 0.f;
#pragma unroll
                for (int jb = 0; jb < i; jb += 4) {
                    const f32x4 lv = *(const LAS f32x4*)(Lm + i * 68 + jb);
                    a0 -= lv[0] * sol[jb];
                    if (jb + 1 < i) a1 -= lv[1] * sol[jb + 1];
                    if (jb + 2 < i) a0 -= lv[2] * sol[jb + 2];
                    if (jb + 3 < i) a1 -= lv[3] * sol[jb + 3];
                }
                sol[i] = a0 + a1;
            }
            bf16_t* dst = QKV + (size_t)t0 * 3072 + ((j < 128) ? (2048 + h * 128 + j) : (1024 + h * 128 + (j - 128)));
#pragma unroll
            for (int i = 0; i < 64; ++i) dst[(size_t)i * 3072] = (bf16_t)f2bf(sol[i]);
        } else {
            const int t = c.tid - 256, dk = t & 127, ch = t >> 7;
            bf16_t* kt = KT + (size_t)((b * NH + h) * 64 + n) * 8192 + dk * 64 + ch * 32;
#pragma unroll
            for (int g4 = 0; g4 < 4; ++g4) {
                u32x4 w;
#pragma unroll
                for (int e = 0; e < 4; ++e) { const int cc = ch * 32 + g4 * 8 + 2 * e; w[e] = (unsigned)kb[cc * 136 + dk] | ((unsigned)kb[(cc + 1) * 136 + dk] << 16); }
                *(u32x4*)(kt + g4 * 8) = w;
            }
            const int r = t >> 2, c0 = (t & 3) * 32;
#pragma unroll
            for (int i = 0; i < 4; ++i) *(u32x4*)(QKV + (size_t)(t0 + r) * 3072 + h * 128 + c0 + 8 * i) = *(const LAS u32x4*)(qb + r * 136 + c0 + 8 * i);
        }
        __syncthreads();
    }
}

__device__ __forceinline__ bf16x8 ld2x4(const bf16_t* p) {
    const u32x2 lo = *(const u32x2*)p, hi = *(const u32x2*)(p + 16);
    u32x4 w; w.x = lo.x; w.y = lo.y; w.z = hi.x; w.w = hi.y; return __builtin_bit_cast(bf16x8, w);
}
__device__ __forceinline__ bf16x8 pack8(const f32x4 a, const f32x4 b) {
    u32x4 w; w.x = pk2(a[0], a[1]); w.y = pk2(a[2], a[3]); w.z = pk2(b[0], b[1]); w.w = pk2(b[2], b[3]); return __builtin_bit_cast(bf16x8, w);
}
__device__ __forceinline__ void dn_scan(const Args& a, const Ctx& c) {
    const bf16_t* QKV = (const bf16_t*)(c.ws + WS_R2); const bf16_t* KT = (const bf16_t*)(c.ws + WS_R1); const bf16_t* ATT = (const bf16_t*)(c.ws + WS_R5);
    const float* GC = (const float*)(c.ws + WS_GC); bf16_t* O = (bf16_t*)(c.ws + WS_R4);
    if (c.wave != 0) return;
    const int lane = c.lane, quad = lane >> 4, l15 = lane & 15;
    for (int item = blockIdx.x; item < BATCH * NH * 8; item += gridDim.x) {
        const int sl = item & 7, h = (item >> 3) & 7, b = item >> 6;
        f32x4 S[8];
#pragma unroll
        for (int mt = 0; mt < 8; ++mt) S[mt] = (f32x4){0.f, 0.f, 0.f, 0.f};
        for (int n = 0; n < 64; ++n) {
            const int t0 = b * SEQ + n * 64;
            const size_t ci = (size_t)((b * NH + h) * 64 + n);
            const bf16_t* qrow = QKV + (size_t)t0 * 3072 + h * 128;
            bf16x8 Sb[4];
#pragma unroll
            for (int ks = 0; ks < 4; ++ks) Sb[ks] = pack8(S[2 * ks], S[2 * ks + 1]);
            f32x4 P[4], QS[4];
#pragma unroll
            for (int ct = 0; ct < 4; ++ct) { P[ct] = (f32x4){0.f, 0.f, 0.f, 0.f}; QS[ct] = (f32x4){0.f, 0.f, 0.f, 0.f}; }
#pragma unroll
            for (int ct = 0; ct < 4; ++ct)
#pragma unroll
                for (int ks = 0; ks < 4; ++ks) {
                    const bf16_t* pr = qrow + (size_t)(16 * ct + l15) * 3072 + 32 * ks + 4 * quad;
                    P[ct] = __builtin_amdgcn_mfma_f32_16x16x32_bf16(ld2x4(pr + 1024), Sb[ks], P[ct], 0, 0, 0);
                    QS[ct] = __builtin_amdgcn_mfma_f32_16x16x32_bf16(ld2x4(pr), Sb[ks], QS[ct], 0, 0, 0);
                }
            const float gL = GC[(size_t)(t0 + 63) * 8 + h];
            f32x4 vn[4], vd[4], o[4];
#pragma unroll
            for (int ct = 0; ct < 4; ++ct)
#pragma unroll
                for (int r = 0; r < 4; ++r) {
                    const int cr = 16 * ct + 4 * quad + r;
                    const float u = bf2f(qrow[(size_t)cr * 3072 + 2048 + 16 * sl + l15]);
                    const float g = GC[(size_t)(t0 + cr) * 8 + h];
                    const float v = u - P[ct][r];
                    vn[ct][r] = v; vd[ct][r] = v * fexp(gL - g); o[ct][r] = QS[ct][r] * fexp(g);
                }
            bf16x8 Vb[2], Vdb[2];
#pragma unroll
            for (int k2 = 0; k2 < 2; ++k2) { Vb[k2] = pack8(vn[2 * k2], vn[2 * k2 + 1]); Vdb[k2] = pack8(vd[2 * k2], vd[2 * k2 + 1]); }
            const bf16_t* att = ATT + ci * 4096;
#pragma unroll
            for (int ct = 0; ct < 4; ++ct)
#pragma unroll
                for (int k2 = 0; k2 < 2; ++k2)
                    o[ct] = __builtin_amdgcn_mfma_f32_16x16x32_bf16(ld2x4(att + (16 * ct + l15) * 64 + 32 * k2 + 4 * quad), Vb[k2], o[ct], 0, 0, 0);
#pragma unroll
            for (int ct = 0; ct < 4; ++ct)
#pragma unroll
                for (int r = 0; r < 4; ++r) O[(size_t)(t0 + 16 * ct + 4 * quad + r) * 1024 + h * 128 + 16 * sl + l15] = (bf16_t)f2bf(o[ct][r]);
            const float eL = fexp(gL);
            const bf16_t* kt = KT + ci * 8192;
#pragma unroll
            for (int mt = 0; mt < 8; ++mt) {
                S[mt] = S[mt] * eL;
#pragma unroll
                for (int k2 = 0; k2 < 2; ++k2)
                    S[mt] = __builtin_amdgcn_mfma_f32_16x16x32_bf16(ld2x4(kt + (16 * mt + l15) * 64 + 32 * k2 + 4 * quad), Vdb[k2], S[mt], 0, 0, 0);
            }
        }
    }
}

__device__ __forceinline__ void dn_post(const Args& a, const Ctx& c, const float* out_norm) {
    bf16_t* O = (bf16_t*)(c.ws + WS_R4); const bf16_t* Z = (const bf16_t*)(c.ws + WS_R3);
    const int cb = (c.lane & 7) * 16;
    float gn[16];
#pragma unroll
    for (int i = 0; i < 16; ++i) gn[i] = out_norm[cb + i];
    for (int m = c.gw; m < M; m += c.ngw) {
        u32x4 ow[2], zw[2];
#pragma unroll
        for (int i = 0; i < 2; ++i) { ow[i] = *(const u32x4*)(O + (size_t)m * D + c.lane * 16 + 8 * i); zw[i] = *(const u32x4*)(Z + (size_t)m * D + c.lane * 16 + 8 * i); }
        float ov[16], s = 0.f;
#pragma unroll
        for (int i = 0; i < 2; ++i)
#pragma unroll
            for (int j = 0; j < 4; ++j) { ov[8 * i + 2 * j] = bflo(ow[i][j]); ov[8 * i + 2 * j + 1] = bfhi(ow[i][j]); }
#pragma unroll
        for (int i = 0; i < 16; ++i) s += ov[i] * ov[i];
        s += __shfl_xor(s, 1); s += __shfl_xor(s, 2); s += __shfl_xor(s, 4);
        const float rs = 1.0f / sqrtf(s * (1.0f / 128.0f) + EPS);
        u32x4 res[2];
#pragma unroll
        for (int i = 0; i < 2; ++i)
#pragma unroll
            for (int j = 0; j < 4; ++j) {
                const float z0 = bflo(zw[i][j]), z1 = bfhi(zw[i][j]);
                res[i][j] = pk2(ov[8 * i + 2 * j] * rs * gn[8 * i + 2 * j] * silu_f(z0), ov[8 * i + 2 * j + 1] * rs * gn[8 * i + 2 * j + 1] * silu_f(z1));
            }
#pragma unroll
        for (int i = 0; i < 2; ++i) *(u32x4*)(O + (size_t)m * D + c.lane * 16 + 8 * i) = res[i];
    }
}

__device__ __forceinline__ void v_transpose(const Ctx& c, const bf16_t* src, int pitch, int head_stride, int col_base, bf16_t* Vt) {
    LAS bf16_t* tile = (LAS bf16_t*)c.lds;
    for (int item = blockIdx.x; item < BATCH * NH * 64; item += gridDim.x) {
        const int tb = item & 63, h = (item >> 6) & 7, b = item >> 9;
        const int t0 = b * SEQ + tb * 64;
        { const int r = c.tid >> 3, cc = (c.tid & 7) * 16;
          const bf16_t* p = src + (size_t)(t0 + r) * pitch + col_base + h * head_stride + cc;
          *(LAS u32x4*)(tile + r * 136 + cc) = *(const u32x4*)p; *(LAS u32x4*)(tile + r * 136 + cc + 8) = *(const u32x4*)(p + 8); }
        __syncthreads();
        { const int d = c.tid >> 2, tq = (c.tid & 3) * 16;
          u32x4 w[2];
#pragma unroll
          for (int i = 0; i < 2; ++i)
#pragma unroll
              for (int e = 0; e < 4; ++e) { const int t = tq + 8 * i + 2 * e; w[i][e] = (unsigned)tile[t * 136 + d] | ((unsigned)tile[(t + 1) * 136 + d] << 16); }
          bf16_t* dst = Vt + ((size_t)((b * NH + h) * 128 + d)) * SEQ + tb * 64 + tq;
          *(u32x4*)dst = w[0]; *(u32x4*)(dst + 8) = w[1]; }
        __syncthreads();
    }
}

__device__ __forceinline__ void sb_prep_rows(const Args& a, const Ctx& c, const float* qn, const float* kn) {
    bf16_t* QKV = (bf16_t*)(c.ws + WS_R2);
    const int cb = (c.lane & 7) * 16;
    float gq[16], gk[16];
#pragma unroll
    for (int i = 0; i < 16; ++i) { gq[i] = qn[cb + i] * 0.08838834764831845f; gk[i] = kn[cb + i]; }
    for (int m = c.gw; m < M; m += c.ngw) {
#pragma unroll
        for (int which = 0; which < 2; ++which) {
            bf16_t* p = QKV + (size_t)m * 3072 + which * 1024 + c.lane * 16;
            u32x4 w[2]; w[0] = *(const u32x4*)p; w[1] = *(const u32x4*)(p + 8);
            float v[16], s = 0.f;
#pragma unroll
            for (int i = 0; i < 2; ++i)
#pragma unroll
                for (int j = 0; j < 4; ++j) { v[8 * i + 2 * j] = bflo(w[i][j]); v[8 * i + 2 * j + 1] = bfhi(w[i][j]); }
#pragma unroll
            for (int i = 0; i < 16; ++i) s += v[i] * v[i];
            s += __shfl_xor(s, 1); s += __shfl_xor(s, 2); s += __shfl_xor(s, 4);
            const float rs = 1.0f / sqrtf(s * (1.0f / 128.0f) + EPS);
            u32x4 o[2];
#pragma unroll
            for (int i = 0; i < 2; ++i)
#pragma unroll
                for (int j = 0; j < 4; ++j) {
                    const float g0 = which ? gk[8 * i + 2 * j] : gq[8 * i + 2 * j], g1 = which ? gk[8 * i + 2 * j + 1] : gq[8 * i + 2 * j + 1];
                    o[i][j] = pk2(v[8 * i + 2 * j] * rs * g0, v[8 * i + 2 * j + 1] * rs * g1);
                }
            *(u32x4*)p = o[0]; *(u32x4*)(p + 8) = o[1];
        }
    }
}

__device__ __forceinline__ void mla_prep_rows(const Args& a, const Ctx& c) {
    bf16_t* Q = (bf16_t*)(c.ws + WS_R2); bf16_t* Kf = (bf16_t*)(c.ws + WS_R2 + 48 * MiB);
    const bf16_t* KV = (const bf16_t*)(c.ws + WS_R3); const bf16_t* C = (const bf16_t*)(c.ws + WS_R5);
    const float* gqn = a.in[25]; const float* gqr = a.in[26]; const float* gkn = a.in[27]; const float* gkr = a.in[28];
    const int lane = c.lane, i32 = lane & 31;
    const float SC = 0.07216878364870322f;
    const float gqn0 = gqn[2 * lane] * SC, gqn1 = gqn[2 * lane + 1] * SC, gkn0 = gkn[2 * lane], gkn1 = gkn[2 * lane + 1];
    const float gqr0 = gqr[i32] * SC, gqr1 = gqr[i32 + 32] * SC, gkr0 = gkr[i32], gkr1 = gkr[i32 + 32];
    const float inv_freq = __builtin_amdgcn_exp2f(-(float)(2 * i32) * (1.0f / 64.0f) * 13.287712379549449f);
    for (int m = c.gw; m < M; m += c.ngw) {
        const int t = m & (SEQ - 1);
        const float ang = (float)t * inv_freq;
        const double rev = (double)ang * 0.15915494309189535; const float fr = (float)(rev - floor(rev));
        const float cs = __builtin_amdgcn_cosf(fr), sn = __builtin_amdgcn_sinf(fr);
        float kr0 = 0.f, kr1 = 0.f;
        { float x1 = 0.f, x2 = 0.f;
          if (lane < 32) { x1 = bf2f(C[(size_t)m * 512 + 384 + lane]); x2 = bf2f(C[(size_t)m * 512 + 416 + lane]); }
          const float s = wave_sum(x1 * x1 + x2 * x2); const float rs = 1.0f / sqrtf(s * (1.0f / 64.0f) + EPS);
          x1 *= rs * gkr0; x2 *= rs * gkr1; kr0 = x1 * cs - x2 * sn; kr1 = x2 * cs + x1 * sn; }
        for (int h = 0; h < NH; ++h) {
            bf16_t* qp = Q + (size_t)m * 1536 + h * 192;
            const unsigned qw = *(const unsigned*)(qp + 2 * lane);
            float a0 = bflo(qw), a1 = bfhi(qw);
            float x1 = 0.f, x2 = 0.f;
            if (lane < 32) { x1 = bf2f(qp[128 + lane]); x2 = bf2f(qp[160 + lane]); }
            const float sn_ = wave_sum(a0 * a0 + a1 * a1), sr_ = wave_sum(x1 * x1 + x2 * x2);
            const float rn = 1.0f / sqrtf(sn_ * (1.0f / 128.0f) + EPS), rr = 1.0f / sqrtf(sr_ * (1.0f / 64.0f) + EPS);
            *(unsigned*)(qp + 2 * lane) = pk2(a0 * rn * gqn0, a1 * rn * gqn1);
            if (lane < 32) { x1 *= rr * gqr0; x2 *= rr * gqr1; qp[128 + lane] = (bf16_t)f2bf(x1 * cs - x2 * sn); qp[160 + lane] = (bf16_t)f2bf(x2 * cs + x1 * sn); }
            const unsigned kw = *(const unsigned*)(KV + (size_t)m * 2048 + h * 256 + 2 * lane);
            const float b0 = bflo(kw), b1 = bfhi(kw);
            const float sk = wave_sum(b0 * b0 + b1 * b1); const float rk = 1.0f / sqrtf(sk * (1.0f / 128.0f) + EPS);
            bf16_t* kp = Kf + (size_t)m * 1536 + h * 192;
            *(unsigned*)(kp + 2 * lane) = pk2(b0 * rk * gkn0, b1 * rk * gkn1);
            if (lane < 32) { kp[128 + lane] = (bf16_t)f2bf(kr0); kp[160 + lane] = (bf16_t)f2bf(kr1); }
        }
    }
}

template <int DK, bool STICK>
__device__ __forceinline__ void attn_phase(const Ctx& c, const bf16_t* Q, int qpitch, const bf16_t* Kg, int kpitch, const bf16_t* Vt, bf16_t* O, int opitch) {
    constexpr int KP = DK + 8;
    constexpr int KS = DK / 32;
    LAS bf16_t* Kt = (LAS bf16_t*)c.lds;
    LAS bf16_t* Vl = (LAS bf16_t*)(c.lds + 64 * KP * 2);
    const int lane = c.lane, wave = c.wave, quad = lane >> 4, l15 = lane & 15;
    for (int pu = blockIdx.x; pu < 256; pu += gridDim.x) {
        const int bh = pu >> 3, s8 = pu & 7, b = bh >> 3, h = bh & 7;
        for (int half = 0; half < 2; ++half) {
            const int qb = half ? 15 - s8 : s8;
            const int q0 = qb * 256 + wave * 32;
            bf16x8 Qf[2][KS];
#pragma unroll
            for (int qt = 0; qt < 2; ++qt)
#pragma unroll
                for (int ks = 0; ks < KS; ++ks) Qf[qt][ks] = *(const bf16x8*)(Q + (size_t)(b * SEQ + q0 + 16 * qt + l15) * qpitch + h * DK + 32 * ks + 8 * quad);
            f32x4 Oa[8][2];
#pragma unroll
            for (int dt = 0; dt < 8; ++dt) { Oa[dt][0] = (f32x4){0.f, 0.f, 0.f, 0.f}; Oa[dt][1] = (f32x4){0.f, 0.f, 0.f, 0.f}; }
            float mrow[2] = {-1e30f, -1e30f}, lrow[2] = {0.f, 0.f}, Rrow[2] = {0.f, 0.f};
            const int ntile = 4 * (qb + 1);
            for (int it = 0; it < ntile; ++it) {
                const int kt = STICK ? (ntile - 1 - it) : it;
                const int key0 = kt * 64;
                __syncthreads();
                { const int r = c.tid >> 3, cc = (c.tid & 7) * (DK / 8);
                  const bf16_t* p = Kg + (size_t)(b * SEQ + key0 + r) * kpitch + h * DK + cc;
#pragma unroll
                  for (int i = 0; i < DK / 64; ++i) *(LAS u32x4*)(Kt + r * KP + cc + 8 * i) = *(const u32x4*)(p + 8 * i);
                  const int d = c.tid >> 2, kq = (c.tid & 3) * 16;
                  const bf16_t* pv = Vt + ((size_t)(bh * 128 + d)) * SEQ + key0 + kq;
                  *(LAS u32x4*)(Vl + d * 72 + kq) = *(const u32x4*)pv; *(LAS u32x4*)(Vl + d * 72 + kq + 8) = *(const u32x4*)(pv + 8); }
                __syncthreads();
                if (key0 > q0 + 31) continue;
                f32x4 St[4][2];
#pragma unroll
                for (int k4 = 0; k4 < 4; ++k4) { St[k4][0] = (f32x4){0.f, 0.f, 0.f, 0.f}; St[k4][1] = (f32x4){0.f, 0.f, 0.f, 0.f}; }
#pragma unroll
                for (int ks = 0; ks < KS; ++ks)
#pragma unroll
                    for (int k4 = 0; k4 < 4; ++k4) {
                        const bf16x8 kf = *(const LAS bf16x8*)(Kt + (16 * k4 + l15) * KP + 32 * ks + 8 * quad);
                        St[k4][0] = __builtin_amdgcn_mfma_f32_16x16x32_bf16(kf, Qf[0][ks], St[k4][0], 0, 0, 0);
                        St[k4][1] = __builtin_amdgcn_mfma_f32_16x16x32_bf16(kf, Qf[1][ks], St[k4][1], 0, 0, 0);
                    }
                bf16x8 Pb[2][2];
#pragma unroll
                for (int qt = 0; qt < 2; ++qt) {
                    const int tq = q0 + 16 * qt + l15;
                    if constexpr (!STICK) {
                        float mx = -1e30f;
#pragma unroll
                        for (int k4 = 0; k4 < 4; ++k4)
#pragma unroll
                            for (int r = 0; r < 4; ++r) { const int key = key0 + 16 * k4 + 4 * quad + r; const float z = (key <= tq) ? St[k4][qt][r] : -1e30f; St[k4][qt][r] = z; mx = fmaxf(mx, z); }
                        mx = fmaxf(mx, __shfl_xor(mx, 16)); mx = fmaxf(mx, __shfl_xor(mx, 32));
                        const float mnew = fmaxf(mrow[qt], mx);
                        const float alpha = fexp(mrow[qt] - mnew);
                        float ps = 0.f;
#pragma unroll
                        for (int k4 = 0; k4 < 4; ++k4)
#pragma unroll
                            for (int r = 0; r < 4; ++r) { const float p = (St[k4][qt][r] > -1e29f) ? fexp(St[k4][qt][r] - mnew) : 0.f; St[k4][qt][r] = p; ps += p; }
                        ps += __shfl_xor(ps, 16); ps += __shfl_xor(ps, 32);
                        lrow[qt] = lrow[qt] * alpha + ps; mrow[qt] = mnew;
#pragma unroll
                        for (int dt = 0; dt < 8; ++dt) Oa[dt][qt] = Oa[dt][qt] * alpha;
                    } else {
                        float G[4], ls[4][4];
#pragma unroll
                        for (int k4 = 0; k4 < 4; ++k4) {
                            G[k4] = 0.f;
#pragma unroll
                            for (int r = 0; r < 4; ++r) { const int key = key0 + 16 * k4 + 4 * quad + r; const float z = St[k4][qt][r];
                                const float sp = softplus_f(z); const bool valid = key < tq; ls[k4][r] = valid ? -sp : 0.f; G[k4] += ls[k4][r];
                                St[k4][qt][r] = valid ? (z - sp) : -1e30f; }
                        }
                        float run = Rrow[qt];
#pragma unroll
                        for (int k4 = 3; k4 >= 0; --k4) {
                            const float g = G[k4];
                            const float gb = __shfl_xor(g, 16), gc2 = __shfl_xor(g, 32), gd = __shfl_xor(gb, 32);
                            const float hi = (((quad ^ 1) > quad) ? gb : 0.f) + (((quad ^ 2) > quad) ? gc2 : 0.f) + (((quad ^ 3) > quad) ? gd : 0.f);
                            float aft = run + hi;
#pragma unroll
                            for (int r = 3; r >= 0; --r) { const float lz = St[k4][qt][r]; St[k4][qt][r] = (lz > -1e29f) ? fexp(lz + aft) : 0.f; aft += ls[k4][r]; }
                            run += (g + gb) + (gc2 + gd);
                        }
                        Rrow[qt] = run;
                    }
                    Pb[qt][0] = pack8(St[0][qt], St[1][qt]); Pb[qt][1] = pack8(St[2][qt], St[3][qt]);
                }
#pragma unroll
                for (int dt = 0; dt < 8; ++dt)
#pragma unroll
                    for (int k2 = 0; k2 < 2; ++k2) {
                        const LAS bf16_t* vp = Vl + (16 * dt + l15) * 72 + 32 * k2 + 4 * quad;
                        const u32x2 lo = *(const LAS u32x2*)vp, hi = *(const LAS u32x2*)(vp + 16);
                        u32x4 w; w.x = lo.x; w.y = lo.y; w.z = hi.x; w.w = hi.y; const bf16x8 vf = __builtin_bit_cast(bf16x8, w);
                        Oa[dt][0] = __builtin_amdgcn_mfma_f32_16x16x32_bf16(vf, Pb[0][k2], Oa[dt][0], 0, 0, 0);
                        Oa[dt][1] = __builtin_amdgcn_mfma_f32_16x16x32_bf16(vf, Pb[1][k2], Oa[dt][1], 0, 0, 0);
                    }
            }
#pragma unroll
            for (int qt = 0; qt < 2; ++qt) {
                const float inv = STICK ? 1.f : 1.f / lrow[qt];
                bf16_t* op = O + (size_t)(b * SEQ + q0 + 16 * qt + l15) * opitch + h * 128 + 4 * quad;
#pragma unroll
                for (int dt = 0; dt < 8; ++dt) { u32x2 w; w.x = pk2(Oa[dt][qt][0] * inv, Oa[dt][qt][1] * inv); w.y = pk2(Oa[dt][qt][2] * inv, Oa[dt][qt][3] * inv); *(u32x2*)(op + 16 * dt) = w; }
            }
        }
    }
}

constexpr int NPHASE = 30;
__device__ __forceinline__ Ctx mkctx(LAS unsigned char* lds, unsigned char* ws_) {
    int t = threadIdx.x; asm volatile("" : "+v"(t));
    asm volatile("" : "+s"(ws_));
    Ctx c; c.lds = lds; c.ws = ws_; c.tid = t; c.lane = t & 63; c.wave = __builtin_amdgcn_readfirstlane(t >> 6);
    c.gw = blockIdx.x * NWAVES + c.wave; c.ngw = gridDim.x * NWAVES; return c;
}
#define PH_BEGIN Ctx c = mkctx(ldsp, args.ws); const Args& A = args; unsigned char* ws = c.ws; \
    bf16_t* XB = (bf16_t*)(ws + WS_R1); float* SS = (float*)(ws + WS_SS); bf16_t* R2 = (bf16_t*)(ws + WS_R2); bf16_t* R3 = (bf16_t*)(ws + WS_R3); \
    bf16_t* R4 = (bf16_t*)(ws + WS_R4); bf16_t* R5 = (bf16_t*)(ws + WS_R5); bf16_t* WMIX = (bf16_t*)(ws + WS_WMIX); bf16_t* WOUT = (bf16_t*)(ws + WS_WMIX_OUT); \
    (void)XB; (void)SS; (void)R2; (void)R3; (void)R4; (void)R5; (void)WMIX; (void)WOUT; (void)c;

__global__ void __launch_bounds__(NTHR, 2) trunk_fwd(Args args) {
    extern __shared__ __attribute__((aligned(16))) unsigned char lds_raw[];
    LAS unsigned char* ldsp = (LAS unsigned char*)lds_raw;
    const int lo = args.ph_lo, hi = args.ph_hi;
    const int G = gridDim.x, bid = blockIdx.x;
#if !MK_PER_PHASE
    cg::grid_group grid = cg::this_grid();
#if MK_XCD_BAR
    volatile LAS unsigned* misc = (volatile LAS unsigned*)(ldsp + LDS_MISC);
    if (threadIdx.x < 16) misc[threadIdx.x] = 0u;
    __syncthreads();
    XcdBarrier xbar = xcd_barrier_post((unsigned*)(args.ws + WS_BAR), misc + 8);
    int nsync = 0;
#define SEAM() do { if (nsync == 0) grid.sync(); else xcd_barrier(xbar); ++nsync; } while (0)
#else
#define SEAM() grid.sync()
#endif
#else
#define SEAM() do {} while (0)
#endif
#define IN(k) (lo <= (k) && (k) < hi)
#define ENDPH(k) do { if (IN((k) + 1)) SEAM(); } while (0)

    float* out = args.out;
    int ph = 0;

    if (IN(ph) && EN(0)) { PH_BEGIN; convert_mixer(A, c, 0); convert_ffn(A, c, 0); prologue_rows(A, c); }
    ENDPH(ph); ++ph;

#pragma unroll 1
    for (int L = 0; L < 4; ++L) {
        const float* resid_in = (L == 0) ? args.in[0] : out;
        if (L == 0 || L == 3) {
            const int ib = (L == 0) ? 1 : 33;
            if (IN(ph)) {
                PH_BEGIN;
                if (L > 0 && EN(0)) convert_ffn(A, c, L);
                __syncthreads();
                pg8::Gemm g{XB, WMIX, M, 4352, D, D}; pg8::StaticOrder S; S.init(M, 4352, G, bid);
                pg8::EpiDN E{R2, R3, (float*)(ws + WS_AB), (bf16_t*)(ws + WS_HALO), SS};
                if (EN(1)) pg8::gemm_phase<pg8::EpiDN>(c.lds, g, S, E);
            }
            ENDPH(ph); ++ph;
            if (IN(ph) && EN(2)) { PH_BEGIN; dn_conv(A, c, A.in[ib + 2]); }
            ENDPH(ph); ++ph;
            if (IN(ph) && EN(3)) { PH_BEGIN; dn_chunk(A, c, A.in[ib + 3], A.in[ib + 4]); }
            ENDPH(ph); ++ph;
            if (IN(ph) && EN(4)) { PH_BEGIN; dn_scan(A, c); }
            ENDPH(ph); ++ph;
            if (IN(ph) && EN(5)) { PH_BEGIN; dn_post(A, c, A.in[ib + 5]); }
            ENDPH(ph); ++ph;
            if (IN(ph)) {
                PH_BEGIN;
                pg8::Gemm g{R4, WOUT, M, D, D, D}; pg8::StaticOrder S; S.init(M, D, G, bid);
                pg8::EpiResidual E{resid_in, out, XB, SS};
                if (EN(10)) pg8::gemm_phase<pg8::EpiResidual>(c.lds, g, S, E);
            }
            ENDPH(ph); ++ph;
        } else if (L == 1) {
            if (IN(ph)) {
                PH_BEGIN;
                if (EN(0)) convert_ffn(A, c, L);
                __syncthreads();
                pg8::Gemm g{XB, WMIX, M, 3072, D, D}; pg8::StaticOrder S; S.init(M, 3072, G, bid);
                pg8::EpiStore E{R2, 3072, SS, 0, 16, 1.0f / D};
                if (EN(11)) pg8::gemm_phase<pg8::EpiStore>(c.lds, g, S, E);
            }
            ENDPH(ph); ++ph;
            if (IN(ph) && EN(6)) { PH_BEGIN; sb_prep_rows(A, c, A.in[13], A.in[14]); v_transpose(c, R2, 3072, 128, 2048, (bf16_t*)(ws + WS_R1)); }
            ENDPH(ph); ++ph;
            if (IN(ph) && EN(7)) { PH_BEGIN; attn_phase<128, true>(c, R2, 3072, R2 + 1024, 3072, (const bf16_t*)(ws + WS_R1), R2, 3072); }
            ENDPH(ph); ++ph;
            if (IN(ph)) {
                PH_BEGIN;
                pg8::Gemm g{R2, WOUT, M, D, D, 3072}; pg8::StaticOrder S; S.init(M, D, G, bid);
                pg8::EpiResidual E{resid_in, out, XB, SS};
                if (EN(10)) pg8::gemm_phase<pg8::EpiResidual>(c.lds, g, S, E);
            }
            ENDPH(ph); ++ph;
        } else {
            if (IN(ph)) {
                PH_BEGIN;
                if (EN(0)) convert_ffn(A, c, L);
                __syncthreads();
                pg8::Gemm g{XB, WMIX, M, 512, D, D}; pg8::StaticOrder S; S.init(M, 512, G, bid);
                pg8::EpiMlaDown E{R5, (float*)(ws + WS_SS2), SS};
                if (EN(12)) pg8::gemm_phase<pg8::EpiMlaDown>(c.lds, g, S, E);
            }
            ENDPH(ph); ++ph;
            if (IN(ph)) {
                PH_BEGIN;
                { pg8::Gemm g{R5, (bf16_t*)(ws + WS_WMIX + 1 * MiB), M, 1536, 256, 512}; pg8::StaticOrder S; S.init(M, 1536, G, bid);
                  pg8::EpiStore E{R2, 1536, (const float*)(ws + WS_SS2), 0, 8, 1.0f / 256.0f};
                  if (EN(11)) pg8::gemm_phase<pg8::EpiStore>(c.lds, g, S, E); }
                { pg8::Gemm g{R5 + 256, (bf16_t*)(ws + WS_WMIX + 2 * MiB), M, 2048, 128, 512}; pg8::StaticOrder S; S.init(M, 2048, G, bid);
                  pg8::EpiStore E{R3, 2048, (const float*)(ws + WS_SS2), 8, 4, 1.0f / 128.0f};
                  if (EN(11)) pg8::gemm_phase<pg8::EpiStore>(c.lds, g, S, E); }
            }
            ENDPH(ph); ++ph;
            if (IN(ph) && EN(8)) { PH_BEGIN; mla_prep_rows(A, c); v_transpose(c, R3, 2048, 256, 128, (bf16_t*)(ws + WS_R1)); }
            ENDPH(ph); ++ph;
            if (IN(ph) && EN(9)) { PH_BEGIN; attn_phase<192, false>(c, R2, 1536, (const bf16_t*)(ws + WS_R2 + 48 * MiB), 1536, (const bf16_t*)(ws + WS_R1), R3, 1024); }
            ENDPH(ph); ++ph;
            if (IN(ph)) {
                PH_BEGIN;
                pg8::Gemm g{R3, WOUT, M, D, D, D}; pg8::StaticOrder S; S.init(M, D, G, bid);
                pg8::EpiResidual E{resid_in, out, XB, SS};
                if (EN(10)) pg8::gemm_phase<pg8::EpiResidual>(c.lds, g, S, E);
            }
            ENDPH(ph); ++ph;
        }
        if (IN(ph)) {
            PH_BEGIN;
            if (L < 3 && EN(0)) convert_mixer(A, c, L + 1);
            __syncthreads();
            pg8::Gemm g{XB, (bf16_t*)(ws + WS_WFFN), M, 2 * FH, D, D}; pg8::StaticOrder S; S.init(M, 2 * FH, G, bid);
            pg8::EpiSwiglu E{R2, SS};
            if (EN(13)) pg8::gemm_phase<pg8::EpiSwiglu>(c.lds, g, S, E);
        }
        ENDPH(ph); ++ph;
        if (IN(ph)) {
            PH_BEGIN;
            pg8::Gemm g{R2, (bf16_t*)(ws + WS_WFFN_DN), M, D, FH, FH}; pg8::StaticOrder S; S.init(M, D, G, bid);
            pg8::EpiResidual E{out, out, XB, SS};
            if (EN(10)) pg8::gemm_phase<pg8::EpiResidual>(c.lds, g, S, E);
        }
        ENDPH(ph); ++ph;
    }
}

extern "C" void kernel_launch(void* const* d_in, const int* in_sizes, int n_in, void* d_out, int out_size, void* d_ws, size_t ws_size, hipStream_t stream) {
    static int grid = 0;
    if (grid == 0) {
        if (n_in != 43 || out_size != M * D || ws_size < WS_END) { fprintf(stderr, "kernel_launch: unexpected shapes (n_in %d out %d ws %zu)\n", n_in, out_size, ws_size); grid = -1; return; }
        int dev = 0, cus = 0, per_cu = 0;
        hipGetDevice(&dev); hipDeviceGetAttribute(&cus, hipDeviceAttributeMultiprocessorCount, dev);
        if (hipFuncSetAttribute((const void*)trunk_fwd, hipFuncAttributeMaxDynamicSharedMemorySize, LDS_BYTES) != hipSuccess) { fprintf(stderr, "kernel_launch: hipFuncSetAttribute failed\n"); grid = -1; return; }
        if (hipOccupancyMaxActiveBlocksPerMultiprocessor(&per_cu, (const void*)trunk_fwd, NTHR, LDS_BYTES) != hipSuccess || per_cu < 1) { fprintf(stderr, "kernel_launch: occupancy query says %d\n", per_cu); per_cu = 1; }
        (void)hipGetLastError();
        grid = cus * 1;
    }
    if (grid < 0) return;
    Args a{};
    for (int i = 0; i < 43; ++i) a.in[i] = (const float*)d_in[i];
    a.out = (float*)d_out; a.ws = (unsigned char*)d_ws;
#if MK_PER_PHASE
    for (int p = 0; p < NPHASE; ++p) {
        a.ph_lo = p; a.ph_hi = p + 1;
        hipLaunchKernelGGL(trunk_fwd, dim3(grid), dim3(NTHR), LDS_BYTES, stream, a);
    }
#else
    hipMemsetAsync((char*)d_ws + WS_BAR, 0, 65536, stream);
    a.ph_lo = 0; a.ph_hi = NPHASE;
    void* kargs[] = {&a};
    hipError_t e = hipLaunchCooperativeKernel((const void*)trunk_fwd, dim3(grid), dim3(NTHR), kargs, LDS_BYTES, stream);
    if (e != hipSuccess) fprintf(stderr, "cooperative launch failed: %s (grid %d)\n", hipGetErrorString(e), grid);
#endif
}
```

```cpp
#include <hip/hip_runtime.h>
#include <hip/hip_cooperative_groups.h>
#include <cstdio>
#include <cstdint>
namespace cg = cooperative_groups;

#ifndef MK_PER_PHASE
#define MK_PER_PHASE 0
#endif
#ifndef MK_XCD_BAR
#define MK_XCD_BAR 1
#endif

#ifndef EN_MASK
#define EN_MASK 0xFFFFFFFFu
#endif
#define EN(b) ((EN_MASK >> (b)) & 1u)
#define LAS __attribute__((address_space(3)))
typedef unsigned short bf16_t;
typedef short bf16x8 __attribute__((ext_vector_type(8)));
typedef short bf16x4 __attribute__((ext_vector_type(4)));
typedef float f32x4 __attribute__((ext_vector_type(4)));
typedef float f32x2 __attribute__((ext_vector_type(2)));
typedef unsigned u32x4 __attribute__((ext_vector_type(4)));
typedef unsigned u32x2 __attribute__((ext_vector_type(2)));

constexpr int BATCH = 4, SEQ = 4096, D = 1024, M = BATCH * SEQ, FH = 2816, NH = 8;
constexpr float EPS = 1e-6f;
constexpr int NWAVES = 8, NTHR = 512;

constexpr size_t MiB = 1u << 20;
constexpr size_t WS_BAR = 0;
constexpr size_t WS_SS = 1 * MiB;
constexpr size_t WS_SS2 = 2 * MiB;
constexpr size_t WS_AB = 3 * MiB;
constexpr size_t WS_RS = 4 * MiB;
constexpr size_t WS_GC = 5 * MiB;
constexpr size_t WS_HALO = 6 * MiB;
constexpr size_t WS_WMIX = 8 * MiB;
constexpr size_t WS_WMIX_OUT = WS_WMIX + 9 * MiB;
constexpr size_t WS_WFFN = 20 * MiB;
constexpr size_t WS_WFFN_DN = WS_WFFN + 11 * MiB;
constexpr size_t WS_R1 = 40 * MiB;
constexpr size_t WS_R2 = 72 * MiB;
constexpr size_t WS_R3 = 168 * MiB;
constexpr size_t WS_R4 = 200 * MiB;
constexpr size_t WS_R5 = 232 * MiB;
constexpr size_t WS_END = 248 * MiB;

constexpr int LDS_BYTES = 147456;
constexpr int LDS_MISC = 147200;

__device__ __forceinline__ unsigned f2bf(float f) { unsigned u = __builtin_bit_cast(unsigned, f); return (u + 0x7fffu + ((u >> 16) & 1u)) >> 16; }
__device__ __forceinline__ unsigned pk2(float lo, float hi) { unsigned r; asm volatile("v_cvt_pk_bf16_f32 %0, %1, %2" : "=v"(r) : "v"(lo), "v"(hi)); return r; }
__device__ __forceinline__ float bf2f(unsigned b) { return __builtin_bit_cast(float, b << 16); }
__device__ __forceinline__ float bflo(unsigned w) { return __builtin_bit_cast(float, w << 16); }
__device__ __forceinline__ float bfhi(unsigned w) { return __builtin_bit_cast(float, w & 0xffff0000u); }
__device__ __forceinline__ float wave_sum(float v) {
#pragma unroll
    for (int o = 1; o < 64; o <<= 1) v += __shfl_xor(v, o);
    return v;
}
__device__ __forceinline__ float fexp(float x) { return __builtin_amdgcn_exp2f(x * 1.4426950408889634f); }
__device__ __forceinline__ float flog(float x) { return __builtin_amdgcn_logf(x) * 0.6931471805599453f; }
__device__ __forceinline__ float softplus_f(float z) { return fmaxf(z, 0.f) + flog(1.f + fexp(-fabsf(z))); }
__device__ __forceinline__ float silu_f(float y) { return y / (1.f + fexp(-y)); }
__device__ __forceinline__ float rowscale(const float* ss, int row, int lo, int n, float inv_dim) {
    float s = 0.f;
    for (int i = 0; i < n; i += 4) { const f32x4 v = *(const f32x4*)(ss + (size_t)row * 16 + lo + i); s += (v[0] + v[1]) + (v[2] + v[3]); }
    return 1.0f / sqrtf(s * inv_dim + EPS);
}

namespace pg8 {
#define PG8_LAS __attribute__((address_space(3)))
constexpr int BM = 256, BK = 64, HALF = 128, HTB = HALF * BK * 2, STAGE_BYTES = 8 * HTB, NXCD = 8, WGM = 8;
__host__ __device__ __forceinline__ int lds_byte(int r, int c) { const int st = (r >> 4) * 2 + (c >> 5), rr = r & 15, cc = c & 31, ob = rr * 64 + cc * 2; return st * 1024 + (ob ^ (((ob >> 9) & 1) << 5)); }
__host__ __device__ __forceinline__ void stage_rc(int b, int& R, int& C) { const int st = b / 1024, sb = b % 1024, swz = sb ^ (((sb >> 9) & 1) << 5); R = (st >> 1) * 16 + swz / 64; C = (st & 1) * 32 + (swz % 64) / 2; }
__host__ __device__ __forceinline__ int perm32(int rho) { const int n = rho >> 4, i = rho & 15; return 8 * (i >> 2) + 4 * n + (i & 3); }
struct Unit { int pm, pn; };
struct Gemm { const bf16_t* A; const bf16_t* Bt; int M, N, K, lda; };
struct StaticOrder {
    int nM, nN, nwg, G, c;
    __host__ __device__ void init(int M_, int N_, int G_, int c_) { nM = M_ / BM; nN = N_ / BM; nwg = nM * nN; G = G_; c = c_; }
    __host__ __device__ bool next(int i, Unit& u) const {
        const long L = (long)i * G + c; if (L >= nwg) return false;
        int wgid = (int)L; { const int q = nwg / NXCD, r = nwg % NXCD, xcd = wgid % NXCD, off = wgid / NXCD; wgid = (xcd < r ? xcd * (q + 1) : r * (q + 1) + (xcd - r) * q) + off; }
        const int nig = WGM * nN, gid = wgid / nig, fm = gid * WGM, gsz = (nM - fm) < WGM ? (nM - fm) : WGM;
        u.pm = fm + ((wgid % nig) % gsz); u.pn = (wgid % nig) / gsz; return true;
    }
};
template <class Epi, bool ALIGN_EPI = true>
__device__ __forceinline__ void gemm_phase(PG8_LAS unsigned char* lds, const Gemm g, const StaticOrder& S, const Epi& E) {
    int tid_ = threadIdx.x; asm volatile("" : "+v"(tid_));
    const int tid = tid_, wid = __builtin_amdgcn_readfirstlane(tid >> 6), lane = tid & 63, wr = wid >> 2, wc = wid & 3, fr = lane & 15, fq = lane >> 4;
    const int K = g.K, nt = K / BK, lda = g.lda;
    unsigned voffA[2], voffB[2];
#pragma unroll
    for (int i = 0; i < 2; ++i) { int R, C; stage_rc(tid * 16 + i * 8192, R, C); const int Rb = Epi::PERM ? ((R & ~31) + perm32(R & 31)) : R;
        voffA[i] = (unsigned)(R * lda + C) * 2u; voffB[i] = (unsigned)(Rb * K + C) * 2u; }
    const size_t kstep = (size_t)(BK * 2);
    const size_t hstepA = (size_t)HALF * lda * 2, hstepB = (size_t)HALF * K * 2;
    const size_t tstepA = 2 * hstepA, tstepB = 2 * hstepB;
    const unsigned ldsw = (unsigned)wid * 1024u;
    const int aoff = lds_byte(wr * 64 + fr, fq * 8), boff = lds_byte(wc * 32 + fr, fq * 8);
#define PG8_SA(b, h) (((b) * 2 + (h)) * HTB)
#define PG8_SB(b, h) ((4 + (b) * 2 + (h)) * HTB)
#define PG8_STAGE(bufoff, gbase, voff) do { _Pragma("unroll") for (int _i = 0; _i < 2; ++_i) \
        __builtin_amdgcn_global_load_lds((const unsigned*)((const char*)(gbase) + (voff)[_i]), (PG8_LAS unsigned*)(lds + (bufoff) + ldsw + _i * 8192), 16, 0, 0); } while (0)
#define PG8_LDA(dst, b, h) do { _Pragma("unroll") for (int m = 0; m < 4; ++m) _Pragma("unroll") for (int k = 0; k < 2; ++k) dst[m][k] = *(const PG8_LAS bf16x8*)(lds + PG8_SA(b, h) + aoff + m * 2048 + k * 1024); } while (0)
#define PG8_LDB(dst, b, h) do { _Pragma("unroll") for (int n = 0; n < 2; ++n) _Pragma("unroll") for (int k = 0; k < 2; ++k) dst[n][k] = *(const PG8_LAS bf16x8*)(lds + PG8_SB(b, h) + boff + n * 2048 + k * 1024); } while (0)
#define PG8_MMA(ai, bj, At, Bt) do { __builtin_amdgcn_s_setprio(1); _Pragma("unroll") for (int m = 0; m < 4; ++m) _Pragma("unroll") for (int n = 0; n < 2; ++n) _Pragma("unroll") for (int k = 0; k < 2; ++k) \
        acc[ai][bj][m][n] = __builtin_amdgcn_mfma_f32_16x16x32_bf16(Bt[n][k], At[m][k], acc[ai][bj][m][n], 0, 0, 0); __builtin_amdgcn_s_setprio(0); } while (0)
#define PG8_WAIT_V(n) asm volatile("s_waitcnt vmcnt(" #n ")" ::: "memory")
#define PG8_WAIT_L(n) asm volatile("s_waitcnt lgkmcnt(" #n ")" ::: "memory")
#define PG8_BAR __builtin_amdgcn_s_barrier()
#define PG8_SCHED __builtin_amdgcn_sched_barrier(0)
    Unit cur, nxt; int ui = 0;
    if (!S.next(0, cur)) return;
    f32x4 acc[2][2][4][2];
#pragma unroll
    for (int a = 0; a < 2; ++a)
#pragma unroll
        for (int b = 0; b < 2; ++b)
#pragma unroll
            for (int m = 0; m < 4; ++m)
#pragma unroll
                for (int n = 0; n < 2; ++n) acc[a][b][m][n] = (f32x4){0.f, 0.f, 0.f, 0.f};
    bf16x8 At[4][2], B0[2][2], B1[2][2];
    const char* cA = (const char*)g.A + (size_t)cur.pm * tstepA; const char* cB = (const char*)g.Bt + (size_t)cur.pn * tstepB;
    PG8_STAGE(PG8_SB(0, 0), cB, voffB); PG8_STAGE(PG8_SB(0, 1), cB + hstepB, voffB); PG8_STAGE(PG8_SA(0, 0), cA, voffA); PG8_STAGE(PG8_SA(0, 1), cA + hstepA, voffA);
    if (wr == 1) PG8_BAR;
    PG8_WAIT_V(2); PG8_BAR;
    PG8_STAGE(PG8_SB(1, 0), cB + kstep, voffB); PG8_STAGE(PG8_SA(1, 0), cA + kstep, voffA); PG8_STAGE(PG8_SB(1, 1), cB + hstepB + kstep, voffB);
    PG8_WAIT_V(6); PG8_BAR;
    for (;;) {
        const bool has_next = S.next(ui + 1, nxt);
        const char* nA = has_next ? (const char*)g.A + (size_t)nxt.pm * tstepA : cA; const char* nB = has_next ? (const char*)g.Bt + (size_t)nxt.pn * tstepB : cB;
        for (int t = 0; t < nt; t += 2) {
            const bool last = (t == nt - 2);
            const char* a1 = cA + (size_t)(t + 1) * kstep;
            const char* a2 = last ? nA : cA + (size_t)(t + 2) * kstep; const char* b2 = last ? nB : cB + (size_t)(t + 2) * kstep;
            const char* a3 = a2 + kstep; const char* b3 = b2 + kstep;
            PG8_LDB(B0, 0, 0); PG8_LDB(B1, 0, 1); PG8_SCHED; PG8_LDA(At, 0, 0); PG8_STAGE(PG8_SA(1, 1), a1 + hstepA, voffA);
            PG8_WAIT_V(8); PG8_WAIT_L(0); PG8_BAR; PG8_MMA(0, 0, At, B0); PG8_MMA(0, 1, At, B1); PG8_BAR; PG8_SCHED;
            PG8_LDA(At, 0, 1); PG8_STAGE(PG8_SB(0, 0), b2, voffB); PG8_STAGE(PG8_SB(0, 1), b2 + hstepB, voffB); PG8_STAGE(PG8_SA(0, 0), a2, voffA);
            PG8_WAIT_V(8); PG8_WAIT_L(0); PG8_BAR; PG8_MMA(1, 0, At, B0); PG8_MMA(1, 1, At, B1); PG8_BAR; PG8_SCHED;
            PG8_LDB(B0, 1, 0); PG8_LDB(B1, 1, 1); PG8_SCHED; PG8_LDA(At, 1, 0); PG8_STAGE(PG8_SA(0, 1), a2 + hstepA, voffA);
            PG8_WAIT_V(8); PG8_WAIT_L(0); PG8_BAR; PG8_MMA(0, 0, At, B0); PG8_MMA(0, 1, At, B1); PG8_BAR; PG8_SCHED;
            PG8_LDA(At, 1, 1); PG8_STAGE(PG8_SB(1, 0), b3, voffB); PG8_STAGE(PG8_SB(1, 1), b3 + hstepB, voffB); PG8_STAGE(PG8_SA(1, 0), a3, voffA);
            PG8_WAIT_V(8); PG8_WAIT_L(0); PG8_BAR; PG8_MMA(1, 0, At, B0); PG8_MMA(1, 1, At, B1); PG8_BAR; PG8_SCHED;
        }
        if constexpr (ALIGN_EPI) { if (wr == 0) PG8_BAR; }
        E(acc, cur, wr, wc, fr, fq);
        if (!has_next) break;
#pragma unroll
        for (int a = 0; a < 2; ++a)
#pragma unroll
            for (int b = 0; b < 2; ++b)
#pragma unroll
                for (int m = 0; m < 4; ++m)
#pragma unroll
                    for (int n = 0; n < 2; ++n) acc[a][b][m][n] = (f32x4){0.f, 0.f, 0.f, 0.f};
        cur = nxt; cA = nA; cB = nB; ++ui;
        if constexpr (ALIGN_EPI) { if (wr == 1) PG8_BAR; }
    }
    PG8_WAIT_V(0);
    if constexpr (!ALIGN_EPI) { if (wr == 0) PG8_BAR; }
    PG8_BAR;
#undef PG8_SA
#undef PG8_SB
#undef PG8_STAGE
#undef PG8_LDA
#undef PG8_LDB
#undef PG8_MMA
#undef PG8_WAIT_V
#undef PG8_WAIT_L
#undef PG8_BAR
#undef PG8_SCHED
}

struct EpiStore {
    static constexpr bool PERM = true;
    bf16_t* O; int ldc; const float* ss; int ss_lo, ss_n; float inv_dim;
    __device__ __forceinline__ void operator()(const f32x4 (&acc)[2][2][4][2], const Unit& u, int wr, int wc, int fr, int fq) const {
#pragma unroll
        for (int ai = 0; ai < 2; ++ai)
#pragma unroll
            for (int m = 0; m < 4; ++m) {
                const int row = u.pm * BM + ai * HALF + wr * 64 + m * 16 + fr;
                const float sc = ss ? rowscale(ss, row, ss_lo, ss_n, inv_dim) : 1.f;
#pragma unroll
                for (int bj = 0; bj < 2; ++bj) {
                    const int col = u.pn * BM + bj * HALF + wc * 32 + 8 * fq;
                    const f32x4 v0 = acc[ai][bj][m][0] * sc, v1 = acc[ai][bj][m][1] * sc;
                    u32x4 w; w.x = pk2(v0[0], v0[1]); w.y = pk2(v0[2], v0[3]); w.z = pk2(v1[0], v1[1]); w.w = pk2(v1[2], v1[3]);
                    *(u32x4*)(O + (size_t)row * ldc + col) = w;
                }
                asm volatile("" ::: "memory");
            }
    }
};
struct EpiDN {
    static constexpr bool PERM = true;
    bf16_t* QKV; bf16_t* Z; float* AB; bf16_t* HALO; const float* ss;
    __device__ __forceinline__ void operator()(const f32x4 (&acc)[2][2][4][2], const Unit& u, int wr, int wc, int fr, int fq) const {
#pragma unroll
        for (int ai = 0; ai < 2; ++ai)
#pragma unroll
            for (int m = 0; m < 4; ++m) {
                const int row = u.pm * BM + ai * HALF + wr * 64 + m * 16 + fr;
                const float sc = rowscale(ss, row, 0, 16, 1.0f / D);
#pragma unroll
                for (int bj = 0; bj < 2; ++bj) {
                    const int col = u.pn * BM + bj * HALF + wc * 32 + 8 * fq;
                    const f32x4 v0 = acc[ai][bj][m][0] * sc, v1 = acc[ai][bj][m][1] * sc;
                    u32x4 w; w.x = pk2(v0[0], v0[1]); w.y = pk2(v0[2], v0[3]); w.z = pk2(v1[0], v1[1]); w.w = pk2(v1[2], v1[3]);
                    if (u.pn < 12) {
                        *(u32x4*)(QKV + (size_t)row * 3072 + col) = w;
                        const int rl = row & 255;
                        if (rl >= 253 && u.pm + 1 < 64) *(u32x4*)(HALO + ((size_t)(u.pm + 1) * 3 + (rl - 253)) * 3072 + col) = w;
                    } else if (u.pn < 16) {
                        *(u32x4*)(Z + (size_t)row * 1024 + (col - 3072)) = w;
                    } else if (bj == 0 && wc == 0 && fq < 2) {
                        *(f32x4*)(AB + (size_t)row * 16 + 8 * fq) = v0; *(f32x4*)(AB + (size_t)row * 16 + 8 * fq + 4) = v1;
                    }
                }
                asm volatile("" ::: "memory");
            }
    }
};
struct EpiSwiglu {
    static constexpr bool PERM = true;
    bf16_t* H; const float* ss;
    __device__ __forceinline__ void operator()(const f32x4 (&acc)[2][2][4][2], const Unit& u, int wr, int wc, int fr, int fq) const {
#pragma unroll
        for (int ai = 0; ai < 2; ++ai)
#pragma unroll
            for (int m = 0; m < 4; ++m) {
                const int row = u.pm * BM + ai * HALF + wr * 64 + m * 16 + fr;
                const float sc = rowscale(ss, row, 0, 16, 1.0f / D);
                const int col = u.pn * HALF + wc * 32 + 8 * fq;
                float h[8];
#pragma unroll
                for (int n = 0; n < 2; ++n)
#pragma unroll
                    for (int i = 0; i < 4; ++i) { const float gt = acc[ai][0][m][n][i] * sc, up = acc[ai][1][m][n][i] * sc; h[4 * n + i] = silu_f(gt) * up; }
                u32x4 w; w.x = pk2(h[0], h[1]); w.y = pk2(h[2], h[3]); w.z = pk2(h[4], h[5]); w.w = pk2(h[6], h[7]);
                *(u32x4*)(H + (size_t)row * FH + col) = w;
                asm volatile("" ::: "memory");
            }
    }
};
struct EpiResidual {
    static constexpr bool PERM = false;
    const float* base; float* out; bf16_t* xb; float* ss;
    __device__ __forceinline__ void operator()(const f32x4 (&acc)[2][2][4][2], const Unit& u, int wr, int wc, int fr, int fq) const {
#pragma unroll
        for (int ai = 0; ai < 2; ++ai)
#pragma unroll
            for (int m = 0; m < 4; ++m) {
                const int row = u.pm * BM + ai * HALF + wr * 64 + m * 16 + fr;
                float s = 0.f;
#pragma unroll
                for (int bj = 0; bj < 2; ++bj)
#pragma unroll
                    for (int n = 0; n < 2; ++n) {
                        const int col = u.pn * BM + bj * HALF + wc * 32 + n * 16 + 4 * fq;
                        const size_t off = (size_t)row * D + col;
                        const f32x4 v = *(const f32x4*)(base + off) + acc[ai][bj][m][n];
                        *(f32x4*)(out + off) = v;
                        u32x2 w; w.x = pk2(v[0], v[1]); w.y = pk2(v[2], v[3]);
                        *(u32x2*)(xb + off) = w;
                        s += (v[0] * v[0] + v[1] * v[1]) + (v[2] * v[2] + v[3] * v[3]);
                    }
                s += __shfl_xor(s, 16); s += __shfl_xor(s, 32);
                if (fq == 0) ss[(size_t)row * 16 + u.pn * 4 + wc] = s;
                asm volatile("" ::: "memory");
            }
    }
};
struct EpiMlaDown {
    static constexpr bool PERM = true;
    bf16_t* C; float* ss2; const float* ss;
    __device__ __forceinline__ void operator()(const f32x4 (&acc)[2][2][4][2], const Unit& u, int wr, int wc, int fr, int fq) const {
#pragma unroll
        for (int ai = 0; ai < 2; ++ai)
#pragma unroll
            for (int m = 0; m < 4; ++m) {
                const int row = u.pm * BM + ai * HALF + wr * 64 + m * 16 + fr;
                const float sc = rowscale(ss, row, 0, 16, 1.0f / D);
#pragma unroll
                for (int bj = 0; bj < 2; ++bj) {
                    const int col = u.pn * BM + bj * HALF + wc * 32 + 8 * fq;
                    const f32x4 v0 = acc[ai][bj][m][0] * sc, v1 = acc[ai][bj][m][1] * sc;
                    u32x4 w; w.x = pk2(v0[0], v0[1]); w.y = pk2(v0[2], v0[3]); w.z = pk2(v1[0], v1[1]); w.w = pk2(v1[2], v1[3]);
                    *(u32x4*)(C + (size_t)row * 512 + col) = w;
                    float s = (v0[0] * v0[0] + v0[1] * v0[1]) + (v0[2] * v0[2] + v0[3] * v0[3]) + (v1[0] * v1[0] + v1[1] * v1[1]) + (v1[2] * v1[2] + v1[3] * v1[3]);
                    s += __shfl_xor(s, 16); s += __shfl_xor(s, 32);
                    if (fq == 0) ss2[(size_t)row * 16 + u.pn * 8 + bj * 4 + wc] = s;
                }
                asm volatile("" ::: "memory");
            }
    }
};
}

#define XB_TMO      128
#define XB_XCNT(j)  (256  + 64 * (j))
#define XB_XSUB(j)  (1280 + 64 * (j))
#define XB_XGEN(j)  (2304 + 64 * (j))
#define XB_TOP      3328
#define XB_TOPGEN   3392
#define XCD_BAR_WORDS 3456
#define XB_SPIN_CAP (1u << 20)
__device__ __forceinline__ unsigned xb_ld(unsigned* p)              { return __hip_atomic_load(p, __ATOMIC_RELAXED, __HIP_MEMORY_SCOPE_AGENT); }
__device__ __forceinline__ unsigned xb_add(unsigned* p, unsigned v) { return __hip_atomic_fetch_add(p, v, __ATOMIC_RELAXED, __HIP_MEMORY_SCOPE_AGENT); }
__device__ __forceinline__ unsigned xb_xcc_id() { return (unsigned)__builtin_amdgcn_s_getreg((3 << 11) | 20) & 0xFu; }
#define XB_SPIN(cond, bar) do { unsigned _sp = 0; while (cond) { __builtin_amdgcn_s_sleep(1); \
    if ((++_sp & 255u) == 0u) { if (xb_ld(&(bar)[XB_TMO])) break; if (_sp > XB_SPIN_CAP) { atomicAdd(&(bar)[XB_TMO], 1u); break; } } } } while (0)
struct XcdBarrier { unsigned* bar; unsigned x; volatile LAS unsigned* st; };
__device__ __forceinline__ XcdBarrier xcd_barrier_post(unsigned* bar, volatile LAS unsigned* st) {
    XcdBarrier b; b.bar = bar; b.x = xb_xcc_id(); b.st = st;
    if (threadIdx.x == 0) (void)xb_add(&bar[XB_XCNT(b.x)], 1u);
    return b;
}
__device__ __forceinline__ void xcd_barrier_complete(unsigned* bar, unsigned x, unsigned& nloc, unsigned& nx) {
    const unsigned G = gridDim.x * gridDim.y * gridDim.z;
    unsigned sum, cnt, mine, sp = 0u;
    for (;;) {
        sum = 0u; cnt = 0u; mine = 0u;
#pragma unroll
        for (unsigned j = 0; j < 16; ++j) { const unsigned c = xb_ld(&bar[XB_XCNT(j)]); sum += c; cnt += (c > 0u) ? 1u : 0u; mine = (j == x) ? c : mine; }
        if (sum == G) break;
        __builtin_amdgcn_s_sleep(1);
        if ((++sp & 255u) == 0u) { if (xb_ld(&bar[XB_TMO])) break; if (sp > XB_SPIN_CAP) { atomicAdd(&bar[XB_TMO], 1u); break; } }
    }
    nloc = mine > 0u ? mine : 1u; nx = cnt > 0u ? cnt : 1u;
}
__device__ __forceinline__ void xcd_barrier(const XcdBarrier& b) {
    asm volatile("s_waitcnt vmcnt(0)" ::: "memory");
    __syncthreads();
    if (threadIdx.x == 0) {
        unsigned* bar = b.bar;
        __builtin_amdgcn_s_waitcnt(0);
        unsigned nloc = b.st[0], nx = b.st[1];
        if (nloc == 0u) { xcd_barrier_complete(bar, b.x, nloc, nx); b.st[0] = nloc; b.st[1] = nx; }
        const unsigned old = xb_add(&bar[XB_XSUB(b.x)], 1u);
        const unsigned gen = old / nloc;
        if (old + 1u == (gen + 1u) * nloc) {
            __builtin_amdgcn_fence(__ATOMIC_RELEASE, "agent");
            asm volatile("s_waitcnt vmcnt(0)" ::: "memory");
            const unsigned og = xb_add(&bar[XB_TOP], 1u);
            const unsigned tg = og / nx;
            if (og + 1u == (tg + 1u) * nx) xb_add(&bar[XB_TOPGEN], 1u);
            else XB_SPIN(xb_ld(&bar[XB_TOPGEN]) == tg, bar);
            __builtin_amdgcn_fence(__ATOMIC_ACQUIRE, "agent");
            xb_add(&bar[XB_XGEN(b.x)], 1u);
            asm volatile("s_waitcnt vmcnt(0)" ::: "memory");
        } else {
            XB_SPIN(xb_ld(&bar[XB_XGEN(b.x)]) == gen, bar);
            __builtin_amdgcn_fence(__ATOMIC_ACQUIRE, "agent");
            asm volatile("s_waitcnt vmcnt(0)" ::: "memory");
        }
    }
    __syncthreads();
}

__device__ __forceinline__ void cvt_item(const float* W, int K, int N, bf16_t* WT, const float* gain, int swiglu, LAS float* scr, int item, int lane) {
    const int nblk = (N + 31) / 32, kb = item / nblk, nb = item % nblk, k0 = 64 * kb, n0 = 32 * nb;
    const int nn = n0 + (lane & 31);
#pragma unroll 8
    for (int i = 0; i < 32; ++i) { const int kk = 2 * i + (lane >> 5);
        float v = (nn < N) ? W[(size_t)(k0 + kk) * N + nn] : 0.f;
        if (gain) v *= gain[k0 + kk];
        scr[kk * 33 + (lane & 31)] = v; }
    asm volatile("s_waitcnt lgkmcnt(0)" ::: "memory");
    const int c = lane & 7;
#pragma unroll
    for (int j = 0; j < 4; ++j) { const int n = (lane >> 3) + 8 * j; const LAS float* s = scr + (8 * c) * 33 + n;
        u32x4 o; o.x = pk2(s[0 * 33], s[1 * 33]); o.y = pk2(s[2 * 33], s[3 * 33]); o.z = pk2(s[4 * 33], s[5 * 33]); o.w = pk2(s[6 * 33], s[7 * 33]);
        int dn = n0 + n;
        if (swiglu) { const int isup = dn >= FH; const int jj = isup ? dn - FH : dn; dn = (jj >> 7) * 256 + isup * 128 + (jj & 127); }
        *(u32x4*)(WT + (size_t)dn * K + k0 + 8 * c) = o; }
    asm volatile("s_waitcnt lgkmcnt(0)" ::: "memory");
}
__device__ __forceinline__ void cvt_weight(const float* W, int K, int N, int Npad, bf16_t* WT, const float* gain, int swiglu, LAS unsigned char* lds, int gw, int ngw, int wave, int lane) {
    LAS float* scr = (LAS float*)(lds + wave * 8704);
    const int nblk = (N + 31) / 32, nitems = (K / 64) * nblk;
    for (int it = gw; it < nitems; it += ngw) cvt_item(W, K, N, WT, gain, swiglu, scr, it, lane);
    const int zr0 = nblk * 32; const int nz = (Npad - zr0) * (K / 8);
    unsigned z0 = 0u; asm volatile("" : "+v"(z0));
    for (int i = gw * 64 + lane; i < nz; i += ngw * 64) *(u32x4*)(WT + (size_t)zr0 * K + (size_t)i * 8) = (u32x4){z0, z0, z0, z0};
}

struct Args { const float* in[43]; float* out; unsigned char* ws; int ph_lo, ph_hi; };

struct Ctx {
    LAS unsigned char* lds; unsigned char* ws; int tid, lane, wave, gw, ngw;
};

__device__ __forceinline__ void convert_mixer(const Args& a, const Ctx& c, int L) {
    unsigned char* ws = c.ws;
    if (L == 0 || L == 3) {
        const int b = (L == 0) ? 1 : 33;
        cvt_weight(a.in[b + 1], D, 4112, 4352, (bf16_t*)(ws + WS_WMIX), a.in[b], 0, c.lds, c.gw, c.ngw, c.wave, c.lane);
        cvt_weight(a.in[b + 6], D, D, D, (bf16_t*)(ws + WS_WMIX_OUT), nullptr, 0, c.lds, c.gw, c.ngw, c.wave, c.lane);
    } else if (L == 1) {
        cvt_weight(a.in[12], D, 3072, 3072, (bf16_t*)(ws + WS_WMIX), a.in[11], 0, c.lds, c.gw, c.ngw, c.wave, c.lane);
        cvt_weight(a.in[15], D, D, D, (bf16_t*)(ws + WS_WMIX_OUT), nullptr, 0, c.lds, c.gw, c.ngw, c.wave, c.lane);
    } else {
        cvt_weight(a.in[20], D, 448, 512, (bf16_t*)(ws + WS_WMIX), a.in[19], 0, c.lds, c.gw, c.ngw, c.wave, c.lane);
        cvt_weight(a.in[23], 256, 1536, 1536, (bf16_t*)(ws + WS_WMIX + 1 * MiB), a.in[21], 0, c.lds, c.gw, c.ngw, c.wave, c.lane);
        cvt_weight(a.in[24], 128, 2048, 2048, (bf16_t*)(ws + WS_WMIX + 2 * MiB), a.in[22], 0, c.lds, c.gw, c.ngw, c.wave, c.lane);
        cvt_weight(a.in[29], D, D, D, (bf16_t*)(ws + WS_WMIX_OUT), nullptr, 0, c.lds, c.gw, c.ngw, c.wave, c.lane);
    }
}
__device__ __forceinline__ void convert_ffn(const Args& a, const Ctx& c, int L) {
    const int b = (L == 0) ? 8 : (L == 1) ? 16 : (L == 2) ? 30 : 40;
    cvt_weight(a.in[b + 1], D, 2 * FH, 2 * FH, (bf16_t*)(c.ws + WS_WFFN), a.in[b], 1, c.lds, c.gw, c.ngw, c.wave, c.lane);
    cvt_weight(a.in[b + 2], FH, D, D, (bf16_t*)(c.ws + WS_WFFN_DN), nullptr, 0, c.lds, c.gw, c.ngw, c.wave, c.lane);
}

__device__ __forceinline__ void prologue_rows(const Args& a, const Ctx& c) {
    const float* x = a.in[0]; bf16_t* xb = (bf16_t*)(c.ws + WS_R1); float* ss = (float*)(c.ws + WS_SS);
    for (int m = c.gw; m < M; m += c.ngw) {
        const f32x4* xr = (const f32x4*)(x + (size_t)m * D) + c.lane;
        f32x4 v[4]; float s = 0.f;
#pragma unroll
        for (int j = 0; j < 4; ++j) { v[j] = xr[64 * j]; s += (v[j][0] * v[j][0] + v[j][1] * v[j][1]) + (v[j][2] * v[j][2] + v[j][3] * v[j][3]); }
        s = wave_sum(s);
        u32x2* o = (u32x2*)(xb + (size_t)m * D) + c.lane;
#pragma unroll
        for (int j = 0; j < 4; ++j) { u32x2 w; w.x = pk2(v[j][0], v[j][1]); w.y = pk2(v[j][2], v[j][3]); o[64 * j] = w; }
        if (c.lane < 16) ss[(size_t)m * 16 + c.lane] = (c.lane == 0) ? s : 0.f;
    }
}

__device__ __forceinline__ void dn_conv(const Args& a, const Ctx& c, const float* conv_w) {
    bf16_t* QKV = (bf16_t*)(c.ws + WS_R2); const bf16_t* HALO = (const bf16_t*)(c.ws + WS_HALO); float* RS = (float*)(c.ws + WS_RS);
    const int cg8 = c.tid & 15, seg = c.tid >> 4;
    for (int item = blockIdx.x; item < 64 * 24; item += gridDim.x) {
        const int pm = item / 24, slab = item % 24, which = slab >> 3, h = slab & 7;
        const int gcol = slab * 128 + cg8 * 8; const int row0 = pm * 256 + seg * 8;
        u32x4 raw[11];
#pragma unroll
        for (int i = 0; i < 3; ++i) {
            if (seg == 0) { raw[i] = ((pm & 15) == 0) ? (u32x4){0u, 0u, 0u, 0u} : *(const u32x4*)(HALO + ((size_t)pm * 3 + i) * 3072 + gcol); }
            else raw[i] = *(const u32x4*)(QKV + (size_t)(row0 - 3 + i) * 3072 + gcol);
        }
#pragma unroll
        for (int i = 0; i < 8; ++i) raw[3 + i] = *(const u32x4*)(QKV + (size_t)(row0 + i) * 3072 + gcol);
        float w[4][8];
#pragma unroll
        for (int j = 0; j < 4; ++j) { const f32x4 w0 = *(const f32x4*)(conv_w + j * 3072 + gcol), w1 = *(const f32x4*)(conv_w + j * 3072 + gcol + 4);
#pragma unroll
            for (int e = 0; e < 4; ++e) { w[j][e] = w0[e]; w[j][4 + e] = w1[e]; } }
        __syncthreads();
#pragma unroll
        for (int r = 0; r < 8; ++r) {
            u32x4 o; float ssq = 0.f;
#pragma unroll
            for (int e2 = 0; e2 < 4; ++e2) {
                float y0 = 0.f, y1 = 0.f;
#pragma unroll
                for (int j = 0; j < 4; ++j) { const unsigned wv = raw[r + j][e2]; y0 += w[j][2 * e2] * bflo(wv); y1 += w[j][2 * e2 + 1] * bfhi(wv); }
                const unsigned pk = pk2(silu_f(y0), silu_f(y1)); o[e2] = pk;
                const float s0 = bflo(pk), s1 = bfhi(pk); ssq += s0 * s0 + s1 * s1;
            }
            *(u32x4*)(QKV + (size_t)(row0 + r) * 3072 + gcol) = o;
            if (which < 2) {
                ssq += __shfl_xor(ssq, 1); ssq += __shfl_xor(ssq, 2); ssq += __shfl_xor(ssq, 4); ssq += __shfl_xor(ssq, 8);
                if (cg8 == 0) RS[(size_t)(row0 + r) * 16 + which * 8 + h] = (1.0f / sqrtf(ssq + EPS)) * (which == 0 ? 0.08838834764831845f : 1.f);
            }
        }
        __syncthreads();
    }
}

constexpr int DB_LM = 0, DB_GC = 17408, DB_BETA = 17664, DB_KB = 17920, DB_QB = 35328, DB_K32 = 52736, DB_V32 = 86528;
__device__ __forceinline__ void dn_chunk(const Args& a, const Ctx& c, const float* a_log, const float* dt_bias) {
    bf16_t* QKV = (bf16_t*)(c.ws + WS_R2); bf16_t* KT = (bf16_t*)(c.ws + WS_R1); bf16_t* ATT = (bf16_t*)(c.ws + WS_R5);
    const float* AB = (const float*)(c.ws + WS_AB); const float* RS = (const float*)(c.ws + WS_RS); float* GC = (float*)(c.ws + WS_GC);
    LAS bf16_t* kb = (LAS bf16_t*)(c.lds + DB_KB); LAS bf16_t* qb = (LAS bf16_t*)(c.lds + DB_QB);
    LAS float* K32 = (LAS float*)(c.lds + DB_K32); LAS float* V32 = (LAS float*)(c.lds + DB_V32); LAS float* Lm = (LAS float*)(c.lds + DB_LM);
    LAS float* gcs = (LAS float*)(c.lds + DB_GC); LAS float* betas = (LAS float*)(c.lds + DB_BETA);
    const int lane = c.lane, wave = c.wave, quad = lane >> 4, l15 = lane & 15;
    for (int item = blockIdx.x; item < BATCH * 64 * NH; item += gridDim.x) {
        const int h = item & 7, n = (item >> 3) & 63, b = item >> 9;
        const int t0 = b * SEQ + n * 64;
        if (wave == 0) {
            const float av = AB[(size_t)(t0 + lane) * 16 + h], bl = AB[(size_t)(t0 + lane) * 16 + 8 + h];
            float g = -fexp(a_log[h]) * softplus_f(av + dt_bias[h]);
#pragma unroll
            for (int o = 1; o < 64; o <<= 1) { const float t = __shfl_up(g, o); if (lane >= o) g += t; }
            gcs[lane] = g; betas[lane] = 1.f / (1.f + fexp(-bl));
            GC[(size_t)(t0 + lane) * 8 + h] = g;
        }
        __syncthreads();
        {
            const int r = c.tid >> 3, cc = (c.tid & 7) * 16;
            const size_t rowoff = (size_t)(t0 + r) * 3072 + h * 128 + cc;
            const float rsq = RS[(size_t)(t0 + r) * 16 + h], rsk = RS[(size_t)(t0 + r) * 16 + 8 + h];
            const float be = betas[r], eg = fexp(gcs[r]);
            u32x4 qw[2], kw[2], vw[2];
#pragma unroll
            for (int i = 0; i < 2; ++i) { qw[i] = *(const u32x4*)(QKV + rowoff + 8 * i); kw[i] = *(const u32x4*)(QKV + rowoff + 1024 + 8 * i); vw[i] = *(const u32x4*)(QKV + rowoff + 2048 + 8 * i); }
#pragma unroll
            for (int i = 0; i < 2; ++i) {
                u32x4 qo, ko;
#pragma unroll
                for (int j = 0; j < 4; ++j) {
                    const float q0 = bflo(qw[i][j]) * rsq, q1 = bfhi(qw[i][j]) * rsq;
                    const float k0 = bflo(kw[i][j]) * rsk, k1 = bfhi(kw[i][j]) * rsk;
                    const float v0 = bflo(vw[i][j]), v1 = bfhi(vw[i][j]);
                    qo[j] = pk2(q0, q1); ko[j] = pk2(k0, k1);
                    const int cidx = cc + 8 * i + 2 * j;
                    K32[r * 132 + cidx] = k0 * be * eg; K32[r * 132 + cidx + 1] = k1 * be * eg;
                    V32[r * 132 + cidx] = v0 * be; V32[r * 132 + cidx + 1] = v1 * be;
                }
                *(LAS u32x4*)(qb + r * 136 + cc + 8 * i) = qo; *(LAS u32x4*)(kb + r * 136 + cc + 8 * i) = ko;
            }
        }
        __syncthreads();
        {
            const int wm = wave & 3; const LAS bf16_t* Asrc = (wave < 4) ? kb : qb;
            f32x4 acc[4];
#pragma unroll
            for (int nt = 0; nt < 4; ++nt) acc[nt] = (f32x4){0.f, 0.f, 0.f, 0.f};
#pragma unroll
            for (int ks = 0; ks < 4; ++ks) {
                const bf16x8 af = *(const LAS bf16x8*)(Asrc + (16 * wm + l15) * 136 + 32 * ks + 8 * quad);
#pragma unroll
                for (int nt = 0; nt < 4; ++nt) {
                    const bf16x8 bfr = *(const LAS bf16x8*)(kb + (16 * nt + l15) * 136 + 32 * ks + 8 * quad);
                    acc[nt] = __builtin_amdgcn_mfma_f32_16x16x32_bf16(af, bfr, acc[nt], 0, 0, 0);
                }
            }
            bf16_t* att = ATT + (size_t)((b * NH + h) * 64 + n) * 4096;
#pragma unroll
            for (int nt = 0; nt < 4; ++nt)
#pragma unroll
                for (int r = 0; r < 4; ++r) {
                    const int cr = 16 * wm + 4 * quad + r, cs = 16 * nt + l15;
                    const float dec = fexp(fminf(gcs[cr] - gcs[cs], 0.f));
                    if (wave < 4) Lm[cr * 68 + cs] = (cr > cs) ? betas[cr] * acc[nt][r] * dec : 0.f;
                    else att[cr * 64 + cs] = (bf16_t)f2bf((cr >= cs) ? acc[nt][r] * dec : 0.f);
                }
        }
        __syncthreads();
        if (wave < 4) {
            const int j = wave * 64 + lane;
            const LAS float* rhs = (j < 128) ? (V32 + j) : (K32 + (j - 128));
            float sol[64];
#pragma unroll
            for (int i = 0; i < 64; ++i) {
                float a0 = rhs[i * 132], a1 = 0.f;
#pragma unroll
                for (int jb = 0; jb < i; jb += 4) {
                    const f32x4 lv = *(const LAS f32x4*)(Lm + i * 68 + jb);
                    a0 -= lv[0] * sol[jb];
                    if (jb + 1 < i) a1 -= lv[1] * sol[jb + 1];
                    if (jb + 2 < i) a0 -= lv[2] * sol[jb + 2];
                    if (jb + 3 < i) a1 -= lv[3] * sol[jb + 3];
                }
                sol[i] = a0 + a1;
            }
            bf16_t* dst = QKV + (size_t)t0 * 3072 + ((j < 128) ? (2048 + h * 128 + j) : (1024 + h * 128 + (j - 128)));
#pragma unroll
            for (int i = 0; i < 64; ++i) dst[(size_t)i * 3072] = (bf16_t)f2bf(sol[i]);
        } else {
            const int t = c.tid - 256, dk = t & 127, ch = t >> 7;
            bf16_t* kt = KT + (size_t)((b * NH + h) * 64 + n) * 8192 + dk * 64 + ch * 32;
#pragma unroll
            for (int g4 = 0; g4 < 4; ++g4) {
                u32x4 w;
#pragma unroll
                for (int e = 0; e < 4; ++e) { const int cc = ch * 32 + g4 * 8 + 2 * e; w[e] = (unsigned)kb[cc * 136 + dk] | ((unsigned)kb[(cc + 1) * 136 + dk] << 16); }
                *(u32x4*)(kt + g4 * 8) = w;
            }
            const int r = t >> 2, c0 = (t & 3) * 32;
#pragma unroll
            for (int i = 0; i < 4; ++i) *(u32x4*)(QKV + (size_t)(t0 + r) * 3072 + h * 128 + c0 + 8 * i) = *(const LAS u32x4*)(qb + r * 136 + c0 + 8 * i);
        }
        __syncthreads();
    }
}

__device__ __forceinline__ bf16x8 ld2x4(const bf16_t* p) {
    const u32x2 lo = *(const u32x2*)p, hi = *(const u32x2*)(p + 16);
    u32x4 w; w.x = lo.x; w.y = lo.y; w.z = hi.x; w.w = hi.y; return __builtin_bit_cast(bf16x8, w);
}
__device__ __forceinline__ bf16x8 pack8(const f32x4 a, const f32x4 b) {
    u32x4 w; w.x = pk2(a[0], a[1]); w.y = pk2(a[2], a[3]); w.z = pk2(b[0], b[1]); w.w = pk2(b[2], b[3]); return __builtin_bit_cast(bf16x8, w);
}
constexpr int SC_W = 0, SC_Q = 17408, SC_KT = 34816, SC_ATT = 53248, SC_U = 62464, SC_GC = 71680, SC_BUF = 71936;
__device__ __forceinline__ bf16x8 ld2x4_lds(const LAS bf16_t* p) {
    const u32x2 lo = *(const LAS u32x2*)p, hi = *(const LAS u32x2*)(p + 16);
    u32x4 w; w.x = lo.x; w.y = lo.y; w.z = hi.x; w.w = hi.y; return __builtin_bit_cast(bf16x8, w);
}
__device__ __forceinline__ void dn_scan(const Args& a, const Ctx& c) {
    const bf16_t* QKV = (const bf16_t*)(c.ws + WS_R2); const bf16_t* KT = (const bf16_t*)(c.ws + WS_R1); const bf16_t* ATT = (const bf16_t*)(c.ws + WS_R5);
    const float* GC = (const float*)(c.ws + WS_GC); bf16_t* O = (bf16_t*)(c.ws + WS_R4);
    const int lane = c.lane, wave = c.wave, quad = lane >> 4, l15 = lane & 15;
    for (int item = blockIdx.x; item < BATCH * NH * 2; item += gridDim.x) {
        const int half = item & 1, bh = item >> 1, b = bh >> 3, h = bh & 7;
        f32x4 S[8];
#pragma unroll
        for (int mt = 0; mt < 8; ++mt) S[mt] = (f32x4){0.f, 0.f, 0.f, 0.f};
        __syncthreads();
        for (int n = -1; n < 64; ++n) {
            if (wave >= 4) {
                const int nn = n + 1;
                if (nn < 64) {
                    LAS unsigned char* buf = c.lds + (nn & 1) * SC_BUF;
                    const int t = c.tid - 256;
                    const int t0 = b * SEQ + nn * 64; const size_t ci = (size_t)(bh * 64 + nn);
                    u32x4 v[16];
#pragma unroll
                    for (int i = 0; i < 4; ++i) { const int id = t + 256 * i, row = id >> 4, ch = id & 15;
                        const bf16_t* p = QKV + (size_t)(t0 + row) * 3072 + h * 128 + ch * 8; v[i] = *(const u32x4*)(p + 1024); v[4 + i] = *(const u32x4*)p; }
#pragma unroll
                    for (int i = 0; i < 4; ++i) { const int id = t + 256 * i; v[8 + i] = *(const u32x4*)(KT + ci * 8192 + (size_t)id * 8); }
#pragma unroll
                    for (int i = 0; i < 2; ++i) { const int id = t + 256 * i, row = id >> 3, ch = id & 7;
                        v[12 + i] = *(const u32x4*)(ATT + ci * 4096 + (size_t)id * 8);
                        v[14 + i] = *(const u32x4*)(QKV + (size_t)(t0 + row) * 3072 + 2048 + h * 128 + half * 64 + ch * 8); }
                    float gv = 0.f; if (t < 64) gv = GC[(size_t)(t0 + t) * 8 + h];
#pragma unroll
                    for (int i = 0; i < 4; ++i) { const int id = t + 256 * i, row = id >> 4, ch = id & 15;
                        *(LAS u32x4*)(buf + SC_W + (row * 136 + ch * 8) * 2) = v[i]; *(LAS u32x4*)(buf + SC_Q + (row * 136 + ch * 8) * 2) = v[4 + i]; }
#pragma unroll
                    for (int i = 0; i < 4; ++i) { const int id = t + 256 * i, row = id >> 3, ch = id & 7; *(LAS u32x4*)(buf + SC_KT + (row * 72 + ch * 8) * 2) = v[8 + i]; }
#pragma unroll
                    for (int i = 0; i < 2; ++i) { const int id = t + 256 * i, row = id >> 3, ch = id & 7;
                        *(LAS u32x4*)(buf + SC_ATT + (row * 72 + ch * 8) * 2) = v[12 + i]; *(LAS u32x4*)(buf + SC_U + (row * 72 + ch * 8) * 2) = v[14 + i]; }
                    if (t < 64) *(LAS float*)(buf + SC_GC + t * 4) = gv;
                }
            } else if (n >= 0) {
                const LAS unsigned char* buf = c.lds + (n & 1) * SC_BUF;
                const LAS bf16_t* Wl = (const LAS bf16_t*)(buf + SC_W); const LAS bf16_t* Ql = (const LAS bf16_t*)(buf + SC_Q);
                const LAS bf16_t* Kl = (const LAS bf16_t*)(buf + SC_KT); const LAS bf16_t* Al = (const LAS bf16_t*)(buf + SC_ATT);
                const LAS bf16_t* Ul = (const LAS bf16_t*)(buf + SC_U); const LAS float* gcl = (const LAS float*)(buf + SC_GC);
                const int t0 = b * SEQ + n * 64;
                bf16x8 Sb[4];
#pragma unroll
                for (int ks = 0; ks < 4; ++ks) Sb[ks] = pack8(S[2 * ks], S[2 * ks + 1]);
                f32x4 P[4], QS[4];
#pragma unroll
                for (int ct = 0; ct < 4; ++ct) { P[ct] = (f32x4){0.f, 0.f, 0.f, 0.f}; QS[ct] = (f32x4){0.f, 0.f, 0.f, 0.f}; }
#pragma unroll
                for (int ct = 0; ct < 4; ++ct)
#pragma unroll
                    for (int ks = 0; ks < 4; ++ks) {
                        const int off = (16 * ct + l15) * 136 + 32 * ks + 4 * quad;
                        P[ct] = __builtin_amdgcn_mfma_f32_16x16x32_bf16(ld2x4_lds(Wl + off), Sb[ks], P[ct], 0, 0, 0);
                        QS[ct] = __builtin_amdgcn_mfma_f32_16x16x32_bf16(ld2x4_lds(Ql + off), Sb[ks], QS[ct], 0, 0, 0);
                    }
                const float gL = gcl[63];
                f32x4 vn[4], vd[4], o[4];
#pragma unroll
                for (int ct = 0; ct < 4; ++ct)
#pragma unroll
                    for (int r = 0; r < 4; ++r) {
                        const int cr = 16 * ct + 4 * quad + r;
                        const float u = bf2f(Ul[cr * 72 + 16 * wave + l15]);
                        const float g = gcl[cr];
                        const float v = u - P[ct][r];
                        vn[ct][r] = v; vd[ct][r] = v * fexp(gL - g); o[ct][r] = QS[ct][r] * fexp(g);
                    }
                bf16x8 Vb[2], Vdb[2];
#pragma unroll
                for (int k2 = 0; k2 < 2; ++k2) { Vb[k2] = pack8(vn[2 * k2], vn[2 * k2 + 1]); Vdb[k2] = pack8(vd[2 * k2], vd[2 * k2 + 1]); }
#pragma unroll
                for (int ct = 0; ct < 4; ++ct)
#pragma unroll
                    for (int k2 = 0; k2 < 2; ++k2)
                        o[ct] = __builtin_amdgcn_mfma_f32_16x16x32_bf16(ld2x4_lds(Al + (16 * ct + l15) * 72 + 32 * k2 + 4 * quad), Vb[k2], o[ct], 0, 0, 0);
#pragma unroll
                for (int ct = 0; ct < 4; ++ct)
#pragma unroll
                    for (int r = 0; r < 4; ++r) O[(size_t)(t0 + 16 * ct + 4 * quad + r) * 1024 + h * 128 + (half * 4 + wave) * 16 + l15] = (bf16_t)f2bf(o[ct][r]);
                const float eL = fexp(gL);
#pragma unroll
                for (int mt = 0; mt < 8; ++mt) {
                    S[mt] = S[mt] * eL;
#pragma unroll
                    for (int k2 = 0; k2 < 2; ++k2)
                        S[mt] = __builtin_amdgcn_mfma_f32_16x16x32_bf16(ld2x4_lds(Kl + (16 * mt + l15) * 72 + 32 * k2 + 4 * quad), Vdb[k2], S[mt], 0, 0, 0);
                }
            }
            __syncthreads();
        }
    }
}

__device__ __forceinline__ void dn_post(const Args& a, const Ctx& c, const float* out_norm) {
    bf16_t* O = (bf16_t*)(c.ws + WS_R4); const bf16_t* Z = (const bf16_t*)(c.ws + WS_R3);
    const int cb = (c.lane & 7) * 16;
    float gn[16];
#pragma unroll
    for (int i = 0; i < 16; ++i) gn[i] = out_norm[cb + i];
    for (int m = c.gw; m < M; m += c.ngw) {
        u32x4 ow[2], zw[2];
#pragma unroll
        for (int i = 0; i < 2; ++i) { ow[i] = *(const u32x4*)(O + (size_t)m * D + c.lane * 16 + 8 * i); zw[i] = *(const u32x4*)(Z + (size_t)m * D + c.lane * 16 + 8 * i); }
        float ov[16], s = 0.f;
#pragma unroll
        for (int i = 0; i < 2; ++i)
#pragma unroll
            for (int j = 0; j < 4; ++j) { ov[8 * i + 2 * j] = bflo(ow[i][j]); ov[8 * i + 2 * j + 1] = bfhi(ow[i][j]); }
#pragma unroll
        for (int i = 0; i < 16; ++i) s += ov[i] * ov[i];
        s += __shfl_xor(s, 1); s += __shfl_xor(s, 2); s += __shfl_xor(s, 4);
        const float rs = 1.0f / sqrtf(s * (1.0f / 128.0f) + EPS);
        u32x4 res[2];
#pragma unroll
        for (int i = 0; i < 2; ++i)
#pragma unroll
            for (int j = 0; j < 4; ++j) {
                const float z0 = bflo(zw[i][j]), z1 = bfhi(zw[i][j]);
                res[i][j] = pk2(ov[8 * i + 2 * j] * rs * gn[8 * i + 2 * j] * silu_f(z0), ov[8 * i + 2 * j + 1] * rs * gn[8 * i + 2 * j + 1] * silu_f(z1));
            }
#pragma unroll
        for (int i = 0; i < 2; ++i) *(u32x4*)(O + (size_t)m * D + c.lane * 16 + 8 * i) = res[i];
    }
}

__device__ __forceinline__ void v_transpose(const Ctx& c, const bf16_t* src, int pitch, int head_stride, int col_base, bf16_t* Vt) {
    LAS bf16_t* tile = (LAS bf16_t*)c.lds;
    for (int item = blockIdx.x; item < BATCH * NH * 64; item += gridDim.x) {
        const int tb = item & 63, h = (item >> 6) & 7, b = item >> 9;
        const int t0 = b * SEQ + tb * 64;
        { const int r = c.tid >> 3, cc = (c.tid & 7) * 16;
          const bf16_t* p = src + (size_t)(t0 + r) * pitch + col_base + h * head_stride + cc;
          *(LAS u32x4*)(tile + r * 136 + cc) = *(const u32x4*)p; *(LAS u32x4*)(tile + r * 136 + cc + 8) = *(const u32x4*)(p + 8); }
        __syncthreads();
        { const int d = c.tid >> 2, tq = (c.tid & 3) * 16;
          u32x4 w[2];
#pragma unroll
          for (int i = 0; i < 2; ++i)
#pragma unroll
              for (int e = 0; e < 4; ++e) { const int t = tq + 8 * i + 2 * e; w[i][e] = (unsigned)tile[t * 136 + d] | ((unsigned)tile[(t + 1) * 136 + d] << 16); }
          bf16_t* dst = Vt + ((size_t)((b * NH + h) * 128 + d)) * SEQ + tb * 64 + tq;
          *(u32x4*)dst = w[0]; *(u32x4*)(dst + 8) = w[1]; }
        __syncthreads();
    }
}

__device__ __forceinline__ void sb_prep_rows(const Args& a, const Ctx& c, const float* qn, const float* kn) {
    bf16_t* QKV = (bf16_t*)(c.ws + WS_R2);
    const int cb = (c.lane & 7) * 16;
    float gq[16], gk[16];
#pragma unroll
    for (int i = 0; i < 16; ++i) { gq[i] = qn[cb + i] * 0.08838834764831845f; gk[i] = kn[cb + i]; }
    for (int m = c.gw; m < M; m += c.ngw) {
#pragma unroll
        for (int which = 0; which < 2; ++which) {
            bf16_t* p = QKV + (size_t)m * 3072 + which * 1024 + c.lane * 16;
            u32x4 w[2]; w[0] = *(const u32x4*)p; w[1] = *(const u32x4*)(p + 8);
            float v[16], s = 0.f;
#pragma unroll
            for (int i = 0; i < 2; ++i)
#pragma unroll
                for (int j = 0; j < 4; ++j) { v[8 * i + 2 * j] = bflo(w[i][j]); v[8 * i + 2 * j + 1] = bfhi(w[i][j]); }
#pragma unroll
            for (int i = 0; i < 16; ++i) s += v[i] * v[i];
            s += __shfl_xor(s, 1); s += __shfl_xor(s, 2); s += __shfl_xor(s, 4);
            const float rs = 1.0f / sqrtf(s * (1.0f / 128.0f) + EPS);
            u32x4 o[2];
#pragma unroll
            for (int i = 0; i < 2; ++i)
#pragma unroll
                for (int j = 0; j < 4; ++j) {
                    const float g0 = which ? gk[8 * i + 2 * j] : gq[8 * i + 2 * j], g1 = which ? gk[8 * i + 2 * j + 1] : gq[8 * i + 2 * j + 1];
                    o[i][j] = pk2(v[8 * i + 2 * j] * rs * g0, v[8 * i + 2 * j + 1] * rs * g1);
                }
            *(u32x4*)p = o[0]; *(u32x4*)(p + 8) = o[1];
        }
    }
}

__device__ __forceinline__ void mla_prep_rows(const Args& a, const Ctx& c) {
    bf16_t* Q = (bf16_t*)(c.ws + WS_R2); bf16_t* Kf = (bf16_t*)(c.ws + WS_R2 + 48 * MiB);
    const bf16_t* KV = (const bf16_t*)(c.ws + WS_R3); const bf16_t* C = (const bf16_t*)(c.ws + WS_R5);
    const float* gqn = a.in[25]; const float* gqr = a.in[26]; const float* gkn = a.in[27]; const float* gkr = a.in[28];
    const int lane = c.lane, h = lane >> 3, p = lane & 7;
    const float SC = 0.07216878364870322f;
    float g_qn[16], g_kn[16], g_qr[8], g_kr[8], invf[8];
#pragma unroll
    for (int i = 0; i < 16; ++i) { g_qn[i] = gqn[16 * p + i] * SC; g_kn[i] = gkn[16 * p + i]; }
#pragma unroll
    for (int i = 0; i < 8; ++i) { g_qr[i] = gqr[8 * p + i] * SC; g_kr[i] = gkr[8 * p + i];
        invf[i] = __builtin_amdgcn_exp2f(-(float)(2 * ((8 * p + i) & 31)) * (1.0f / 64.0f) * 13.287712379549449f); }
    const bool first = p < 4;
    for (int m = c.gw; m < M; m += c.ngw) {
        const int t = m & (SEQ - 1);
        const bf16_t* qp = Q + (size_t)m * 1536 + h * 192;
        const u32x4 qn0 = *(const u32x4*)(qp + 16 * p), qn1 = *(const u32x4*)(qp + 16 * p + 8), qr = *(const u32x4*)(qp + 128 + 8 * p);
        const bf16_t* kvp = KV + (size_t)m * 2048 + h * 256;
        const u32x4 kn0 = *(const u32x4*)(kvp + 16 * p), kn1 = *(const u32x4*)(kvp + 16 * p + 8);
        const u32x4 kr = *(const u32x4*)(C + (size_t)m * 512 + 384 + 8 * p);
        float cs[8], sn[8];
#pragma unroll
        for (int i = 0; i < 8; ++i) { const float ang = (float)t * invf[i]; const double rev = (double)ang * 0.15915494309189535; const float fr = (float)(rev - floor(rev));
            cs[i] = __builtin_amdgcn_cosf(fr); sn[i] = __builtin_amdgcn_sinf(fr); }
        float qv[16], kv[16], qrv[8], krv[8];
#pragma unroll
        for (int j = 0; j < 4; ++j) { qv[2 * j] = bflo(qn0[j]); qv[2 * j + 1] = bfhi(qn0[j]); qv[8 + 2 * j] = bflo(qn1[j]); qv[9 + 2 * j] = bfhi(qn1[j]);
            kv[2 * j] = bflo(kn0[j]); kv[2 * j + 1] = bfhi(kn0[j]); kv[8 + 2 * j] = bflo(kn1[j]); kv[9 + 2 * j] = bfhi(kn1[j]);
            qrv[2 * j] = bflo(qr[j]); qrv[2 * j + 1] = bfhi(qr[j]); krv[2 * j] = bflo(kr[j]); krv[2 * j + 1] = bfhi(kr[j]); }
        float sq = 0.f, sk = 0.f, sqr = 0.f, skr = 0.f;
#pragma unroll
        for (int i = 0; i < 16; ++i) { sq += qv[i] * qv[i]; sk += kv[i] * kv[i]; }
#pragma unroll
        for (int i = 0; i < 8; ++i) { sqr += qrv[i] * qrv[i]; skr += krv[i] * krv[i]; }
#pragma unroll
        for (int o = 1; o < 8; o <<= 1) { sq += __shfl_xor(sq, o); sk += __shfl_xor(sk, o); sqr += __shfl_xor(sqr, o); skr += __shfl_xor(skr, o); }
        const float rq = 1.0f / sqrtf(sq * (1.0f / 128.0f) + EPS), rk = 1.0f / sqrtf(sk * (1.0f / 128.0f) + EPS);
        const float rqr = 1.0f / sqrtf(sqr * (1.0f / 64.0f) + EPS), rkr = 1.0f / sqrtf(skr * (1.0f / 64.0f) + EPS);
        u32x4 oq0, oq1, ok0, ok1, oqr, okr;
#pragma unroll
        for (int j = 0; j < 4; ++j) { oq0[j] = pk2(qv[2 * j] * rq * g_qn[2 * j], qv[2 * j + 1] * rq * g_qn[2 * j + 1]); oq1[j] = pk2(qv[8 + 2 * j] * rq * g_qn[8 + 2 * j], qv[9 + 2 * j] * rq * g_qn[9 + 2 * j]);
            ok0[j] = pk2(kv[2 * j] * rk * g_kn[2 * j], kv[2 * j + 1] * rk * g_kn[2 * j + 1]); ok1[j] = pk2(kv[8 + 2 * j] * rk * g_kn[8 + 2 * j], kv[9 + 2 * j] * rk * g_kn[9 + 2 * j]); }
        float qo[8], ko[8];
#pragma unroll
        for (int i = 0; i < 8; ++i) {
            const float xq = qrv[i] * rqr * g_qr[i], xk = krv[i] * rkr * g_kr[i];
            const float yq = __shfl_xor(xq, 4), yk = __shfl_xor(xk, 4);
            qo[i] = first ? (xq * cs[i] - yq * sn[i]) : (xq * cs[i] + yq * sn[i]);
            ko[i] = first ? (xk * cs[i] - yk * sn[i]) : (xk * cs[i] + yk * sn[i]);
        }
#pragma unroll
        for (int j = 0; j < 4; ++j) { oqr[j] = pk2(qo[2 * j], qo[2 * j + 1]); okr[j] = pk2(ko[2 * j], ko[2 * j + 1]); }
        bf16_t* qw = Q + (size_t)m * 1536 + h * 192; bf16_t* kw = Kf + (size_t)m * 1536 + h * 192;
        *(u32x4*)(qw + 16 * p) = oq0; *(u32x4*)(qw + 16 * p + 8) = oq1; *(u32x4*)(qw + 128 + 8 * p) = oqr;
        *(u32x4*)(kw + 16 * p) = ok0; *(u32x4*)(kw + 16 * p + 8) = ok1; *(u32x4*)(kw + 128 + 8 * p) = okr;
    }
}

template <int DK, bool STICK>
__device__ __forceinline__ void attn_phase(const Ctx& c, const bf16_t* Q, int qpitch, const bf16_t* Kg, int kpitch, const bf16_t* Vt, bf16_t* O, int opitch) {
    constexpr int KP = DK + 8;
    constexpr int KS = DK / 32;
    LAS bf16_t* Kt = (LAS bf16_t*)c.lds;
    LAS bf16_t* Vl = (LAS bf16_t*)(c.lds + 64 * KP * 2);
    const int lane = c.lane, wave = c.wave, quad = lane >> 4, l15 = lane & 15;
    for (int pu = blockIdx.x; pu < 256; pu += gridDim.x) {
        const int bh = pu >> 3, s8 = pu & 7, b = bh >> 3, h = bh & 7;
        for (int half = 0; half < 2; ++half) {
            const int qb = half ? 15 - s8 : s8;
            const int q0 = qb * 256 + wave * 32;
            bf16x8 Qf[2][KS];
#pragma unroll
            for (int qt = 0; qt < 2; ++qt)
#pragma unroll
                for (int ks = 0; ks < KS; ++ks) Qf[qt][ks] = *(const bf16x8*)(Q + (size_t)(b * SEQ + q0 + 16 * qt + l15) * qpitch + h * DK + 32 * ks + 8 * quad);
            f32x4 Oa[8][2];
#pragma unroll
            for (int dt = 0; dt < 8; ++dt) { Oa[dt][0] = (f32x4){0.f, 0.f, 0.f, 0.f}; Oa[dt][1] = (f32x4){0.f, 0.f, 0.f, 0.f}; }
            float mrow[2] = {-1e30f, -1e30f}, lrow[2] = {0.f, 0.f}, Rrow[2] = {0.f, 0.f};
            const int ntile = 4 * (qb + 1);
            for (int it = 0; it < ntile; ++it) {
                const int kt = STICK ? (ntile - 1 - it) : it;
                const int key0 = kt * 64;
                __syncthreads();
                { const int r = c.tid >> 3, cc = (c.tid & 7) * (DK / 8);
                  const bf16_t* p = Kg + (size_t)(b * SEQ + key0 + r) * kpitch + h * DK + cc;
#pragma unroll
                  for (int i = 0; i < DK / 64; ++i) *(LAS u32x4*)(Kt + r * KP + cc + 8 * i) = *(const u32x4*)(p + 8 * i);
                  const int d = c.tid >> 2, kq = (c.tid & 3) * 16;
                  const bf16_t* pv = Vt + ((size_t)(bh * 128 + d)) * SEQ + key0 + kq;
                  *(LAS u32x4*)(Vl + d * 72 + kq) = *(const u32x4*)pv; *(LAS u32x4*)(Vl + d * 72 + kq + 8) = *(const u32x4*)(pv + 8); }
                __syncthreads();
                if (key0 > q0 + 31) continue;
                f32x4 St[4][2];
#pragma unroll
                for (int k4 = 0; k4 < 4; ++k4) { St[k4][0] = (f32x4){0.f, 0.f, 0.f, 0.f}; St[k4][1] = (f32x4){0.f, 0.f, 0.f, 0.f}; }
#pragma unroll
                for (int ks = 0; ks < KS; ++ks)
#pragma unroll
                    for (int k4 = 0; k4 < 4; ++k4) {
                        const bf16x8 kf = *(const LAS bf16x8*)(Kt + (16 * k4 + l15) * KP + 32 * ks + 8 * quad);
                        St[k4][0] = __builtin_amdgcn_mfma_f32_16x16x32_bf16(kf, Qf[0][ks], St[k4][0], 0, 0, 0);
                        St[k4][1] = __builtin_amdgcn_mfma_f32_16x16x32_bf16(kf, Qf[1][ks], St[k4][1], 0, 0, 0);
                    }
                bf16x8 Pb[2][2];
#pragma unroll
                for (int qt = 0; qt < 2; ++qt) {
                    const int tq = q0 + 16 * qt + l15;
                    if constexpr (!STICK) {
                        float mx = -1e30f;
#pragma unroll
                        for (int k4 = 0; k4 < 4; ++k4)
#pragma unroll
                            for (int r = 0; r < 4; ++r) { const int key = key0 + 16 * k4 + 4 * quad + r; const float z = (key <= tq) ? St[k4][qt][r] : -1e30f; St[k4][qt][r] = z; mx = fmaxf(mx, z); }
                        mx = fmaxf(mx, __shfl_xor(mx, 16)); mx = fmaxf(mx, __shfl_xor(mx, 32));
                        const float mnew = fmaxf(mrow[qt], mx);
                        const float alpha = fexp(mrow[qt] - mnew);
                        float ps = 0.f;
#pragma unroll
                        for (int k4 = 0; k4 < 4; ++k4)
#pragma unroll
                            for (int r = 0; r < 4; ++r) { const float p = (St[k4][qt][r] > -1e29f) ? fexp(St[k4][qt][r] - mnew) : 0.f; St[k4][qt][r] = p; ps += p; }
                        ps += __shfl_xor(ps, 16); ps += __shfl_xor(ps, 32);
                        lrow[qt] = lrow[qt] * alpha + ps; mrow[qt] = mnew;
#pragma unroll
                        for (int dt = 0; dt < 8; ++dt) Oa[dt][qt] = Oa[dt][qt] * alpha;
                    } else {
                        float G[4], ls[4][4];
#pragma unroll
                        for (int k4 = 0; k4 < 4; ++k4) {
                            G[k4] = 0.f;
#pragma unroll
                            for (int r = 0; r < 4; ++r) { const int key = key0 + 16 * k4 + 4 * quad + r; const float z = St[k4][qt][r];
                                const float sp = softplus_f(z); const bool valid = key < tq; ls[k4][r] = valid ? -sp : 0.f; G[k4] += ls[k4][r];
                                St[k4][qt][r] = valid ? (z - sp) : -1e30f; }
                        }
                        float run = Rrow[qt];
#pragma unroll
                        for (int k4 = 3; k4 >= 0; --k4) {
                            const float g = G[k4];
                            const float gb = __shfl_xor(g, 16), gc2 = __shfl_xor(g, 32), gd = __shfl_xor(gb, 32);
                            const float hi = (((quad ^ 1) > quad) ? gb : 0.f) + (((quad ^ 2) > quad) ? gc2 : 0.f) + (((quad ^ 3) > quad) ? gd : 0.f);
                            float aft = run + hi;
#pragma unroll
                            for (int r = 3; r >= 0; --r) { const float lz = St[k4][qt][r]; St[k4][qt][r] = (lz > -1e29f) ? fexp(lz + aft) : 0.f; aft += ls[k4][r]; }
                            run += (g + gb) + (gc2 + gd);
                        }
                        Rrow[qt] = run;
                    }
                    Pb[qt][0] = pack8(St[0][qt], St[1][qt]); Pb[qt][1] = pack8(St[2][qt], St[3][qt]);
                }
#pragma unroll
                for (int dt = 0; dt < 8; ++dt)
#pragma unroll
                    for (int k2 = 0; k2 < 2; ++k2) {
                        const LAS bf16_t* vp = Vl + (16 * dt + l15) * 72 + 32 * k2 + 4 * quad;
                        const u32x2 lo = *(const LAS u32x2*)vp, hi = *(const LAS u32x2*)(vp + 16);
                        u32x4 w; w.x = lo.x; w.y = lo.y; w.z = hi.x; w.w = hi.y; const bf16x8 vf = __builtin_bit_cast(bf16x8, w);
                        Oa[dt][0] = __builtin_amdgcn_mfma_f32_16x16x32_bf16(vf, Pb[0][k2], Oa[dt][0], 0, 0, 0);
                        Oa[dt][1] = __builtin_amdgcn_mfma_f32_16x16x32_bf16(vf, Pb[1][k2], Oa[dt][1], 0, 0, 0);
                    }
            }
#pragma unroll
            for (int qt = 0; qt < 2; ++qt) {
                const float inv = STICK ? 1.f : 1.f / lrow[qt];
                bf16_t* op = O + (size_t)(b * SEQ + q0 + 16 * qt + l15) * opitch + h * 128 + 4 * quad;
#pragma unroll
                for (int dt = 0; dt < 8; ++dt) { u32x2 w; w.x = pk2(Oa[dt][qt][0] * inv, Oa[dt][qt][1] * inv); w.y = pk2(Oa[dt][qt][2] * inv, Oa[dt][qt][3] * inv); *(u32x2*)(op + 16 * dt) = w; }
            }
        }
    }
}

constexpr int NPHASE = 30;
__device__ __forceinline__ Ctx mkctx(LAS unsigned char* lds, unsigned char* ws_) {
    int t = threadIdx.x; asm volatile("" : "+v"(t));
    asm volatile("" : "+s"(ws_));
    Ctx c; c.lds = lds; c.ws = ws_; c.tid = t; c.lane = t & 63; c.wave = __builtin_amdgcn_readfirstlane(t >> 6);
    c.gw = blockIdx.x * NWAVES + c.wave; c.ngw = gridDim.x * NWAVES; return c;
}
#define PH_BEGIN Ctx c = mkctx(ldsp, args.ws); const Args& A = args; unsigned char* ws = c.ws; \
    bf16_t* XB = (bf16_t*)(ws + WS_R1); float* SS = (float*)(ws + WS_SS); bf16_t* R2 = (bf16_t*)(ws + WS_R2); bf16_t* R3 = (bf16_t*)(ws + WS_R3); \
    bf16_t* R4 = (bf16_t*)(ws + WS_R4); bf16_t* R5 = (bf16_t*)(ws + WS_R5); bf16_t* WMIX = (bf16_t*)(ws + WS_WMIX); bf16_t* WOUT = (bf16_t*)(ws + WS_WMIX_OUT); \
    (void)XB; (void)SS; (void)R2; (void)R3; (void)R4; (void)R5; (void)WMIX; (void)WOUT; (void)c;

__global__ void __launch_bounds__(NTHR, 2) trunk_fwd(Args args) {
    extern __shared__ __attribute__((aligned(16))) unsigned char lds_raw[];
    LAS unsigned char* ldsp = (LAS unsigned char*)lds_raw;
    const int lo = args.ph_lo, hi = args.ph_hi;
    const int G = gridDim.x, bid = blockIdx.x;
#if !MK_PER_PHASE
    cg::grid_group grid = cg::this_grid();
#if MK_XCD_BAR
    volatile LAS unsigned* misc = (volatile LAS unsigned*)(ldsp + LDS_MISC);
    if (threadIdx.x < 16) misc[threadIdx.x] = 0u;
    __syncthreads();
    XcdBarrier xbar = xcd_barrier_post((unsigned*)(args.ws + WS_BAR), misc + 8);
    int nsync = 0;
#define SEAM() do { if (nsync == 0) grid.sync(); else xcd_barrier(xbar); ++nsync; } while (0)
#else
#define SEAM() grid.sync()
#endif
#else
#define SEAM() do {} while (0)
#endif
#define IN(k) (lo <= (k) && (k) < hi)
#ifndef PROBE_MASK
#define PROBE_MASK 0ull
#endif
    unsigned long long tacc = 0ull, tph = (PROBE_MASK != 0ull) ? __builtin_amdgcn_s_memrealtime() : 0ull;
#define ENDPH(k) do { if (IN((k) + 1)) SEAM(); if (PROBE_MASK != 0ull) { const unsigned long long tn = __builtin_amdgcn_s_memrealtime(); if ((PROBE_MASK >> (k)) & 1ull) tacc += tn - tph; tph = tn; } } while (0)

    float* out = args.out;
    int ph = 0;

    if (IN(ph) && EN(0)) { PH_BEGIN; convert_mixer(A, c, 0); convert_ffn(A, c, 0); prologue_rows(A, c); }
    ENDPH(ph); ++ph;

#pragma unroll 1
    for (int L = 0; L < 4; ++L) {
        const float* resid_in = (L == 0) ? args.in[0] : out;
        if (L == 0 || L == 3) {
            const int ib = (L == 0) ? 1 : 33;
            if (IN(ph)) {
                PH_BEGIN;
                if (L > 0 && EN(0)) convert_ffn(A, c, L);
                __syncthreads();
                pg8::Gemm g{XB, WMIX, M, 4352, D, D}; pg8::StaticOrder S; S.init(M, 4352, G, bid);
                pg8::EpiDN E{R2, R3, (float*)(ws + WS_AB), (bf16_t*)(ws + WS_HALO), SS};
                if (EN(1)) pg8::gemm_phase<pg8::EpiDN>(c.lds, g, S, E);
            }
            ENDPH(ph); ++ph;
            if (IN(ph) && EN(2)) { PH_BEGIN; dn_conv(A, c, A.in[ib + 2]); }
            ENDPH(ph); ++ph;
            if (IN(ph) && EN(3)) { PH_BEGIN; dn_chunk(A, c, A.in[ib + 3], A.in[ib + 4]); }
            ENDPH(ph); ++ph;
            if (IN(ph) && EN(4)) { PH_BEGIN; dn_scan(A, c); }
            ENDPH(ph); ++ph;
            if (IN(ph) && EN(5)) { PH_BEGIN; dn_post(A, c, A.in[ib + 5]); }
            ENDPH(ph); ++ph;
            if (IN(ph)) {
                PH_BEGIN;
                pg8::Gemm g{R4, WOUT, M, D, D, D}; pg8::StaticOrder S; S.init(M, D, G, bid);
                pg8::EpiResidual E{resid_in, out, XB, SS};
                if (EN(10)) pg8::gemm_phase<pg8::EpiResidual>(c.lds, g, S, E);
            }
            ENDPH(ph); ++ph;
        } else if (L == 1) {
            if (IN(ph)) {
                PH_BEGIN;
                if (EN(0)) convert_ffn(A, c, L);
                __syncthreads();
                pg8::Gemm g{XB, WMIX, M, 3072, D, D}; pg8::StaticOrder S; S.init(M, 3072, G, bid);
                pg8::EpiStore E{R2, 3072, SS, 0, 16, 1.0f / D};
                if (EN(11)) pg8::gemm_phase<pg8::EpiStore>(c.lds, g, S, E);
            }
            ENDPH(ph); ++ph;
            if (IN(ph) && EN(6)) { PH_BEGIN; sb_prep_rows(A, c, A.in[13], A.in[14]); v_transpose(c, R2, 3072, 128, 2048, (bf16_t*)(ws + WS_R1)); }
            ENDPH(ph); ++ph;
            if (IN(ph) && EN(7)) { PH_BEGIN; attn_phase<128, true>(c, R2, 3072, R2 + 1024, 3072, (const bf16_t*)(ws + WS_R1), R2, 3072); }
            ENDPH(ph); ++ph;
            if (IN(ph)) {
                PH_BEGIN;
                pg8::Gemm g{R2, WOUT, M, D, D, 3072}; pg8::StaticOrder S; S.init(M, D, G, bid);
                pg8::EpiResidual E{resid_in, out, XB, SS};
                if (EN(10)) pg8::gemm_phase<pg8::EpiResidual>(c.lds, g, S, E);
            }
            ENDPH(ph); ++ph;
        } else {
            if (IN(ph)) {
                PH_BEGIN;
                if (EN(0)) convert_ffn(A, c, L);
                __syncthreads();
                pg8::Gemm g{XB, WMIX, M, 512, D, D}; pg8::StaticOrder S; S.init(M, 512, G, bid);
                pg8::EpiMlaDown E{R5, (float*)(ws + WS_SS2), SS};
                if (EN(12)) pg8::gemm_phase<pg8::EpiMlaDown>(c.lds, g, S, E);
            }
            ENDPH(ph); ++ph;
            if (IN(ph)) {
                PH_BEGIN;
                { pg8::Gemm g{R5, (bf16_t*)(ws + WS_WMIX + 1 * MiB), M, 1536, 256, 512}; pg8::StaticOrder S; S.init(M, 1536, G, bid);
                  pg8::EpiStore E{R2, 1536, (const float*)(ws + WS_SS2), 0, 8, 1.0f / 256.0f};
                  if (EN(11)) pg8::gemm_phase<pg8::EpiStore>(c.lds, g, S, E); }
                { pg8::Gemm g{R5 + 256, (bf16_t*)(ws + WS_WMIX + 2 * MiB), M, 2048, 128, 512}; pg8::StaticOrder S; S.init(M, 2048, G, bid);
                  pg8::EpiStore E{R3, 2048, (const float*)(ws + WS_SS2), 8, 4, 1.0f / 128.0f};
                  if (EN(11)) pg8::gemm_phase<pg8::EpiStore>(c.lds, g, S, E); }
            }
            ENDPH(ph); ++ph;
            if (IN(ph) && EN(8)) { PH_BEGIN; mla_prep_rows(A, c); v_transpose(c, R3, 2048, 256, 128, (bf16_t*)(ws + WS_R1)); }
            ENDPH(ph); ++ph;
            if (IN(ph) && EN(9)) { PH_BEGIN; attn_phase<192, false>(c, R2, 1536, (const bf16_t*)(ws + WS_R2 + 48 * MiB), 1536, (const bf16_t*)(ws + WS_R1), R3, 1024); }
            ENDPH(ph); ++ph;
            if (IN(ph)) {
                PH_BEGIN;
                pg8::Gemm g{R3, WOUT, M, D, D, D}; pg8::StaticOrder S; S.init(M, D, G, bid);
                pg8::EpiResidual E{resid_in, out, XB, SS};
                if (EN(10)) pg8::gemm_phase<pg8::EpiResidual>(c.lds, g, S, E);
            }
            ENDPH(ph); ++ph;
        }
        if (IN(ph)) {
            PH_BEGIN;
            if (L < 3 && EN(0)) convert_mixer(A, c, L + 1);
            __syncthreads();
            pg8::Gemm g{XB, (bf16_t*)(ws + WS_WFFN), M, 2 * FH, D, D}; pg8::StaticOrder S; S.init(M, 2 * FH, G, bid);
            pg8::EpiSwiglu E{R2, SS};
            if (EN(13)) pg8::gemm_phase<pg8::EpiSwiglu>(c.lds, g, S, E);
        }
        ENDPH(ph); ++ph;
        if (IN(ph)) {
            PH_BEGIN;
            pg8::Gemm g{R2, (bf16_t*)(ws + WS_WFFN_DN), M, D, FH, FH}; pg8::StaticOrder S; S.init(M, D, G, bid);
            pg8::EpiResidual E{out, out, XB, SS};
            if (EN(10)) pg8::gemm_phase<pg8::EpiResidual>(c.lds, g, S, E);
        }
        ENDPH(ph); ++ph;
    }
    if (PROBE_MASK != 0ull) { const unsigned long long te = __builtin_amdgcn_s_memrealtime(); while (__builtin_amdgcn_s_memrealtime() - te < tacc) __builtin_amdgcn_s_sleep(8); }
}

extern "C" void kernel_launch(void* const* d_in, const int* in_sizes, int n_in, void* d_out, int out_size, void* d_ws, size_t ws_size, hipStream_t stream) {
    static int grid = 0;
    if (grid == 0) {
        if (n_in != 43 || out_size != M * D || ws_size < WS_END) { fprintf(stderr, "kernel_launch: unexpected shapes (n_in %d out %d ws %zu)\n", n_in, out_size, ws_size); grid = -1; return; }
        int dev = 0, cus = 0, per_cu = 0;
        hipGetDevice(&dev); hipDeviceGetAttribute(&cus, hipDeviceAttributeMultiprocessorCount, dev);
        if (hipFuncSetAttribute((const void*)trunk_fwd, hipFuncAttributeMaxDynamicSharedMemorySize, LDS_BYTES) != hipSuccess) { fprintf(stderr, "kernel_launch: hipFuncSetAttribute failed\n"); grid = -1; return; }
        if (hipOccupancyMaxActiveBlocksPerMultiprocessor(&per_cu, (const void*)trunk_fwd, NTHR, LDS_BYTES) != hipSuccess || per_cu < 1) { fprintf(stderr, "kernel_launch: occupancy query says %d\n", per_cu); per_cu = 1; }
        (void)hipGetLastError();
        grid = cus * 1;
    }
    if (grid < 0) return;
    Args a{};
    for (int i = 0; i < 43; ++i) a.in[i] = (const float*)d_in[i];
    a.out = (float*)d_out; a.ws = (unsigned char*)d_ws;
#if MK_PER_PHASE
    for (int p = 0; p < NPHASE; ++p) {
        a.ph_lo = p; a.ph_hi = p + 1;
        hipLaunchKernelGGL(trunk_fwd, dim3(grid), dim3(NTHR), LDS_BYTES, stream, a);
    }
#else
    hipMemsetAsync((char*)d_ws + WS_BAR, 0, 65536, stream);
    a.ph_lo = 0; a.ph_hi = NPHASE;
    void* kargs[] = {&a};
    hipError_t e = hipLaunchCooperativeKernel((const void*)trunk_fwd, dim3(grid), dim3(NTHR), kargs, LDS_BYTES, stream);
    if (e != hipSuccess) fprintf(stderr, "cooperative launch failed: %s (grid %d)\n", hipGetErrorString(e), grid);
#endif
}
```

```cpp
#include <hip/hip_runtime.h>
#include <hip/hip_cooperative_groups.h>
#include <cstdio>
#include <cstdint>
namespace cg = cooperative_groups;

#ifndef MK_PER_PHASE
#define MK_PER_PHASE 0
#endif
#ifndef MK_XCD_BAR
#define MK_XCD_BAR 1
#endif

#ifndef EN_MASK
#define EN_MASK 0xFFFFFFFFu
#endif
#define EN(b) ((EN_MASK >> (b)) & 1u)
#define LAS __attribute__((address_space(3)))
typedef unsigned short bf16_t;
typedef short bf16x8 __attribute__((ext_vector_type(8)));
typedef short bf16x4 __attribute__((ext_vector_type(4)));
typedef float f32x4 __attribute__((ext_vector_type(4)));
typedef float f32x2 __attribute__((ext_vector_type(2)));
typedef unsigned u32x4 __attribute__((ext_vector_type(4)));
typedef unsigned u32x2 __attribute__((ext_vector_type(2)));

constexpr int BATCH = 4, SEQ = 4096, D = 1024, M = BATCH * SEQ, FH = 2816, NH = 8;
constexpr float EPS = 1e-6f;
constexpr int NWAVES = 8, NTHR = 512;

constexpr size_t MiB = 1u << 20;
constexpr size_t WS_BAR = 0;
constexpr size_t WS_SS = 1 * MiB;
constexpr size_t WS_SS2 = 2 * MiB;
constexpr size_t WS_AB = 3 * MiB;
constexpr size_t WS_RS = 4 * MiB;
constexpr size_t WS_GC = 5 * MiB;
constexpr size_t WS_HALO = 6 * MiB;
constexpr size_t WS_WMIX = 8 * MiB;
constexpr size_t WS_WMIX_OUT = WS_WMIX + 9 * MiB;
constexpr size_t WS_WFFN = 20 * MiB;
constexpr size_t WS_WFFN_DN = WS_WFFN + 11 * MiB;
constexpr size_t WS_R1 = 40 * MiB;
constexpr size_t WS_R2 = 72 * MiB;
constexpr size_t WS_R3 = 168 * MiB;
constexpr size_t WS_R4 = 200 * MiB;
constexpr size_t WS_R5 = 232 * MiB;
constexpr size_t WS_END = 248 * MiB;

constexpr int LDS_BYTES = 147456;
constexpr int LDS_MISC = 147200;

__device__ __forceinline__ unsigned f2bf(float f) { unsigned u = __builtin_bit_cast(unsigned, f); return (u + 0x7fffu + ((u >> 16) & 1u)) >> 16; }
__device__ __forceinline__ unsigned pk2(float lo, float hi) { unsigned r; asm volatile("v_cvt_pk_bf16_f32 %0, %1, %2" : "=v"(r) : "v"(lo), "v"(hi)); return r; }
__device__ __forceinline__ float bf2f(unsigned b) { return __builtin_bit_cast(float, b << 16); }
__device__ __forceinline__ float bflo(unsigned w) { return __builtin_bit_cast(float, w << 16); }
__device__ __forceinline__ float bfhi(unsigned w) { return __builtin_bit_cast(float, w & 0xffff0000u); }
__device__ __forceinline__ float wave_sum(float v) {
#pragma unroll
    for (int o = 1; o < 64; o <<= 1) v += __shfl_xor(v, o);
    return v;
}
__device__ __forceinline__ float fexp(float x) { return __builtin_amdgcn_exp2f(x * 1.4426950408889634f); }
__device__ __forceinline__ float flog(float x) { return __builtin_amdgcn_logf(x) * 0.6931471805599453f; }
__device__ __forceinline__ float softplus_f(float z) { return fmaxf(z, 0.f) + flog(1.f + fexp(-fabsf(z))); }
__device__ __forceinline__ float silu_f(float y) { return y / (1.f + fexp(-y)); }
__device__ __forceinline__ float rowscale(const float* ss, int row, int lo, int n, float inv_dim) {
    float s = 0.f;
    for (int i = 0; i < n; i += 4) { const f32x4 v = *(const f32x4*)(ss + (size_t)row * 16 + lo + i); s += (v[0] + v[1]) + (v[2] + v[3]); }
    return 1.0f / sqrtf(s * inv_dim + EPS);
}

namespace pg8 {
#define PG8_LAS __attribute__((address_space(3)))
constexpr int BM = 256, BK = 64, HALF = 128, HTB = HALF * BK * 2, STAGE_BYTES = 8 * HTB, NXCD = 8, WGM = 8;
__host__ __device__ __forceinline__ int lds_byte(int r, int c) { const int st = (r >> 4) * 2 + (c >> 5), rr = r & 15, cc = c & 31, ob = rr * 64 + cc * 2; return st * 1024 + (ob ^ (((ob >> 9) & 1) << 5)); }
__host__ __device__ __forceinline__ void stage_rc(int b, int& R, int& C) { const int st = b / 1024, sb = b % 1024, swz = sb ^ (((sb >> 9) & 1) << 5); R = (st >> 1) * 16 + swz / 64; C = (st & 1) * 32 + (swz % 64) / 2; }
__host__ __device__ __forceinline__ int perm32(int rho) { const int n = rho >> 4, i = rho & 15; return 8 * (i >> 2) + 4 * n + (i & 3); }
struct Unit { int pm, pn; };
struct Gemm { const bf16_t* A; const bf16_t* Bt; int M, N, K, lda; };
struct StaticOrder {
    int nM, nN, nwg, G, c;
    __host__ __device__ void init(int M_, int N_, int G_, int c_) { nM = M_ / BM; nN = N_ / BM; nwg = nM * nN; G = G_; c = c_; }
    __host__ __device__ bool next(int i, Unit& u) const {
        const long L = (long)i * G + c; if (L >= nwg) return false;
        int wgid = (int)L; { const int q = nwg / NXCD, r = nwg % NXCD, xcd = wgid % NXCD, off = wgid / NXCD; wgid = (xcd < r ? xcd * (q + 1) : r * (q + 1) + (xcd - r) * q) + off; }
        const int nig = WGM * nN, gid = wgid / nig, fm = gid * WGM, gsz = (nM - fm) < WGM ? (nM - fm) : WGM;
        u.pm = fm + ((wgid % nig) % gsz); u.pn = (wgid % nig) / gsz; return true;
    }
};
template <class Epi, bool ALIGN_EPI = true>
__device__ __forceinline__ void gemm_phase(PG8_LAS unsigned char* lds, const Gemm g, const StaticOrder& S, const Epi& E, int tid_in) {
    int tid_ = tid_in; asm volatile("" : "+v"(tid_));
    const int tid = tid_, wid = __builtin_amdgcn_readfirstlane(tid >> 6), lane = tid & 63, wr = wid >> 2, wc = wid & 3, fr = lane & 15, fq = lane >> 4;
    const int K = g.K, nt = K / BK, lda = g.lda;
    unsigned voffA[2], voffB[2];
#pragma unroll
    for (int i = 0; i < 2; ++i) { int R, C; stage_rc(tid * 16 + i * 8192, R, C); const int Rb = Epi::PERM ? ((R & ~31) + perm32(R & 31)) : R;
        voffA[i] = (unsigned)(R * lda + C) * 2u; voffB[i] = (unsigned)(Rb * K + C) * 2u; }
    const size_t kstep = (size_t)(BK * 2);
    const size_t hstepA = (size_t)HALF * lda * 2, hstepB = (size_t)HALF * K * 2;
    const size_t tstepA = 2 * hstepA, tstepB = 2 * hstepB;
    const unsigned ldsw = (unsigned)wid * 1024u;
    const int aoff = lds_byte(wr * 64 + fr, fq * 8), boff = lds_byte(wc * 32 + fr, fq * 8);
#define PG8_SA(b, h) (((b) * 2 + (h)) * HTB)
#define PG8_SB(b, h) ((4 + (b) * 2 + (h)) * HTB)
#define PG8_STAGE(bufoff, gbase, voff) do { _Pragma("unroll") for (int _i = 0; _i < 2; ++_i) \
        __builtin_amdgcn_global_load_lds((const unsigned*)((const char*)(gbase) + (voff)[_i]), (PG8_LAS unsigned*)(lds + (bufoff) + ldsw + _i * 8192), 16, 0, 0); } while (0)
#define PG8_LDA(dst, b, h) do { _Pragma("unroll") for (int m = 0; m < 4; ++m) _Pragma("unroll") for (int k = 0; k < 2; ++k) dst[m][k] = *(const PG8_LAS bf16x8*)(lds + PG8_SA(b, h) + aoff + m * 2048 + k * 1024); } while (0)
#define PG8_LDB(dst, b, h) do { _Pragma("unroll") for (int n = 0; n < 2; ++n) _Pragma("unroll") for (int k = 0; k < 2; ++k) dst[n][k] = *(const PG8_LAS bf16x8*)(lds + PG8_SB(b, h) + boff + n * 2048 + k * 1024); } while (0)
#define PG8_MMA(ai, bj, At, Bt) do { __builtin_amdgcn_s_setprio(1); _Pragma("unroll") for (int m = 0; m < 4; ++m) _Pragma("unroll") for (int n = 0; n < 2; ++n) _Pragma("unroll") for (int k = 0; k < 2; ++k) \
        acc[ai][bj][m][n] = __builtin_amdgcn_mfma_f32_16x16x32_bf16(Bt[n][k], At[m][k], acc[ai][bj][m][n], 0, 0, 0); __builtin_amdgcn_s_setprio(0); } while (0)
#define PG8_WAIT_V(n) asm volatile("s_waitcnt vmcnt(" #n ")" ::: "memory")
#define PG8_WAIT_L(n) asm volatile("s_waitcnt lgkmcnt(" #n ")" ::: "memory")
#define PG8_BAR __builtin_amdgcn_s_barrier()
#define PG8_SCHED __builtin_amdgcn_sched_barrier(0)
    Unit cur, nxt; int ui = 0;
    if (!S.next(0, cur)) return;
    f32x4 acc[2][2][4][2];
#pragma unroll
    for (int a = 0; a < 2; ++a)
#pragma unroll
        for (int b = 0; b < 2; ++b)
#pragma unroll
            for (int m = 0; m < 4; ++m)
#pragma unroll
                for (int n = 0; n < 2; ++n) acc[a][b][m][n] = (f32x4){0.f, 0.f, 0.f, 0.f};
    bf16x8 At[4][2], B0[2][2], B1[2][2];
    const char* cA = (const char*)g.A + (size_t)cur.pm * tstepA; const char* cB = (const char*)g.Bt + (size_t)cur.pn * tstepB;
    PG8_STAGE(PG8_SB(0, 0), cB, voffB); PG8_STAGE(PG8_SB(0, 1), cB + hstepB, voffB); PG8_STAGE(PG8_SA(0, 0), cA, voffA); PG8_STAGE(PG8_SA(0, 1), cA + hstepA, voffA);
    if (wr == 1) PG8_BAR;
    PG8_WAIT_V(2); PG8_BAR;
    PG8_STAGE(PG8_SB(1, 0), cB + kstep, voffB); PG8_STAGE(PG8_SA(1, 0), cA + kstep, voffA); PG8_STAGE(PG8_SB(1, 1), cB + hstepB + kstep, voffB);
    PG8_WAIT_V(6); PG8_BAR;
    for (;;) {
        const bool has_next = S.next(ui + 1, nxt);
        const char* nA = has_next ? (const char*)g.A + (size_t)nxt.pm * tstepA : cA; const char* nB = has_next ? (const char*)g.Bt + (size_t)nxt.pn * tstepB : cB;
        for (int t = 0; t < nt; t += 2) {
            const bool last = (t == nt - 2);
            const char* a1 = cA + (size_t)(t + 1) * kstep;
            const char* a2 = last ? nA : cA + (size_t)(t + 2) * kstep; const char* b2 = last ? nB : cB + (size_t)(t + 2) * kstep;
            const char* a3 = a2 + kstep; const char* b3 = b2 + kstep;
            PG8_LDB(B0, 0, 0); PG8_LDB(B1, 0, 1); PG8_SCHED; PG8_LDA(At, 0, 0); PG8_STAGE(PG8_SA(1, 1), a1 + hstepA, voffA);
            PG8_WAIT_V(8); PG8_WAIT_L(0); PG8_BAR; PG8_MMA(0, 0, At, B0); PG8_MMA(0, 1, At, B1); PG8_BAR; PG8_SCHED;
            PG8_LDA(At, 0, 1); PG8_STAGE(PG8_SB(0, 0), b2, voffB); PG8_STAGE(PG8_SB(0, 1), b2 + hstepB, voffB); PG8_STAGE(PG8_SA(0, 0), a2, voffA);
            PG8_WAIT_V(8); PG8_WAIT_L(0); PG8_BAR; PG8_MMA(1, 0, At, B0); PG8_MMA(1, 1, At, B1); PG8_BAR; PG8_SCHED;
            PG8_LDB(B0, 1, 0); PG8_LDB(B1, 1, 1); PG8_SCHED; PG8_LDA(At, 1, 0); PG8_STAGE(PG8_SA(0, 1), a2 + hstepA, voffA);
            PG8_WAIT_V(8); PG8_WAIT_L(0); PG8_BAR; PG8_MMA(0, 0, At, B0); PG8_MMA(0, 1, At, B1); PG8_BAR; PG8_SCHED;
            PG8_LDA(At, 1, 1); PG8_STAGE(PG8_SB(1, 0), b3, voffB); PG8_STAGE(PG8_SB(1, 1), b3 + hstepB, voffB); PG8_STAGE(PG8_SA(1, 0), a3, voffA);
            PG8_WAIT_V(8); PG8_WAIT_L(0); PG8_BAR; PG8_MMA(1, 0, At, B0); PG8_MMA(1, 1, At, B1); PG8_BAR; PG8_SCHED;
        }
        if constexpr (ALIGN_EPI) { if (wr == 0) PG8_BAR; }
        E(acc, cur, wr, wc, fr, fq);
        if (!has_next) break;
#pragma unroll
        for (int a = 0; a < 2; ++a)
#pragma unroll
            for (int b = 0; b < 2; ++b)
#pragma unroll
                for (int m = 0; m < 4; ++m)
#pragma unroll
                    for (int n = 0; n < 2; ++n) acc[a][b][m][n] = (f32x4){0.f, 0.f, 0.f, 0.f};
        cur = nxt; cA = nA; cB = nB; ++ui;
        if constexpr (ALIGN_EPI) { if (wr == 1) PG8_BAR; }
    }
    PG8_WAIT_V(0);
    if constexpr (!ALIGN_EPI) { if (wr == 0) PG8_BAR; }
    PG8_BAR;
#undef PG8_SA
#undef PG8_SB
#undef PG8_STAGE
#undef PG8_LDA
#undef PG8_LDB
#undef PG8_MMA
#undef PG8_WAIT_V
#undef PG8_WAIT_L
#undef PG8_BAR
#undef PG8_SCHED
}

struct EpiStore {
    static constexpr bool PERM = true;
    bf16_t* O; int ldc; const float* ss; int ss_lo, ss_n; float inv_dim;
    __device__ __forceinline__ void operator()(const f32x4 (&acc)[2][2][4][2], const Unit& u, int wr, int wc, int fr, int fq) const {
#pragma unroll
        for (int ai = 0; ai < 2; ++ai)
#pragma unroll
            for (int m = 0; m < 4; ++m) {
                const int row = u.pm * BM + ai * HALF + wr * 64 + m * 16 + fr;
                const float sc = ss ? rowscale(ss, row, ss_lo, ss_n, inv_dim) : 1.f;
#pragma unroll
                for (int bj = 0; bj < 2; ++bj) {
                    const int col = u.pn * BM + bj * HALF + wc * 32 + 8 * fq;
                    const f32x4 v0 = acc[ai][bj][m][0] * sc, v1 = acc[ai][bj][m][1] * sc;
                    u32x4 w; w.x = pk2(v0[0], v0[1]); w.y = pk2(v0[2], v0[3]); w.z = pk2(v1[0], v1[1]); w.w = pk2(v1[2], v1[3]);
                    *(u32x4*)(O + (size_t)row * ldc + col) = w;
                }
                asm volatile("" ::: "memory");
            }
    }
};
struct EpiDN {
    static constexpr bool PERM = true;
    bf16_t* QKV; bf16_t* Z; float* AB; bf16_t* HALO; const float* ss;
    __device__ __forceinline__ void operator()(const f32x4 (&acc)[2][2][4][2], const Unit& u, int wr, int wc, int fr, int fq) const {
#pragma unroll
        for (int ai = 0; ai < 2; ++ai)
#pragma unroll
            for (int m = 0; m < 4; ++m) {
                const int row = u.pm * BM + ai * HALF + wr * 64 + m * 16 + fr;
                const float sc = rowscale(ss, row, 0, 16, 1.0f / D);
#pragma unroll
                for (int bj = 0; bj < 2; ++bj) {
                    const int col = u.pn * BM + bj * HALF + wc * 32 + 8 * fq;
                    const f32x4 v0 = acc[ai][bj][m][0] * sc, v1 = acc[ai][bj][m][1] * sc;
                    u32x4 w; w.x = pk2(v0[0], v0[1]); w.y = pk2(v0[2], v0[3]); w.z = pk2(v1[0], v1[1]); w.w = pk2(v1[2], v1[3]);
                    if (u.pn < 12) {
                        *(u32x4*)(QKV + (size_t)row * 3072 + col) = w;
                        const int rl = row & 255;
                        if (rl >= 253 && u.pm + 1 < 64) *(u32x4*)(HALO + ((size_t)(u.pm + 1) * 3 + (rl - 253)) * 3072 + col) = w;
                    } else if (u.pn < 16) {
                        *(u32x4*)(Z + (size_t)row * 1024 + (col - 3072)) = w;
                    } else if (bj == 0 && wc == 0 && fq < 2) {
                        *(f32x4*)(AB + (size_t)row * 16 + 8 * fq) = v0; *(f32x4*)(AB + (size_t)row * 16 + 8 * fq + 4) = v1;
                    }
                }
                asm volatile("" ::: "memory");
            }
    }
};
struct EpiSwiglu {
    static constexpr bool PERM = true;
    bf16_t* H; const float* ss;
    __device__ __forceinline__ void operator()(const f32x4 (&acc)[2][2][4][2], const Unit& u, int wr, int wc, int fr, int fq) const {
#pragma unroll
        for (int ai = 0; ai < 2; ++ai)
#pragma unroll
            for (int m = 0; m < 4; ++m) {
                const int row = u.pm * BM + ai * HALF + wr * 64 + m * 16 + fr;
                const float sc = rowscale(ss, row, 0, 16, 1.0f / D);
                const int col = u.pn * HALF + wc * 32 + 8 * fq;
                float h[8];
#pragma unroll
                for (int n = 0; n < 2; ++n)
#pragma unroll
                    for (int i = 0; i < 4; ++i) { const float gt = acc[ai][0][m][n][i] * sc, up = acc[ai][1][m][n][i] * sc; h[4 * n + i] = silu_f(gt) * up; }
                u32x4 w; w.x = pk2(h[0], h[1]); w.y = pk2(h[2], h[3]); w.z = pk2(h[4], h[5]); w.w = pk2(h[6], h[7]);
                *(u32x4*)(H + (size_t)row * FH + col) = w;
                asm volatile("" ::: "memory");
            }
    }
};
struct EpiResidual {
    static constexpr bool PERM = false;
    const float* base; float* out; bf16_t* xb; float* ss;
    __device__ __forceinline__ void operator()(const f32x4 (&acc)[2][2][4][2], const Unit& u, int wr, int wc, int fr, int fq) const {
#pragma unroll
        for (int ai = 0; ai < 2; ++ai)
#pragma unroll
            for (int m = 0; m < 4; ++m) {
                const int row = u.pm * BM + ai * HALF + wr * 64 + m * 16 + fr;
                float s = 0.f;
#pragma unroll
                for (int bj = 0; bj < 2; ++bj)
#pragma unroll
                    for (int n = 0; n < 2; ++n) {
                        const int col = u.pn * BM + bj * HALF + wc * 32 + n * 16 + 4 * fq;
                        const size_t off = (size_t)row * D + col;
                        const f32x4 v = *(const f32x4*)(base + off) + acc[ai][bj][m][n];
                        *(f32x4*)(out + off) = v;
                        u32x2 w; w.x = pk2(v[0], v[1]); w.y = pk2(v[2], v[3]);
                        *(u32x2*)(xb + off) = w;
                        s += (v[0] * v[0] + v[1] * v[1]) + (v[2] * v[2] + v[3] * v[3]);
                    }
                s += __shfl_xor(s, 16); s += __shfl_xor(s, 32);
                if (fq == 0) ss[(size_t)row * 16 + u.pn * 4 + wc] = s;
                asm volatile("" ::: "memory");
            }
    }
};
struct EpiMlaDown {
    static constexpr bool PERM = true;
    bf16_t* C; float* ss2; const float* ss;
    __device__ __forceinline__ void operator()(const f32x4 (&acc)[2][2][4][2], const Unit& u, int wr, int wc, int fr, int fq) const {
#pragma unroll
        for (int ai = 0; ai < 2; ++ai)
#pragma unroll
            for (int m = 0; m < 4; ++m) {
                const int row = u.pm * BM + ai * HALF + wr * 64 + m * 16 + fr;
                const float sc = rowscale(ss, row, 0, 16, 1.0f / D);
#pragma unroll
                for (int bj = 0; bj < 2; ++bj) {
                    const int col = u.pn * BM + bj * HALF + wc * 32 + 8 * fq;
                    const f32x4 v0 = acc[ai][bj][m][0] * sc, v1 = acc[ai][bj][m][1] * sc;
                    u32x4 w; w.x = pk2(v0[0], v0[1]); w.y = pk2(v0[2], v0[3]); w.z = pk2(v1[0], v1[1]); w.w = pk2(v1[2], v1[3]);
                    *(u32x4*)(C + (size_t)row * 512 + col) = w;
                    float s = (v0[0] * v0[0] + v0[1] * v0[1]) + (v0[2] * v0[2] + v0[3] * v0[3]) + (v1[0] * v1[0] + v1[1] * v1[1]) + (v1[2] * v1[2] + v1[3] * v1[3]);
                    s += __shfl_xor(s, 16); s += __shfl_xor(s, 32);
                    if (fq == 0) ss2[(size_t)row * 16 + u.pn * 8 + bj * 4 + wc] = s;
                }
                asm volatile("" ::: "memory");
            }
    }
};
}

#define XB_TMO      128
#define XB_XCNT(j)  (256  + 64 * (j))
#define XB_XSUB(j)  (1280 + 64 * (j))
#define XB_XGEN(j)  (2304 + 64 * (j))
#define XB_TOP      3328
#define XB_TOPGEN   3392
#define XCD_BAR_WORDS 3456
#define XB_SPIN_CAP (1u << 20)
__device__ __forceinline__ unsigned xb_ld(unsigned* p)              { return __hip_atomic_load(p, __ATOMIC_RELAXED, __HIP_MEMORY_SCOPE_AGENT); }
__device__ __forceinline__ unsigned xb_add(unsigned* p, unsigned v) { return __hip_atomic_fetch_add(p, v, __ATOMIC_RELAXED, __HIP_MEMORY_SCOPE_AGENT); }
__device__ __forceinline__ unsigned xb_xcc_id() { return (unsigned)__builtin_amdgcn_s_getreg((3 << 11) | 20) & 0xFu; }
#define XB_SPIN(cond, bar) do { unsigned _sp = 0; while (cond) { __builtin_amdgcn_s_sleep(1); \
    if ((++_sp & 255u) == 0u) { if (xb_ld(&(bar)[XB_TMO])) break; if (_sp > XB_SPIN_CAP) { atomicAdd(&(bar)[XB_TMO], 1u); break; } } } } while (0)
struct XcdBarrier { unsigned* bar; unsigned x; volatile LAS unsigned* st; };
__device__ __forceinline__ XcdBarrier xcd_barrier_post(unsigned* bar, volatile LAS unsigned* st, int tid) {
    XcdBarrier b; b.bar = bar; b.x = xb_xcc_id(); b.st = st;
    if (tid == 0) (void)xb_add(&bar[XB_XCNT(b.x)], 1u);
    return b;
}
__device__ __forceinline__ void xcd_barrier_complete(unsigned* bar, unsigned x, unsigned& nloc, unsigned& nx) {
    const unsigned G = gridDim.x * gridDim.y * gridDim.z;
    unsigned sum, cnt, mine, sp = 0u;
    for (;;) {
        sum = 0u; cnt = 0u; mine = 0u;
#pragma unroll
        for (unsigned j = 0; j < 16; ++j) { const unsigned c = xb_ld(&bar[XB_XCNT(j)]); sum += c; cnt += (c > 0u) ? 1u : 0u; mine = (j == x) ? c : mine; }
        if (sum == G) break;
        __builtin_amdgcn_s_sleep(1);
        if ((++sp & 255u) == 0u) { if (xb_ld(&bar[XB_TMO])) break; if (sp > XB_SPIN_CAP) { atomicAdd(&bar[XB_TMO], 1u); break; } }
    }
    nloc = mine > 0u ? mine : 1u; nx = cnt > 0u ? cnt : 1u;
}
__device__ __forceinline__ void xcd_barrier(const XcdBarrier& b, int tid) {
    asm volatile("s_waitcnt vmcnt(0)" ::: "memory");
    __syncthreads();
    if (tid == 0) {
        unsigned* bar = b.bar;
        __builtin_amdgcn_s_waitcnt(0);
        unsigned nloc = b.st[0], nx = b.st[1];
        if (nloc == 0u) { xcd_barrier_complete(bar, b.x, nloc, nx); b.st[0] = nloc; b.st[1] = nx; }
        const unsigned old = xb_add(&bar[XB_XSUB(b.x)], 1u);
        const unsigned gen = old / nloc;
        if (old + 1u == (gen + 1u) * nloc) {
            __builtin_amdgcn_fence(__ATOMIC_RELEASE, "agent");
            asm volatile("s_waitcnt vmcnt(0)" ::: "memory");
            const unsigned og = xb_add(&bar[XB_TOP], 1u);
            const unsigned tg = og / nx;
            if (og + 1u == (tg + 1u) * nx) xb_add(&bar[XB_TOPGEN], 1u);
            else XB_SPIN(xb_ld(&bar[XB_TOPGEN]) == tg, bar);
            __builtin_amdgcn_fence(__ATOMIC_ACQUIRE, "agent");
            xb_add(&bar[XB_XGEN(b.x)], 1u);
            asm volatile("s_waitcnt vmcnt(0)" ::: "memory");
        } else {
            XB_SPIN(xb_ld(&bar[XB_XGEN(b.x)]) == gen, bar);
            __builtin_amdgcn_fence(__ATOMIC_ACQUIRE, "agent");
            asm volatile("s_waitcnt vmcnt(0)" ::: "memory");
        }
    }
    __syncthreads();
}

__device__ __forceinline__ void cvt_item(const float* W, int K, int N, bf16_t* WT, const float* gain, int swiglu, LAS float* scr, int item, int lane) {
    const int nblk = (N + 31) / 32, kb = item / nblk, nb = item % nblk, k0 = 64 * kb, n0 = 32 * nb;
    const int nn = n0 + (lane & 31);
#pragma unroll 8
    for (int i = 0; i < 32; ++i) { const int kk = 2 * i + (lane >> 5);
        float v = (nn < N) ? W[(size_t)(k0 + kk) * N + nn] : 0.f;
        if (gain) v *= gain[k0 + kk];
        scr[kk * 33 + (lane & 31)] = v; }
    asm volatile("s_waitcnt lgkmcnt(0)" ::: "memory");
    const int c = lane & 7;
#pragma unroll
    for (int j = 0; j < 4; ++j) { const int n = (lane >> 3) + 8 * j; const LAS float* s = scr + (8 * c) * 33 + n;
        u32x4 o; o.x = pk2(s[0 * 33], s[1 * 33]); o.y = pk2(s[2 * 33], s[3 * 33]); o.z = pk2(s[4 * 33], s[5 * 33]); o.w = pk2(s[6 * 33], s[7 * 33]);
        int dn = n0 + n;
        if (swiglu) { const int isup = dn >= FH; const int jj = isup ? dn - FH : dn; dn = (jj >> 7) * 256 + isup * 128 + (jj & 127); }
        *(u32x4*)(WT + (size_t)dn * K + k0 + 8 * c) = o; }
    asm volatile("s_waitcnt lgkmcnt(0)" ::: "memory");
}
__device__ __forceinline__ void cvt_weight(const float* W, int K, int N, int Npad, bf16_t* WT, const float* gain, int swiglu, LAS unsigned char* lds, int gw, int ngw, int wave, int lane) {
    LAS float* scr = (LAS float*)(lds + wave * 8704);
    const int nblk = (N + 31) / 32, nitems = (K / 64) * nblk;
    for (int it = gw; it < nitems; it += ngw) cvt_item(W, K, N, WT, gain, swiglu, scr, it, lane);
    const int zr0 = nblk * 32; const int nz = (Npad - zr0) * (K / 8);
    unsigned z0 = 0u; asm volatile("" : "+v"(z0));
    for (int i = gw * 64 + lane; i < nz; i += ngw * 64) *(u32x4*)(WT + (size_t)zr0 * K + (size_t)i * 8) = (u32x4){z0, z0, z0, z0};
}

struct Args { const float* in[43]; float* out; unsigned char* ws; int ph_lo, ph_hi; };

struct Ctx {
    LAS unsigned char* lds; unsigned char* ws; int tid, lane, wave, gw, ngw;
};

__device__ __forceinline__ void convert_mixer(const Args& a, const Ctx& c, int L) {
    unsigned char* ws = c.ws;
    if (L == 0 || L == 3) {
        const int b = (L == 0) ? 1 : 33;
        cvt_weight(a.in[b + 1], D, 4112, 4352, (bf16_t*)(ws + WS_WMIX), a.in[b], 0, c.lds, c.gw, c.ngw, c.wave, c.lane);
        cvt_weight(a.in[b + 6], D, D, D, (bf16_t*)(ws + WS_WMIX_OUT), nullptr, 0, c.lds, c.gw, c.ngw, c.wave, c.lane);
    } else if (L == 1) {
        cvt_weight(a.in[12], D, 3072, 3072, (bf16_t*)(ws + WS_WMIX), a.in[11], 0, c.lds, c.gw, c.ngw, c.wave, c.lane);
        cvt_weight(a.in[15], D, D, D, (bf16_t*)(ws + WS_WMIX_OUT), nullptr, 0, c.lds, c.gw, c.ngw, c.wave, c.lane);
    } else {
        cvt_weight(a.in[20], D, 448, 512, (bf16_t*)(ws + WS_WMIX), a.in[19], 0, c.lds, c.gw, c.ngw, c.wave, c.lane);
        cvt_weight(a.in[23], 256, 1536, 1536, (bf16_t*)(ws + WS_WMIX + 1 * MiB), a.in[21], 0, c.lds, c.gw, c.ngw, c.wave, c.lane);
        cvt_weight(a.in[24], 128, 2048, 2048, (bf16_t*)(ws + WS_WMIX + 2 * MiB), a.in[22], 0, c.lds, c.gw, c.ngw, c.wave, c.lane);
        cvt_weight(a.in[29], D, D, D, (bf16_t*)(ws + WS_WMIX_OUT), nullptr, 0, c.lds, c.gw, c.ngw, c.wave, c.lane);
    }
}
__device__ __forceinline__ void convert_ffn(const Args& a, const Ctx& c, int L) {
    const int b = (L == 0) ? 8 : (L == 1) ? 16 : (L == 2) ? 30 : 40;
    cvt_weight(a.in[b + 1], D, 2 * FH, 2 * FH, (bf16_t*)(c.ws + WS_WFFN), a.in[b], 1, c.lds, c.gw, c.ngw, c.wave, c.lane);
    cvt_weight(a.in[b + 2], FH, D, D, (bf16_t*)(c.ws + WS_WFFN_DN), nullptr, 0, c.lds, c.gw, c.ngw, c.wave, c.lane);
}

__device__ __forceinline__ void prologue_rows(const Args& a, const Ctx& c) {
    const float* x = a.in[0]; bf16_t* xb = (bf16_t*)(c.ws + WS_R1); float* ss = (float*)(c.ws + WS_SS);
    for (int m = c.gw; m < M; m += c.ngw) {
        const f32x4* xr = (const f32x4*)(x + (size_t)m * D) + c.lane;
        f32x4 v[4]; float s = 0.f;
#pragma unroll
        for (int j = 0; j < 4; ++j) { v[j] = xr[64 * j]; s += (v[j][0] * v[j][0] + v[j][1] * v[j][1]) + (v[j][2] * v[j][2] + v[j][3] * v[j][3]); }
        s = wave_sum(s);
        u32x2* o = (u32x2*)(xb + (size_t)m * D) + c.lane;
#pragma unroll
        for (int j = 0; j < 4; ++j) { u32x2 w; w.x = pk2(v[j][0], v[j][1]); w.y = pk2(v[j][2], v[j][3]); o[64 * j] = w; }
        if (c.lane < 16) ss[(size_t)m * 16 + c.lane] = (c.lane == 0) ? s : 0.f;
    }
}

__device__ __forceinline__ void dn_conv(const Args& a, const Ctx& c, const float* conv_w) {
    bf16_t* QKV = (bf16_t*)(c.ws + WS_R2); const bf16_t* HALO = (const bf16_t*)(c.ws + WS_HALO); float* RS = (float*)(c.ws + WS_RS);
    const int cg8 = c.tid & 15, seg = c.tid >> 4;
    for (int item = blockIdx.x; item < 64 * 24; item += gridDim.x) {
        const int pm = item / 24, slab = item % 24, which = slab >> 3, h = slab & 7;
        const int gcol = slab * 128 + cg8 * 8; const int row0 = pm * 256 + seg * 8;
        u32x4 raw[11];
#pragma unroll
        for (int i = 0; i < 3; ++i) {
            if (seg == 0) { raw[i] = ((pm & 15) == 0) ? (u32x4){0u, 0u, 0u, 0u} : *(const u32x4*)(HALO + ((size_t)pm * 3 + i) * 3072 + gcol); }
            else raw[i] = *(const u32x4*)(QKV + (size_t)(row0 - 3 + i) * 3072 + gcol);
        }
#pragma unroll
        for (int i = 0; i < 8; ++i) raw[3 + i] = *(const u32x4*)(QKV + (size_t)(row0 + i) * 3072 + gcol);
        float w[4][8];
#pragma unroll
        for (int j = 0; j < 4; ++j) { const f32x4 w0 = *(const f32x4*)(conv_w + j * 3072 + gcol), w1 = *(const f32x4*)(conv_w + j * 3072 + gcol + 4);
#pragma unroll
            for (int e = 0; e < 4; ++e) { w[j][e] = w0[e]; w[j][4 + e] = w1[e]; } }
        __syncthreads();
#pragma unroll
        for (int r = 0; r < 8; ++r) {
            u32x4 o; float ssq = 0.f;
#pragma unroll
            for (int e2 = 0; e2 < 4; ++e2) {
                float y0 = 0.f, y1 = 0.f;
#pragma unroll
                for (int j = 0; j < 4; ++j) { const unsigned wv = raw[r + j][e2]; y0 += w[j][2 * e2] * bflo(wv); y1 += w[j][2 * e2 + 1] * bfhi(wv); }
                const unsigned pk = pk2(silu_f(y0), silu_f(y1)); o[e2] = pk;
                const float s0 = bflo(pk), s1 = bfhi(pk); ssq += s0 * s0 + s1 * s1;
            }
            *(u32x4*)(QKV + (size_t)(row0 + r) * 3072 + gcol) = o;
            if (which < 2) {
                ssq += __shfl_xor(ssq, 1); ssq += __shfl_xor(ssq, 2); ssq += __shfl_xor(ssq, 4); ssq += __shfl_xor(ssq, 8);
                if (cg8 == 0) RS[(size_t)(row0 + r) * 16 + which * 8 + h] = (1.0f / sqrtf(ssq + EPS)) * (which == 0 ? 0.08838834764831845f : 1.f);
            }
        }
        __syncthreads();
    }
}

constexpr int DB_LM = 0, DB_GC = 17408, DB_BETA = 17664, DB_KB = 17920, DB_QB = 35328, DB_K32 = 52736, DB_V32 = 86528;
__device__ __forceinline__ void dn_chunk(const Args& a, const Ctx& c, const float* a_log, const float* dt_bias) {
    bf16_t* QKV = (bf16_t*)(c.ws + WS_R2); bf16_t* KT = (bf16_t*)(c.ws + WS_R1); bf16_t* ATT = (bf16_t*)(c.ws + WS_R5);
    const float* AB = (const float*)(c.ws + WS_AB); const float* RS = (const float*)(c.ws + WS_RS); float* GC = (float*)(c.ws + WS_GC);
    LAS bf16_t* kb = (LAS bf16_t*)(c.lds + DB_KB); LAS bf16_t* qb = (LAS bf16_t*)(c.lds + DB_QB);
    LAS float* K32 = (LAS float*)(c.lds + DB_K32); LAS float* V32 = (LAS float*)(c.lds + DB_V32); LAS float* Lm = (LAS float*)(c.lds + DB_LM);
    LAS float* gcs = (LAS float*)(c.lds + DB_GC); LAS float* betas = (LAS float*)(c.lds + DB_BETA);
    const int lane = c.lane, wave = c.wave, quad = lane >> 4, l15 = lane & 15;
    for (int item = blockIdx.x; item < BATCH * 64 * NH; item += gridDim.x) {
        const int h = item & 7, n = (item >> 3) & 63, b = item >> 9;
        const int t0 = b * SEQ + n * 64;
        if (wave == 0) {
            const float av = AB[(size_t)(t0 + lane) * 16 + h], bl = AB[(size_t)(t0 + lane) * 16 + 8 + h];
            float g = -fexp(a_log[h]) * softplus_f(av + dt_bias[h]);
#pragma unroll
            for (int o = 1; o < 64; o <<= 1) { const float t = __shfl_up(g, o); if (lane >= o) g += t; }
            gcs[lane] = g; betas[lane] = 1.f / (1.f + fexp(-bl));
            GC[(size_t)(t0 + lane) * 8 + h] = g;
        }
        __syncthreads();
        {
            const int r = c.tid >> 3, cc = (c.tid & 7) * 16;
            const size_t rowoff = (size_t)(t0 + r) * 3072 + h * 128 + cc;
            const float rsq = RS[(size_t)(t0 + r) * 16 + h], rsk = RS[(size_t)(t0 + r) * 16 + 8 + h];
            const float be = betas[r], eg = fexp(gcs[r]);
            u32x4 qw[2], kw[2], vw[2];
#pragma unroll
            for (int i = 0; i < 2; ++i) { qw[i] = *(const u32x4*)(QKV + rowoff + 8 * i); kw[i] = *(const u32x4*)(QKV + rowoff + 1024 + 8 * i); vw[i] = *(const u32x4*)(QKV + rowoff + 2048 + 8 * i); }
#pragma unroll
            for (int i = 0; i < 2; ++i) {
                u32x4 qo, ko;
#pragma unroll
                for (int j = 0; j < 4; ++j) {
                    const float q0 = bflo(qw[i][j]) * rsq, q1 = bfhi(qw[i][j]) * rsq;
                    const float k0 = bflo(kw[i][j]) * rsk, k1 = bfhi(kw[i][j]) * rsk;
                    const float v0 = bflo(vw[i][j]), v1 = bfhi(vw[i][j]);
                    qo[j] = pk2(q0, q1); ko[j] = pk2(k0, k1);
                    const int cidx = cc + 8 * i + 2 * j;
                    K32[r * 132 + cidx] = k0 * be * eg; K32[r * 132 + cidx + 1] = k1 * be * eg;
                    V32[r * 132 + cidx] = v0 * be; V32[r * 132 + cidx + 1] = v1 * be;
                }
                *(LAS u32x4*)(qb + r * 136 + cc + 8 * i) = qo; *(LAS u32x4*)(kb + r * 136 + cc + 8 * i) = ko;
            }
        }
        __syncthreads();
        {
            const int wm = wave & 3; const LAS bf16_t* Asrc = (wave < 4) ? kb : qb;
            f32x4 acc[4];
#pragma unroll
            for (int nt = 0; nt < 4; ++nt) acc[nt] = (f32x4){0.f, 0.f, 0.f, 0.f};
#pragma unroll
            for (int ks = 0; ks < 4; ++ks) {
                const bf16x8 af = *(const LAS bf16x8*)(Asrc + (16 * wm + l15) * 136 + 32 * ks + 8 * quad);
#pragma unroll
                for (int nt = 0; nt < 4; ++nt) {
                    const bf16x8 bfr = *(const LAS bf16x8*)(kb + (16 * nt + l15) * 136 + 32 * ks + 8 * quad);
                    acc[nt] = __builtin_amdgcn_mfma_f32_16x16x32_bf16(af, bfr, acc[nt], 0, 0, 0);
                }
            }
            bf16_t* att = ATT + (size_t)((b * NH + h) * 64 + n) * 4096;
#pragma unroll
            for (int nt = 0; nt < 4; ++nt)
#pragma unroll
                for (int r = 0; r < 4; ++r) {
                    const int cr = 16 * wm + 4 * quad + r, cs = 16 * nt + l15;
                    const float dec = fexp(fminf(gcs[cr] - gcs[cs], 0.f));
                    if (wave < 4) Lm[cr * 68 + cs] = (cr > cs) ? betas[cr] * acc[nt][r] * dec : 0.f;
                    else att[cr * 64 + cs] = (bf16_t)f2bf((cr >= cs) ? acc[nt][r] * dec : 0.f);
                }
        }
        __syncthreads();
        if (wave < 4) {
            const int j = wave * 64 + lane;
            const LAS float* rhs = (j < 128) ? (V32 + j) : (K32 + (j - 128));
            float sol[64];
#pragma unroll
            for (int i = 0; i < 64; ++i) {
                float a0 = rhs[i * 132], a1 = 0.f;
#pragma unroll
                for (int jb = 0; jb < i; jb += 4) {
                    const f32x4 lv = *(const LAS f32x4*)(Lm + i * 68 + jb);
                    a0 -= lv[0] * sol[jb];
                    if (jb + 1 < i) a1 -= lv[1] * sol[jb + 1];
                    if (jb + 2 < i) a0 -= lv[2] * sol[jb + 2];
                    if (jb + 3 < i) a1 -= lv[3] * sol[jb + 3];
                }
                sol[i] = a0 + a1;
            }
            bf16_t* dst = QKV + (size_t)t0 * 3072 + ((j < 128) ? (2048 + h * 128 + j) : (1024 + h * 128 + (j - 128)));
#pragma unroll
            for (int i = 0; i < 64; ++i) dst[(size_t)i * 3072] = (bf16_t)f2bf(sol[i]);
        } else {
            const int t = c.tid - 256, dk = t & 127, ch = t >> 7;
            bf16_t* kt = KT + (size_t)((b * NH + h) * 64 + n) * 8192 + dk * 64 + ch * 32;
#pragma unroll
            for (int g4 = 0; g4 < 4; ++g4) {
                u32x4 w;
#pragma unroll
                for (int e = 0; e < 4; ++e) { const int cc = ch * 32 + g4 * 8 + 2 * e; w[e] = (unsigned)kb[cc * 136 + dk] | ((unsigned)kb[(cc + 1) * 136 + dk] << 16); }
                *(u32x4*)(kt + g4 * 8) = w;
            }
            const int r = t >> 2, c0 = (t & 3) * 32;
#pragma unroll
            for (int i = 0; i < 4; ++i) *(u32x4*)(QKV + (size_t)(t0 + r) * 3072 + h * 128 + c0 + 8 * i) = *(const LAS u32x4*)(qb + r * 136 + c0 + 8 * i);
        }
        __syncthreads();
    }
}

__device__ __forceinline__ bf16x8 ld2x4(const bf16_t* p) {
    const u32x2 lo = *(const u32x2*)p, hi = *(const u32x2*)(p + 16);
    u32x4 w; w.x = lo.x; w.y = lo.y; w.z = hi.x; w.w = hi.y; return __builtin_bit_cast(bf16x8, w);
}
__device__ __forceinline__ bf16x8 pack8(const f32x4 a, const f32x4 b) {
    u32x4 w; w.x = pk2(a[0], a[1]); w.y = pk2(a[2], a[3]); w.z = pk2(b[0], b[1]); w.w = pk2(b[2], b[3]); return __builtin_bit_cast(bf16x8, w);
}
constexpr int SC_W = 0, SC_Q = 17408, SC_KT = 34816, SC_ATT = 53248, SC_U = 62464, SC_GC = 71680, SC_BUF = 71936;
__device__ __forceinline__ bf16x8 ld2x4_lds(const LAS bf16_t* p) {
    const u32x2 lo = *(const LAS u32x2*)p, hi = *(const LAS u32x2*)(p + 16);
    u32x4 w; w.x = lo.x; w.y = lo.y; w.z = hi.x; w.w = hi.y; return __builtin_bit_cast(bf16x8, w);
}
__device__ __forceinline__ void dn_scan(const Args& a, const Ctx& c) {
    const bf16_t* QKV = (const bf16_t*)(c.ws + WS_R2); const bf16_t* KT = (const bf16_t*)(c.ws + WS_R1); const bf16_t* ATT = (const bf16_t*)(c.ws + WS_R5);
    const float* GC = (const float*)(c.ws + WS_GC); bf16_t* O = (bf16_t*)(c.ws + WS_R4);
    const int lane = c.lane, wave = c.wave, quad = lane >> 4, l15 = lane & 15;
    for (int item = blockIdx.x; item < BATCH * NH * 2; item += gridDim.x) {
        const int half = item & 1, bh = item >> 1, b = bh >> 3, h = bh & 7;
        __syncthreads();
        const int pair = (wave >= 6) ? 1 : 0, lt = (c.tid - 256) & 127;
        u32x4 lv[32]; float lg = 0.f;
#define SCAN_LOAD(step) do { const int t0_ = b * SEQ + (step) * 64; const size_t ci_ = (size_t)(bh * 64 + (step)); \
            _Pragma("unroll") for (int i = 0; i < 8; ++i) { const int id = lt + 128 * i, row = id >> 4, ch = id & 15; \
                const bf16_t* p_ = QKV + (size_t)(t0_ + row) * 3072 + h * 128 + ch * 8; lv[i] = *(const u32x4*)(p_ + 1024); lv[8 + i] = *(const u32x4*)p_; } \
            _Pragma("unroll") for (int i = 0; i < 8; ++i) { const int id = lt + 128 * i; lv[16 + i] = *(const u32x4*)(KT + ci_ * 8192 + (size_t)id * 8); } \
            _Pragma("unroll") for (int i = 0; i < 4; ++i) { const int id = lt + 128 * i, row = id >> 3, ch = id & 7; \
                lv[24 + i] = *(const u32x4*)(ATT + ci_ * 4096 + (size_t)id * 8); \
                lv[28 + i] = *(const u32x4*)(QKV + (size_t)(t0_ + row) * 3072 + 2048 + h * 128 + half * 64 + ch * 8); } \
            if (lt < 64) lg = GC[(size_t)(t0_ + lt) * 8 + h]; } while (0)
        if (wave >= 4) { if (pair == 0) { SCAN_LOAD(0); } else { SCAN_LOAD(1); } }
        if (wave >= 4) {
            for (int n = -1; n < 64; ++n) {
                if (((n + 1) & 1) == pair) {
                    { const int nn = n + 1;
                      LAS unsigned char* buf = c.lds + (nn & 1) * SC_BUF;
#pragma unroll
                      for (int i = 0; i < 8; ++i) { const int id = lt + 128 * i, row = id >> 4, ch = id & 15;
                          *(LAS u32x4*)(buf + SC_W + (row * 136 + ch * 8) * 2) = lv[i]; *(LAS u32x4*)(buf + SC_Q + (row * 136 + ch * 8) * 2) = lv[8 + i]; }
#pragma unroll
                      for (int i = 0; i < 8; ++i) { const int id = lt + 128 * i, row = id >> 3, ch = id & 7; *(LAS u32x4*)(buf + SC_KT + (row * 72 + ch * 8) * 2) = lv[16 + i]; }
#pragma unroll
                      for (int i = 0; i < 4; ++i) { const int id = lt + 128 * i, row = id >> 3, ch = id & 7;
                          *(LAS u32x4*)(buf + SC_ATT + (row * 72 + ch * 8) * 2) = lv[24 + i]; *(LAS u32x4*)(buf + SC_U + (row * 72 + ch * 8) * 2) = lv[28 + i]; }
                      if (lt < 64) *(LAS float*)(buf + SC_GC + lt * 4) = lg; }
                    if (n + 3 < 64) { SCAN_LOAD(n + 3); }
                }
                __syncthreads();
            }
        } else {
            f32x4 S[8];
#pragma unroll
            for (int mt = 0; mt < 8; ++mt) S[mt] = (f32x4){0.f, 0.f, 0.f, 0.f};
            __syncthreads();
            for (int n = 0; n < 64; ++n) {
                const LAS unsigned char* buf = c.lds + (n & 1) * SC_BUF;
                const LAS bf16_t* Wl = (const LAS bf16_t*)(buf + SC_W); const LAS bf16_t* Ql = (const LAS bf16_t*)(buf + SC_Q);
                const LAS bf16_t* Kl = (const LAS bf16_t*)(buf + SC_KT); const LAS bf16_t* Al = (const LAS bf16_t*)(buf + SC_ATT);
                const LAS bf16_t* Ul = (const LAS bf16_t*)(buf + SC_U); const LAS float* gcl = (const LAS float*)(buf + SC_GC);
                const int t0 = b * SEQ + n * 64;
                bf16x8 Sb[4];
#pragma unroll
                for (int ks = 0; ks < 4; ++ks) Sb[ks] = pack8(S[2 * ks], S[2 * ks + 1]);
                f32x4 P[4], QS[4];
#pragma unroll
                for (int ct = 0; ct < 4; ++ct) { P[ct] = (f32x4){0.f, 0.f, 0.f, 0.f}; QS[ct] = (f32x4){0.f, 0.f, 0.f, 0.f}; }
#pragma unroll
                for (int ct = 0; ct < 4; ++ct)
#pragma unroll
                    for (int ks = 0; ks < 4; ++ks) {
                        const int off = (16 * ct + l15) * 136 + 32 * ks + 4 * quad;
                        P[ct] = __builtin_amdgcn_mfma_f32_16x16x32_bf16(ld2x4_lds(Wl + off), Sb[ks], P[ct], 0, 0, 0);
                        QS[ct] = __builtin_amdgcn_mfma_f32_16x16x32_bf16(ld2x4_lds(Ql + off), Sb[ks], QS[ct], 0, 0, 0);
                    }
                const float gL = gcl[63];
                f32x4 vn[4], vd[4], o[4];
#pragma unroll
                for (int ct = 0; ct < 4; ++ct)
#pragma unroll
                    for (int r = 0; r < 4; ++r) {
                        const int cr = 16 * ct + 4 * quad + r;
                        const float u = bf2f(Ul[cr * 72 + 16 * wave + l15]);
                        const float g = gcl[cr];
                        const float v = u - P[ct][r];
                        vn[ct][r] = v; vd[ct][r] = v * fexp(gL - g); o[ct][r] = QS[ct][r] * fexp(g);
                    }
                bf16x8 Vb[2], Vdb[2];
#pragma unroll
                for (int k2 = 0; k2 < 2; ++k2) { Vb[k2] = pack8(vn[2 * k2], vn[2 * k2 + 1]); Vdb[k2] = pack8(vd[2 * k2], vd[2 * k2 + 1]); }
#pragma unroll
                for (int ct = 0; ct < 4; ++ct)
#pragma unroll
                    for (int k2 = 0; k2 < 2; ++k2)
                        o[ct] = __builtin_amdgcn_mfma_f32_16x16x32_bf16(ld2x4_lds(Al + (16 * ct + l15) * 72 + 32 * k2 + 4 * quad), Vb[k2], o[ct], 0, 0, 0);
#pragma unroll
                for (int ct = 0; ct < 4; ++ct)
#pragma unroll
                    for (int r = 0; r < 4; ++r) O[(size_t)(t0 + 16 * ct + 4 * quad + r) * 1024 + h * 128 + (half * 4 + wave) * 16 + l15] = (bf16_t)f2bf(o[ct][r]);
                const float eL = fexp(gL);
#pragma unroll
                for (int mt = 0; mt < 8; ++mt) {
                    S[mt] = S[mt] * eL;
#pragma unroll
                    for (int k2 = 0; k2 < 2; ++k2)
                        S[mt] = __builtin_amdgcn_mfma_f32_16x16x32_bf16(ld2x4_lds(Kl + (16 * mt + l15) * 72 + 32 * k2 + 4 * quad), Vdb[k2], S[mt], 0, 0, 0);
                }
                __syncthreads();
            }
        }
    }
}

__device__ __forceinline__ void dn_post(const Args& a, const Ctx& c, const float* out_norm) {
    bf16_t* O = (bf16_t*)(c.ws + WS_R4); const bf16_t* Z = (const bf16_t*)(c.ws + WS_R3);
    const int cb = (c.lane & 7) * 16;
    float gn[16];
#pragma unroll
    for (int i = 0; i < 16; ++i) gn[i] = out_norm[cb + i];
    for (int m = c.gw; m < M; m += c.ngw) {
        u32x4 ow[2], zw[2];
#pragma unroll
        for (int i = 0; i < 2; ++i) { ow[i] = *(const u32x4*)(O + (size_t)m * D + c.lane * 16 + 8 * i); zw[i] = *(const u32x4*)(Z + (size_t)m * D + c.lane * 16 + 8 * i); }
        float ov[16], s = 0.f;
#pragma unroll
        for (int i = 0; i < 2; ++i)
#pragma unroll
            for (int j = 0; j < 4; ++j) { ov[8 * i + 2 * j] = bflo(ow[i][j]); ov[8 * i + 2 * j + 1] = bfhi(ow[i][j]); }
#pragma unroll
        for (int i = 0; i < 16; ++i) s += ov[i] * ov[i];
        s += __shfl_xor(s, 1); s += __shfl_xor(s, 2); s += __shfl_xor(s, 4);
        const float rs = 1.0f / sqrtf(s * (1.0f / 128.0f) + EPS);
        u32x4 res[2];
#pragma unroll
        for (int i = 0; i < 2; ++i)
#pragma unroll
            for (int j = 0; j < 4; ++j) {
                const float z0 = bflo(zw[i][j]), z1 = bfhi(zw[i][j]);
                res[i][j] = pk2(ov[8 * i + 2 * j] * rs * gn[8 * i + 2 * j] * silu_f(z0), ov[8 * i + 2 * j + 1] * rs * gn[8 * i + 2 * j + 1] * silu_f(z1));
            }
#pragma unroll
        for (int i = 0; i < 2; ++i) *(u32x4*)(O + (size_t)m * D + c.lane * 16 + 8 * i) = res[i];
    }
}

__device__ __forceinline__ void v_transpose(const Ctx& c, const bf16_t* src, int pitch, int head_stride, int col_base, bf16_t* Vt) {
    LAS bf16_t* tile = (LAS bf16_t*)c.lds;
    for (int item = blockIdx.x; item < BATCH * NH * 64; item += gridDim.x) {
        const int tb = item & 63, h = (item >> 6) & 7, b = item >> 9;
        const int t0 = b * SEQ + tb * 64;
        { const int r = c.tid >> 3, cc = (c.tid & 7) * 16;
          const bf16_t* p = src + (size_t)(t0 + r) * pitch + col_base + h * head_stride + cc;
          *(LAS u32x4*)(tile + r * 136 + cc) = *(const u32x4*)p; *(LAS u32x4*)(tile + r * 136 + cc + 8) = *(const u32x4*)(p + 8); }
        __syncthreads();
        { const int d = c.tid >> 2, tq = (c.tid & 3) * 16;
          u32x4 w[2];
#pragma unroll
          for (int i = 0; i < 2; ++i)
#pragma unroll
              for (int e = 0; e < 4; ++e) { const int t = tq + 8 * i + 2 * e; w[i][e] = (unsigned)tile[t * 136 + d] | ((unsigned)tile[(t + 1) * 136 + d] << 16); }
          bf16_t* dst = Vt + ((size_t)((b * NH + h) * 128 + d)) * SEQ + tb * 64 + tq;
          *(u32x4*)dst = w[0]; *(u32x4*)(dst + 8) = w[1]; }
        __syncthreads();
    }
}

__device__ __forceinline__ void sb_prep_rows(const Args& a, const Ctx& c, const float* qn, const float* kn) {
    bf16_t* QKV = (bf16_t*)(c.ws + WS_R2);
    const int cb = (c.lane & 7) * 16;
    float gq[16], gk[16];
#pragma unroll
    for (int i = 0; i < 16; ++i) { gq[i] = qn[cb + i] * 0.08838834764831845f; gk[i] = kn[cb + i]; }
    for (int m = c.gw; m < M; m += c.ngw) {
#pragma unroll
        for (int which = 0; which < 2; ++which) {
            bf16_t* p = QKV + (size_t)m * 3072 + which * 1024 + c.lane * 16;
            u32x4 w[2]; w[0] = *(const u32x4*)p; w[1] = *(const u32x4*)(p + 8);
            float v[16], s = 0.f;
#pragma unroll
            for (int i = 0; i < 2; ++i)
#pragma unroll
                for (int j = 0; j < 4; ++j) { v[8 * i + 2 * j] = bflo(w[i][j]); v[8 * i + 2 * j + 1] = bfhi(w[i][j]); }
#pragma unroll
            for (int i = 0; i < 16; ++i) s += v[i] * v[i];
            s += __shfl_xor(s, 1); s += __shfl_xor(s, 2); s += __shfl_xor(s, 4);
            const float rs = 1.0f / sqrtf(s * (1.0f / 128.0f) + EPS);
            u32x4 o[2];
#pragma unroll
            for (int i = 0; i < 2; ++i)
#pragma unroll
                for (int j = 0; j < 4; ++j) {
                    const float g0 = which ? gk[8 * i + 2 * j] : gq[8 * i + 2 * j], g1 = which ? gk[8 * i + 2 * j + 1] : gq[8 * i + 2 * j + 1];
                    o[i][j] = pk2(v[8 * i + 2 * j] * rs * g0, v[8 * i + 2 * j + 1] * rs * g1);
                }
            *(u32x4*)p = o[0]; *(u32x4*)(p + 8) = o[1];
        }
    }
}

__device__ __forceinline__ void mla_prep_rows(const Args& a, const Ctx& c) {
    bf16_t* Q = (bf16_t*)(c.ws + WS_R2); bf16_t* Kf = (bf16_t*)(c.ws + WS_R2 + 48 * MiB);
    const bf16_t* KV = (const bf16_t*)(c.ws + WS_R3); const bf16_t* C = (const bf16_t*)(c.ws + WS_R5);
    const float* gqn = a.in[25]; const float* gqr = a.in[26]; const float* gkn = a.in[27]; const float* gkr = a.in[28];
    const int lane = c.lane, h = lane >> 3, p = lane & 7;
    const float SC = 0.07216878364870322f;
    float g_qn[16], g_kn[16], g_qr[8], g_kr[8], invf[8];
#pragma unroll
    for (int i = 0; i < 16; ++i) { g_qn[i] = gqn[16 * p + i] * SC; g_kn[i] = gkn[16 * p + i]; }
#pragma unroll
    for (int i = 0; i < 8; ++i) { g_qr[i] = gqr[8 * p + i] * SC; g_kr[i] = gkr[8 * p + i];
        invf[i] = __builtin_amdgcn_exp2f(-(float)(2 * ((8 * p + i) & 31)) * (1.0f / 64.0f) * 13.287712379549449f); }
    const bool first = p < 4;
    for (int m = c.gw; m < M; m += c.ngw) {
        const int t = m & (SEQ - 1);
        const bf16_t* qp = Q + (size_t)m * 1536 + h * 192;
        const u32x4 qn0 = *(const u32x4*)(qp + 16 * p), qn1 = *(const u32x4*)(qp + 16 * p + 8), qr = *(const u32x4*)(qp + 128 + 8 * p);
        const bf16_t* kvp = KV + (size_t)m * 2048 + h * 256;
        const u32x4 kn0 = *(const u32x4*)(kvp + 16 * p), kn1 = *(const u32x4*)(kvp + 16 * p + 8);
        const u32x4 kr = *(const u32x4*)(C + (size_t)m * 512 + 384 + 8 * p);
        float cs[8], sn[8];
#pragma unroll
        for (int i = 0; i < 8; ++i) { const float ang = (float)t * invf[i]; const double rev = (double)ang * 0.15915494309189535; const float fr = (float)(rev - floor(rev));
            cs[i] = __builtin_amdgcn_cosf(fr); sn[i] = __builtin_amdgcn_sinf(fr); }
        float qv[16], kv[16], qrv[8], krv[8];
#pragma unroll
        for (int j = 0; j < 4; ++j) { qv[2 * j] = bflo(qn0[j]); qv[2 * j + 1] = bfhi(qn0[j]); qv[8 + 2 * j] = bflo(qn1[j]); qv[9 + 2 * j] = bfhi(qn1[j]);
            kv[2 * j] = bflo(kn0[j]); kv[2 * j + 1] = bfhi(kn0[j]); kv[8 + 2 * j] = bflo(kn1[j]); kv[9 + 2 * j] = bfhi(kn1[j]);
            qrv[2 * j] = bflo(qr[j]); qrv[2 * j + 1] = bfhi(qr[j]); krv[2 * j] = bflo(kr[j]); krv[2 * j + 1] = bfhi(kr[j]); }
        float sq = 0.f, sk = 0.f, sqr = 0.f, skr = 0.f;
#pragma unroll
        for (int i = 0; i < 16; ++i) { sq += qv[i] * qv[i]; sk += kv[i] * kv[i]; }
#pragma unroll
        for (int i = 0; i < 8; ++i) { sqr += qrv[i] * qrv[i]; skr += krv[i] * krv[i]; }
#pragma unroll
        for (int o = 1; o < 8; o <<= 1) { sq += __shfl_xor(sq, o); sk += __shfl_xor(sk, o); sqr += __shfl_xor(sqr, o); skr += __shfl_xor(skr, o); }
        const float rq = 1.0f / sqrtf(sq * (1.0f / 128.0f) + EPS), rk = 1.0f / sqrtf(sk * (1.0f / 128.0f) + EPS);
        const float rqr = 1.0f / sqrtf(sqr * (1.0f / 64.0f) + EPS), rkr = 1.0f / sqrtf(skr * (1.0f / 64.0f) + EPS);
        u32x4 oq0, oq1, ok0, ok1, oqr, okr;
#pragma unroll
        for (int j = 0; j < 4; ++j) { oq0[j] = pk2(qv[2 * j] * rq * g_qn[2 * j], qv[2 * j + 1] * rq * g_qn[2 * j + 1]); oq1[j] = pk2(qv[8 + 2 * j] * rq * g_qn[8 + 2 * j], qv[9 + 2 * j] * rq * g_qn[9 + 2 * j]);
            ok0[j] = pk2(kv[2 * j] * rk * g_kn[2 * j], kv[2 * j + 1] * rk * g_kn[2 * j + 1]); ok1[j] = pk2(kv[8 + 2 * j] * rk * g_kn[8 + 2 * j], kv[9 + 2 * j] * rk * g_kn[9 + 2 * j]); }
        float qo[8], ko[8];
#pragma unroll
        for (int i = 0; i < 8; ++i) {
            const float xq = qrv[i] * rqr * g_qr[i], xk = krv[i] * rkr * g_kr[i];
            const float yq = __shfl_xor(xq, 4), yk = __shfl_xor(xk, 4);
            qo[i] = first ? (xq * cs[i] - yq * sn[i]) : (xq * cs[i] + yq * sn[i]);
            ko[i] = first ? (xk * cs[i] - yk * sn[i]) : (xk * cs[i] + yk * sn[i]);
        }
#pragma unroll
        for (int j = 0; j < 4; ++j) { oqr[j] = pk2(qo[2 * j], qo[2 * j + 1]); okr[j] = pk2(ko[2 * j], ko[2 * j + 1]); }
        bf16_t* qw = Q + (size_t)m * 1536 + h * 192; bf16_t* kw = Kf + (size_t)m * 1536 + h * 192;
        *(u32x4*)(qw + 16 * p) = oq0; *(u32x4*)(qw + 16 * p + 8) = oq1; *(u32x4*)(qw + 128 + 8 * p) = oqr;
        *(u32x4*)(kw + 16 * p) = ok0; *(u32x4*)(kw + 16 * p + 8) = ok1; *(u32x4*)(kw + 128 + 8 * p) = okr;
    }
}

template <int DK, bool STICK>
__device__ __forceinline__ void attn_phase(const Ctx& c, const bf16_t* Q, int qpitch, const bf16_t* Kg, int kpitch, const bf16_t* Vt, bf16_t* O, int opitch) {
    constexpr int KP = DK + 8;
    constexpr int KS = DK / 32;
    constexpr int NKL = DK / 64;
    LAS bf16_t* Kt = (LAS bf16_t*)c.lds;
    LAS bf16_t* Vl = (LAS bf16_t*)(c.lds + 64 * KP * 2);
    LAS unsigned* flags = (LAS unsigned*)(c.lds + 64 * KP * 2 + 128 * 72 * 2);
    const int lane = c.lane, wave = c.wave, quad = lane >> 4, l15 = lane & 15;
    const int sr = c.tid >> 3, scc = (c.tid & 7) * (DK / 8);
    const int sd = c.tid >> 2, skq = (c.tid & 3) * 16;
    for (int pu = blockIdx.x; pu < 256; pu += gridDim.x) {
        const int bh = pu >> 3, s8 = pu & 7, b = bh >> 3, h = bh & 7;
        for (int half = 0; half < 2; ++half) {
            const int qb = half ? 15 - s8 : s8;
            const int q0 = qb * 256 + wave * 32;
            bf16x8 Qf[2][KS];
#pragma unroll
            for (int qt = 0; qt < 2; ++qt)
#pragma unroll
                for (int ks = 0; ks < KS; ++ks) Qf[qt][ks] = *(const bf16x8*)(Q + (size_t)(b * SEQ + q0 + 16 * qt + l15) * qpitch + h * DK + 32 * ks + 8 * quad);
            f32x4 Oa[8][2];
#pragma unroll
            for (int dt = 0; dt < 8; ++dt) { Oa[dt][0] = (f32x4){0.f, 0.f, 0.f, 0.f}; Oa[dt][1] = (f32x4){0.f, 0.f, 0.f, 0.f}; }
            float mrow[2] = {-1e30f, -1e30f}, lrow[2] = {0.f, 0.f}, Rrow[2] = {0.f, 0.f};
            const int ntile = 4 * (qb + 1);
            bool wdone = false;
            u32x4 kreg[NKL], vreg[2];
            { const int key0 = (STICK ? (ntile - 1) : 0) * 64;
              const bf16_t* p = Kg + (size_t)(b * SEQ + key0 + sr) * kpitch + h * DK + scc;
#pragma unroll
              for (int i = 0; i < NKL; ++i) kreg[i] = *(const u32x4*)(p + 8 * i);
              const bf16_t* pv = Vt + ((size_t)(bh * 128 + sd)) * SEQ + key0 + skq;
              vreg[0] = *(const u32x4*)pv; vreg[1] = *(const u32x4*)(pv + 8); }
            for (int it = 0; it < ntile; ++it) {
                const int kt = STICK ? (ntile - 1 - it) : it;
                const int key0 = kt * 64;
                if (STICK) { if (lane == 0) flags[wave] = wdone ? 1u : 0u; }
                __syncthreads();
                if (STICK) { unsigned alld = 1u;
#pragma unroll
                    for (int w = 0; w < 8; ++w) alld &= flags[w];
                    if (alld) break; }
#pragma unroll
                for (int i = 0; i < NKL; ++i) *(LAS u32x4*)(Kt + sr * KP + scc + 8 * i) = kreg[i];
                *(LAS u32x4*)(Vl + sd * 72 + skq) = vreg[0]; *(LAS u32x4*)(Vl + sd * 72 + skq + 8) = vreg[1];
                if (it + 1 < ntile) {
                    const int key1 = (STICK ? (kt - 1) : (kt + 1)) * 64;
                    const bf16_t* p = Kg + (size_t)(b * SEQ + key1 + sr) * kpitch + h * DK + scc;
#pragma unroll
                    for (int i = 0; i < NKL; ++i) kreg[i] = *(const u32x4*)(p + 8 * i);
                    const bf16_t* pv = Vt + ((size_t)(bh * 128 + sd)) * SEQ + key1 + skq;
                    vreg[0] = *(const u32x4*)pv; vreg[1] = *(const u32x4*)(pv + 8);
                }
                __syncthreads();
                if (key0 > q0 + 31) continue;
                if (STICK && wdone) continue;
                f32x4 St[4][2];
#pragma unroll
                for (int k4 = 0; k4 < 4; ++k4) { St[k4][0] = (f32x4){0.f, 0.f, 0.f, 0.f}; St[k4][1] = (f32x4){0.f, 0.f, 0.f, 0.f}; }
#pragma unroll
                for (int ks = 0; ks < KS; ++ks)
#pragma unroll
                    for (int k4 = 0; k4 < 4; ++k4) {
                        const bf16x8 kf = *(const LAS bf16x8*)(Kt + (16 * k4 + l15) * KP + 32 * ks + 8 * quad);
                        St[k4][0] = __builtin_amdgcn_mfma_f32_16x16x32_bf16(kf, Qf[0][ks], St[k4][0], 0, 0, 0);
                        St[k4][1] = __builtin_amdgcn_mfma_f32_16x16x32_bf16(kf, Qf[1][ks], St[k4][1], 0, 0, 0);
                    }
                bf16x8 Pb[2][2];
#pragma unroll
                for (int qt = 0; qt < 2; ++qt) {
                    const int tq = q0 + 16 * qt + l15;
                    if constexpr (!STICK) {
                        float mx = -1e30f;
#pragma unroll
                        for (int k4 = 0; k4 < 4; ++k4)
#pragma unroll
                            for (int r = 0; r < 4; ++r) { const int key = key0 + 16 * k4 + 4 * quad + r; const float z = (key <= tq) ? St[k4][qt][r] : -1e30f; St[k4][qt][r] = z; mx = fmaxf(mx, z); }
                        mx = fmaxf(mx, __shfl_xor(mx, 16)); mx = fmaxf(mx, __shfl_xor(mx, 32));
                        const float mnew = fmaxf(mrow[qt], mx);
                        const float alpha = fexp(mrow[qt] - mnew);
                        float ps = 0.f;
#pragma unroll
                        for (int k4 = 0; k4 < 4; ++k4)
#pragma unroll
                            for (int r = 0; r < 4; ++r) { const float p = (St[k4][qt][r] > -1e29f) ? fexp(St[k4][qt][r] - mnew) : 0.f; St[k4][qt][r] = p; ps += p; }
                        ps += __shfl_xor(ps, 16); ps += __shfl_xor(ps, 32);
                        lrow[qt] = lrow[qt] * alpha + ps; mrow[qt] = mnew;
#pragma unroll
                        for (int dt = 0; dt < 8; ++dt) Oa[dt][qt] = Oa[dt][qt] * alpha;
                    } else {
                        float G[4], ls[4][4];
#pragma unroll
                        for (int k4 = 0; k4 < 4; ++k4) {
                            G[k4] = 0.f;
#pragma unroll
                            for (int r = 0; r < 4; ++r) { const int key = key0 + 16 * k4 + 4 * quad + r; const float z = St[k4][qt][r];
                                const float sp = softplus_f(z); const bool valid = key < tq; ls[k4][r] = valid ? -sp : 0.f; G[k4] += ls[k4][r];
                                St[k4][qt][r] = valid ? (z - sp) : -1e30f; }
                        }
                        float run = Rrow[qt];
#pragma unroll
                        for (int k4 = 3; k4 >= 0; --k4) {
                            const float g = G[k4];
                            const float gb = __shfl_xor(g, 16), gc2 = __shfl_xor(g, 32), gd = __shfl_xor(gb, 32);
                            const float hi = (((quad ^ 1) > quad) ? gb : 0.f) + (((quad ^ 2) > quad) ? gc2 : 0.f) + (((quad ^ 3) > quad) ? gd : 0.f);
                            float aft = run + hi;
#pragma unroll
                            for (int r = 3; r >= 0; --r) { const float lz = St[k4][qt][r]; St[k4][qt][r] = (lz > -1e29f) ? fexp(lz + aft) : 0.f; aft += ls[k4][r]; }
                            run += (g + gb) + (gc2 + gd);
                        }
                        Rrow[qt] = run;
                    }
                    Pb[qt][0] = pack8(St[0][qt], St[1][qt]); Pb[qt][1] = pack8(St[2][qt], St[3][qt]);
                }
#pragma unroll
                for (int dt = 0; dt < 8; ++dt)
#pragma unroll
                    for (int k2 = 0; k2 < 2; ++k2) {
                        const LAS bf16_t* vp = Vl + (16 * dt + l15) * 72 + 32 * k2 + 4 * quad;
                        const u32x2 lo = *(const LAS u32x2*)vp, hi = *(const LAS u32x2*)(vp + 16);
                        u32x4 w; w.x = lo.x; w.y = lo.y; w.z = hi.x; w.w = hi.y; const bf16x8 vf = __builtin_bit_cast(bf16x8, w);
                        Oa[dt][0] = __builtin_amdgcn_mfma_f32_16x16x32_bf16(vf, Pb[0][k2], Oa[dt][0], 0, 0, 0);
                        Oa[dt][1] = __builtin_amdgcn_mfma_f32_16x16x32_bf16(vf, Pb[1][k2], Oa[dt][1], 0, 0, 0);
                    }
                if (STICK) wdone = __all((Rrow[0] < -110.f) && (Rrow[1] < -110.f));
            }
#pragma unroll
            for (int qt = 0; qt < 2; ++qt) {
                const float inv = STICK ? 1.f : 1.f / lrow[qt];
                bf16_t* op = O + (size_t)(b * SEQ + q0 + 16 * qt + l15) * opitch + h * 128 + 4 * quad;
#pragma unroll
                for (int dt = 0; dt < 8; ++dt) { u32x2 w; w.x = pk2(Oa[dt][qt][0] * inv, Oa[dt][qt][1] * inv); w.y = pk2(Oa[dt][qt][2] * inv, Oa[dt][qt][3] * inv); *(u32x2*)(op + 16 * dt) = w; }
            }
        }
    }
}

constexpr int NPHASE = 30;
__device__ __forceinline__ int lane_id() { int l; asm volatile("v_mbcnt_lo_u32_b32 %0, -1, 0\n\tv_mbcnt_hi_u32_b32 %0, -1, %0" : "=v"(l)); return l; }
__device__ __forceinline__ Ctx mkctx(LAS unsigned char* lds, unsigned char* ws_, int wave_s) {
    int ln = lane_id(); asm volatile("" : "+v"(ln));
    int wv = wave_s; asm volatile("" : "+s"(wv));
    asm volatile("" : "+s"(ws_));
    Ctx c; c.lds = lds; c.ws = ws_; c.lane = ln; c.wave = wv; c.tid = wv * 64 + ln;
    c.gw = blockIdx.x * NWAVES + c.wave; c.ngw = gridDim.x * NWAVES; return c;
}
#define PH_BEGIN Ctx c = mkctx(ldsp, args.ws, wave_s); const Args& A = args; unsigned char* ws = c.ws; \
    bf16_t* XB = (bf16_t*)(ws + WS_R1); float* SS = (float*)(ws + WS_SS); bf16_t* R2 = (bf16_t*)(ws + WS_R2); bf16_t* R3 = (bf16_t*)(ws + WS_R3); \
    bf16_t* R4 = (bf16_t*)(ws + WS_R4); bf16_t* R5 = (bf16_t*)(ws + WS_R5); bf16_t* WMIX = (bf16_t*)(ws + WS_WMIX); bf16_t* WOUT = (bf16_t*)(ws + WS_WMIX_OUT); \
    (void)XB; (void)SS; (void)R2; (void)R3; (void)R4; (void)R5; (void)WMIX; (void)WOUT; (void)c;

__global__ void __launch_bounds__(NTHR, 2) trunk_fwd(Args args) {
    extern __shared__ __attribute__((aligned(16))) unsigned char lds_raw[];
    LAS unsigned char* ldsp = (LAS unsigned char*)lds_raw;
    const int wave_s = __builtin_amdgcn_readfirstlane((int)(threadIdx.x >> 6));
    const int lo = args.ph_lo, hi = args.ph_hi;
    const int G = gridDim.x, bid = blockIdx.x;
#if !MK_PER_PHASE
    cg::grid_group grid = cg::this_grid();
#if MK_XCD_BAR
    volatile LAS unsigned* misc = (volatile LAS unsigned*)(ldsp + LDS_MISC);
    if (threadIdx.x < 16) misc[threadIdx.x] = 0u;
    __syncthreads();
    XcdBarrier xbar = xcd_barrier_post((unsigned*)(args.ws + WS_BAR), misc + 8, (int)threadIdx.x);
    int nsync = 0;
#define SEAM() do { if (nsync == 0) grid.sync(); else xcd_barrier(xbar, wave_s * 64 + lane_id()); ++nsync; } while (0)
#else
#define SEAM() grid.sync()
#endif
#else
#define SEAM() do {} while (0)
#endif
#define IN(k) (lo <= (k) && (k) < hi)
#ifndef PROBE_MASK
#define PROBE_MASK 0ull
#endif
    unsigned long long tacc = 0ull, tph = (PROBE_MASK != 0ull) ? __builtin_amdgcn_s_memrealtime() : 0ull;
#define ENDPH(k) do { if (IN((k) + 1)) SEAM(); if (PROBE_MASK != 0ull) { const unsigned long long tn = __builtin_amdgcn_s_memrealtime(); if ((PROBE_MASK >> (k)) & 1ull) tacc += tn - tph; tph = tn; } } while (0)

    float* out = args.out;
    int ph = 0;

    if (IN(ph) && EN(0)) { PH_BEGIN; convert_mixer(A, c, 0); convert_ffn(A, c, 0); prologue_rows(A, c); }
    ENDPH(ph); ++ph;

#pragma unroll 1
    for (int L = 0; L < 4; ++L) {
        const float* resid_in = (L == 0) ? args.in[0] : out;
        if (L == 0 || L == 3) {
            const int ib = (L == 0) ? 1 : 33;
            if (IN(ph)) {
                PH_BEGIN;
                if (L > 0 && EN(0)) convert_ffn(A, c, L);
                __syncthreads();
                pg8::Gemm g{XB, WMIX, M, 4352, D, D}; pg8::StaticOrder S; S.init(M, 4352, G, bid);
                pg8::EpiDN E{R2, R3, (float*)(ws + WS_AB), (bf16_t*)(ws + WS_HALO), SS};
                if (EN(1)) pg8::gemm_phase<pg8::EpiDN>(c.lds, g, S, E, c.tid);
            }
            ENDPH(ph); ++ph;
            if (IN(ph) && EN(2)) { PH_BEGIN; dn_conv(A, c, A.in[ib + 2]); }
            ENDPH(ph); ++ph;
            if (IN(ph) && EN(3)) { PH_BEGIN; dn_chunk(A, c, A.in[ib + 3], A.in[ib + 4]); }
            ENDPH(ph); ++ph;
            if (IN(ph) && EN(4)) { PH_BEGIN; dn_scan(A, c); }
            ENDPH(ph); ++ph;
            if (IN(ph) && EN(5)) { PH_BEGIN; dn_post(A, c, A.in[ib + 5]); }
            ENDPH(ph); ++ph;
            if (IN(ph)) {
                PH_BEGIN;
                pg8::Gemm g{R4, WOUT, M, D, D, D}; pg8::StaticOrder S; S.init(M, D, G, bid);
                pg8::EpiResidual E{resid_in, out, XB, SS};
                if (EN(10)) pg8::gemm_phase<pg8::EpiResidual>(c.lds, g, S, E, c.tid);
            }
            ENDPH(ph); ++ph;
        } else if (L == 1) {
            if (IN(ph)) {
                PH_BEGIN;
                if (EN(0)) convert_ffn(A, c, L);
                __syncthreads();
                pg8::Gemm g{XB, WMIX, M, 3072, D, D}; pg8::StaticOrder S; S.init(M, 3072, G, bid);
                pg8::EpiStore E{R2, 3072, SS, 0, 16, 1.0f / D};
                if (EN(11)) pg8::gemm_phase<pg8::EpiStore>(c.lds, g, S, E, c.tid);
            }
            ENDPH(ph); ++ph;
            if (IN(ph) && EN(6)) { PH_BEGIN; sb_prep_rows(A, c, A.in[13], A.in[14]); v_transpose(c, R2, 3072, 128, 2048, (bf16_t*)(ws + WS_R1)); }
            ENDPH(ph); ++ph;
            if (IN(ph) && EN(7)) { PH_BEGIN; attn_phase<128, true>(c, R2, 3072, R2 + 1024, 3072, (const bf16_t*)(ws + WS_R1), R3, 1024); }
            ENDPH(ph); ++ph;
            if (IN(ph)) {
                PH_BEGIN;
                pg8::Gemm g{R3, WOUT, M, D, D, D}; pg8::StaticOrder S; S.init(M, D, G, bid);
                pg8::EpiResidual E{resid_in, out, XB, SS};
                if (EN(10)) pg8::gemm_phase<pg8::EpiResidual>(c.lds, g, S, E, c.tid);
            }
            ENDPH(ph); ++ph;
        } else {
            if (IN(ph)) {
                PH_BEGIN;
                if (EN(0)) convert_ffn(A, c, L);
                __syncthreads();
                pg8::Gemm g{XB, WMIX, M, 512, D, D}; pg8::StaticOrder S; S.init(M, 512, G, bid);
                pg8::EpiMlaDown E{R5, (float*)(ws + WS_SS2), SS};
                if (EN(12)) pg8::gemm_phase<pg8::EpiMlaDown>(c.lds, g, S, E, c.tid);
            }
            ENDPH(ph); ++ph;
            if (IN(ph)) {
                PH_BEGIN;
                { pg8::Gemm g{R5, (bf16_t*)(ws + WS_WMIX + 1 * MiB), M, 1536, 256, 512}; pg8::StaticOrder S; S.init(M, 1536, G, bid);
                  pg8::EpiStore E{R2, 1536, (const float*)(ws + WS_SS2), 0, 8, 1.0f / 256.0f};
                  if (EN(11)) pg8::gemm_phase<pg8::EpiStore>(c.lds, g, S, E, c.tid); }
                { pg8::Gemm g{R5 + 256, (bf16_t*)(ws + WS_WMIX + 2 * MiB), M, 2048, 128, 512}; pg8::StaticOrder S; S.init(M, 2048, G, bid);
                  pg8::EpiStore E{R3, 2048, (const float*)(ws + WS_SS2), 8, 4, 1.0f / 128.0f};
                  if (EN(11)) pg8::gemm_phase<pg8::EpiStore>(c.lds, g, S, E, c.tid); }
            }
            ENDPH(ph); ++ph;
            if (IN(ph) && EN(8)) { PH_BEGIN; mla_prep_rows(A, c); v_transpose(c, R3, 2048, 256, 128, (bf16_t*)(ws + WS_R1)); }
            ENDPH(ph); ++ph;
            if (IN(ph) && EN(9)) { PH_BEGIN; attn_phase<192, false>(c, R2, 1536, (const bf16_t*)(ws + WS_R2 + 48 * MiB), 1536, (const bf16_t*)(ws + WS_R1), R3, 1024); }
            ENDPH(ph); ++ph;
            if (IN(ph)) {
                PH_BEGIN;
                pg8::Gemm g{R3, WOUT, M, D, D, D}; pg8::StaticOrder S; S.init(M, D, G, bid);
                pg8::EpiResidual E{resid_in, out, XB, SS};
                if (EN(10)) pg8::gemm_phase<pg8::EpiResidual>(c.lds, g, S, E, c.tid);
            }
            ENDPH(ph); ++ph;
        }
        if (IN(ph)) {
            PH_BEGIN;
            if (L < 3 && EN(0)) convert_mixer(A, c, L + 1);
            __syncthreads();
            pg8::Gemm g{XB, (bf16_t*)(ws + WS_WFFN), M, 2 * FH, D, D}; pg8::StaticOrder S; S.init(M, 2 * FH, G, bid);
            pg8::EpiSwiglu E{R2, SS};
            if (EN(13)) pg8::gemm_phase<pg8::EpiSwiglu>(c.lds, g, S, E, c.tid);
        }
        ENDPH(ph); ++ph;
        if (IN(ph)) {
            PH_BEGIN;
            pg8::Gemm g{R2, (bf16_t*)(ws + WS_WFFN_DN), M, D, FH, FH}; pg8::StaticOrder S; S.init(M, D, G, bid);
            pg8::EpiResidual E{out, out, XB, SS};
            if (EN(10)) pg8::gemm_phase<pg8::EpiResidual>(c.lds, g, S, E, c.tid);
        }
        ENDPH(ph); ++ph;
    }
    if (PROBE_MASK != 0ull) { const unsigned long long te = __builtin_amdgcn_s_memrealtime(); while (__builtin_amdgcn_s_memrealtime() - te < tacc) __builtin_amdgcn_s_sleep(8); }
}

extern "C" void kernel_launch(void* const* d_in, const int* in_sizes, int n_in, void* d_out, int out_size, void* d_ws, size_t ws_size, hipStream_t stream) {
    static int grid = 0;
    if (grid == 0) {
        if (n_in != 43 || out_size != M * D || ws_size < WS_END) { fprintf(stderr, "kernel_launch: unexpected shapes (n_in %d out %d ws %zu)\n", n_in, out_size, ws_size); grid = -1; return; }
        int dev = 0, cus = 0, per_cu = 0;
        hipGetDevice(&dev); hipDeviceGetAttribute(&cus, hipDeviceAttributeMultiprocessorCount, dev);
        if (hipFuncSetAttribute((const void*)trunk_fwd, hipFuncAttributeMaxDynamicSharedMemorySize, LDS_BYTES) != hipSuccess) { fprintf(stderr, "kernel_launch: hipFuncSetAttribute failed\n"); grid = -1; return; }
        if (hipOccupancyMaxActiveBlocksPerMultiprocessor(&per_cu, (const void*)trunk_fwd, NTHR, LDS_BYTES) != hipSuccess || per_cu < 1) { fprintf(stderr, "kernel_launch: occupancy query says %d\n", per_cu); per_cu = 1; }
        (void)hipGetLastError();
        grid = cus * 1;
    }
    if (grid < 0) return;
    Args a{};
    for (int i = 0; i < 43; ++i) a.in[i] = (const float*)d_in[i];
    a.out = (float*)d_out; a.ws = (unsigned char*)d_ws;
#if MK_PER_PHASE
    for (int p = 0; p < NPHASE; ++p) {
        a.ph_lo = p; a.ph_hi = p + 1;
        hipLaunchKernelGGL(trunk_fwd, dim3(grid), dim3(NTHR), LDS_BYTES, stream, a);
    }
#else
    hipMemsetAsync((char*)d_ws + WS_BAR, 0, 65536, stream);
    a.ph_lo = 0; a.ph_hi = NPHASE;
    void* kargs[] = {&a};
    hipError_t e = hipLaunchCooperativeKernel((const void*)trunk_fwd, dim3(grid), dim3(NTHR), kargs, LDS_BYTES, stream);
    if (e != hipSuccess) fprintf(stderr, "cooperative launch failed: %s (grid %d)\n", hipGetErrorString(e), grid);
#endif
}
```

```cpp
#include <hip/hip_runtime.h>
#include <hip/hip_cooperative_groups.h>
#include <cstdio>
#include <cstdint>
namespace cg = cooperative_groups;

#ifndef MK_PER_PHASE
#define MK_PER_PHASE 0
#endif
#ifndef MK_XCD_BAR
#define MK_XCD_BAR 1
#endif

#ifndef EN_MASK
#define EN_MASK 0xFFFFFFFFu
#endif
#define EN(b) ((EN_MASK >> (b)) & 1u)
#define LAS __attribute__((address_space(3)))
typedef unsigned short bf16_t;
typedef short bf16x8 __attribute__((ext_vector_type(8)));
typedef short bf16x4 __attribute__((ext_vector_type(4)));
typedef float f32x4 __attribute__((ext_vector_type(4)));
typedef float f32x2 __attribute__((ext_vector_type(2)));
typedef unsigned u32x4 __attribute__((ext_vector_type(4)));
typedef unsigned u32x2 __attribute__((ext_vector_type(2)));

constexpr int BATCH = 4, SEQ = 4096, D = 1024, M = BATCH * SEQ, FH = 2816, NH = 8;
constexpr float EPS = 1e-6f;
constexpr int NWAVES = 8, NTHR = 512;

constexpr size_t MiB = 1u << 20;
constexpr size_t WS_BAR = 0;
constexpr size_t WS_SS = 1 * MiB;
constexpr size_t WS_SS2 = 2 * MiB;
constexpr size_t WS_AB = 3 * MiB;
constexpr size_t WS_RS = 4 * MiB;
constexpr size_t WS_GC = 5 * MiB;
constexpr size_t WS_HALO = 6 * MiB;
constexpr size_t WS_WMIX = 8 * MiB;
constexpr size_t WS_WMIX_OUT = WS_WMIX + 9 * MiB;
constexpr size_t WS_WFFN = 20 * MiB;
constexpr size_t WS_WFFN_DN = WS_WFFN + 11 * MiB;
constexpr size_t WS_R1 = 40 * MiB;
constexpr size_t WS_R2 = 72 * MiB;
constexpr size_t WS_R3 = 168 * MiB;
constexpr size_t WS_R4 = 200 * MiB;
constexpr size_t WS_R5 = 232 * MiB;
constexpr size_t WS_END = 248 * MiB;

constexpr int LDS_BYTES = 147456;
constexpr int LDS_MISC = 147200;

__device__ __forceinline__ unsigned f2bf(float f) { unsigned u = __builtin_bit_cast(unsigned, f); return (u + 0x7fffu + ((u >> 16) & 1u)) >> 16; }
__device__ __forceinline__ unsigned pk2(float lo, float hi) { unsigned r; asm volatile("v_cvt_pk_bf16_f32 %0, %1, %2" : "=v"(r) : "v"(lo), "v"(hi)); return r; }
__device__ __forceinline__ float bf2f(unsigned b) { return __builtin_bit_cast(float, b << 16); }
__device__ __forceinline__ float bflo(unsigned w) { return __builtin_bit_cast(float, w << 16); }
__device__ __forceinline__ float bfhi(unsigned w) { return __builtin_bit_cast(float, w & 0xffff0000u); }
__device__ __forceinline__ float wave_sum(float v) {
#pragma unroll
    for (int o = 1; o < 64; o <<= 1) v += __shfl_xor(v, o);
    return v;
}
#define LDS_BARRIER() do { asm volatile("s_waitcnt lgkmcnt(0)" ::: "memory"); __builtin_amdgcn_s_barrier(); asm volatile("" ::: "memory"); } while (0)
__device__ __forceinline__ float fexp(float x) { return __builtin_amdgcn_exp2f(x * 1.4426950408889634f); }
__device__ __forceinline__ float flog(float x) { return __builtin_amdgcn_logf(x) * 0.6931471805599453f; }
__device__ __forceinline__ float softplus_f(float z) { return fmaxf(z, 0.f) + flog(1.f + fexp(-fabsf(z))); }
__device__ __forceinline__ float silu_f(float y) { return y / (1.f + fexp(-y)); }
__device__ __forceinline__ float rowscale(const float* ss, int row, int lo, int n, float inv_dim) {
    float s = 0.f;
    for (int i = 0; i < n; i += 4) { const f32x4 v = *(const f32x4*)(ss + (size_t)row * 16 + lo + i); s += (v[0] + v[1]) + (v[2] + v[3]); }
    return 1.0f / sqrtf(s * inv_dim + EPS);
}

namespace pg8 {
#define PG8_LAS __attribute__((address_space(3)))
constexpr int BM = 256, BK = 64, HALF = 128, HTB = HALF * BK * 2, STAGE_BYTES = 8 * HTB, NXCD = 8, WGM = 8;
__host__ __device__ __forceinline__ int lds_byte(int r, int c) { const int st = (r >> 4) * 2 + (c >> 5), rr = r & 15, cc = c & 31, ob = rr * 64 + cc * 2; return st * 1024 + (ob ^ (((ob >> 9) & 1) << 5)); }
__host__ __device__ __forceinline__ void stage_rc(int b, int& R, int& C) { const int st = b / 1024, sb = b % 1024, swz = sb ^ (((sb >> 9) & 1) << 5); R = (st >> 1) * 16 + swz / 64; C = (st & 1) * 32 + (swz % 64) / 2; }
__host__ __device__ __forceinline__ int perm32(int rho) { const int n = rho >> 4, i = rho & 15; return 8 * (i >> 2) + 4 * n + (i & 3); }
struct Unit { int pm, pn; };
struct Gemm { const bf16_t* A; const bf16_t* Bt; int M, N, K, lda; };
struct StaticOrder {
    int nM, nN, nwg, G, c;
    __host__ __device__ void init(int M_, int N_, int G_, int c_) { nM = M_ / BM; nN = N_ / BM; nwg = nM * nN; G = G_; c = c_; }
    __host__ __device__ bool next(int i, Unit& u) const {
        const long L = (long)i * G + c; if (L >= nwg) return false;
        int wgid = (int)L; { const int q = nwg / NXCD, r = nwg % NXCD, xcd = wgid % NXCD, off = wgid / NXCD; wgid = (xcd < r ? xcd * (q + 1) : r * (q + 1) + (xcd - r) * q) + off; }
        const int nig = WGM * nN, gid = wgid / nig, fm = gid * WGM, gsz = (nM - fm) < WGM ? (nM - fm) : WGM;
        u.pm = fm + ((wgid % nig) % gsz); u.pn = (wgid % nig) / gsz; return true;
    }
};
template <class Epi, bool ALIGN_EPI = true>
__device__ __forceinline__ void gemm_phase(PG8_LAS unsigned char* lds, const Gemm g, const StaticOrder& S, const Epi& E, int tid_in) {
    int tid_ = tid_in; asm volatile("" : "+v"(tid_));
    const int tid = tid_, wid = __builtin_amdgcn_readfirstlane(tid >> 6), lane = tid & 63, wr = wid >> 2, wc = wid & 3, fr = lane & 15, fq = lane >> 4;
    const int K = g.K, nt = K / BK, lda = g.lda;
    unsigned voffA[2], voffB[2];
#pragma unroll
    for (int i = 0; i < 2; ++i) { int R, C; stage_rc(tid * 16 + i * 8192, R, C); const int Rb = Epi::PERM ? ((R & ~31) + perm32(R & 31)) : R;
        voffA[i] = (unsigned)(R * lda + C) * 2u; voffB[i] = (unsigned)(Rb * K + C) * 2u; }
    const size_t kstep = (size_t)(BK * 2);
    const size_t hstepA = (size_t)HALF * lda * 2, hstepB = (size_t)HALF * K * 2;
    const size_t tstepA = 2 * hstepA, tstepB = 2 * hstepB;
    const unsigned ldsw = (unsigned)wid * 1024u;
    const int aoff = lds_byte(wr * 64 + fr, fq * 8), boff = lds_byte(wc * 32 + fr, fq * 8);
#define PG8_SA(b, h) (((b) * 2 + (h)) * HTB)
#define PG8_SB(b, h) ((4 + (b) * 2 + (h)) * HTB)
#define PG8_STAGE(bufoff, gbase, voff) do { _Pragma("unroll") for (int _i = 0; _i < 2; ++_i) \
        __builtin_amdgcn_global_load_lds((const unsigned*)((const char*)(gbase) + (voff)[_i]), (PG8_LAS unsigned*)(lds + (bufoff) + ldsw + _i * 8192), 16, 0, 0); } while (0)
#define PG8_LDA(dst, b, h) do { _Pragma("unroll") for (int m = 0; m < 4; ++m) _Pragma("unroll") for (int k = 0; k < 2; ++k) dst[m][k] = *(const PG8_LAS bf16x8*)(lds + PG8_SA(b, h) + aoff + m * 2048 + k * 1024); } while (0)
#define PG8_LDB(dst, b, h) do { _Pragma("unroll") for (int n = 0; n < 2; ++n) _Pragma("unroll") for (int k = 0; k < 2; ++k) dst[n][k] = *(const PG8_LAS bf16x8*)(lds + PG8_SB(b, h) + boff + n * 2048 + k * 1024); } while (0)
#define PG8_MMA(ai, bj, At, Bt) do { __builtin_amdgcn_s_setprio(1); _Pragma("unroll") for (int m = 0; m < 4; ++m) _Pragma("unroll") for (int n = 0; n < 2; ++n) _Pragma("unroll") for (int k = 0; k < 2; ++k) \
        acc[ai][bj][m][n] = __builtin_amdgcn_mfma_f32_16x16x32_bf16(Bt[n][k], At[m][k], acc[ai][bj][m][n], 0, 0, 0); __builtin_amdgcn_s_setprio(0); } while (0)
#define PG8_WAIT_V(n) asm volatile("s_waitcnt vmcnt(" #n ")" ::: "memory")
#define PG8_WAIT_L(n) asm volatile("s_waitcnt lgkmcnt(" #n ")" ::: "memory")
#define PG8_BAR __builtin_amdgcn_s_barrier()
#define PG8_SCHED __builtin_amdgcn_sched_barrier(0)
    Unit cur, nxt; int ui = 0;
    if (!S.next(0, cur)) return;
    f32x4 acc[2][2][4][2];
#pragma unroll
    for (int a = 0; a < 2; ++a)
#pragma unroll
        for (int b = 0; b < 2; ++b)
#pragma unroll
            for (int m = 0; m < 4; ++m)
#pragma unroll
                for (int n = 0; n < 2; ++n) acc[a][b][m][n] = (f32x4){0.f, 0.f, 0.f, 0.f};
    bf16x8 At[4][2], B0[2][2], B1[2][2];
    const char* cA = (const char*)g.A + (size_t)cur.pm * tstepA; const char* cB = (const char*)g.Bt + (size_t)cur.pn * tstepB;
    PG8_STAGE(PG8_SB(0, 0), cB, voffB); PG8_STAGE(PG8_SB(0, 1), cB + hstepB, voffB); PG8_STAGE(PG8_SA(0, 0), cA, voffA); PG8_STAGE(PG8_SA(0, 1), cA + hstepA, voffA);
    if (wr == 1) PG8_BAR;
    PG8_WAIT_V(2); PG8_BAR;
    PG8_STAGE(PG8_SB(1, 0), cB + kstep, voffB); PG8_STAGE(PG8_SA(1, 0), cA + kstep, voffA); PG8_STAGE(PG8_SB(1, 1), cB + hstepB + kstep, voffB);
    PG8_WAIT_V(6); PG8_BAR;
    for (;;) {
        const bool has_next = S.next(ui + 1, nxt);
        const char* nA = has_next ? (const char*)g.A + (size_t)nxt.pm * tstepA : cA; const char* nB = has_next ? (const char*)g.Bt + (size_t)nxt.pn * tstepB : cB;
        for (int t = 0; t < nt; t += 2) {
            const bool last = (t == nt - 2);
            const char* a1 = cA + (size_t)(t + 1) * kstep;
            const char* a2 = last ? nA : cA + (size_t)(t + 2) * kstep; const char* b2 = last ? nB : cB + (size_t)(t + 2) * kstep;
            const char* a3 = a2 + kstep; const char* b3 = b2 + kstep;
            PG8_LDB(B0, 0, 0); PG8_LDB(B1, 0, 1); PG8_SCHED; PG8_LDA(At, 0, 0); PG8_STAGE(PG8_SA(1, 1), a1 + hstepA, voffA);
            PG8_WAIT_V(8); PG8_WAIT_L(0); PG8_BAR; PG8_MMA(0, 0, At, B0); PG8_MMA(0, 1, At, B1); PG8_BAR; PG8_SCHED;
            PG8_LDA(At, 0, 1); PG8_STAGE(PG8_SB(0, 0), b2, voffB); PG8_STAGE(PG8_SB(0, 1), b2 + hstepB, voffB); PG8_STAGE(PG8_SA(0, 0), a2, voffA);
            PG8_WAIT_V(8); PG8_WAIT_L(0); PG8_BAR; PG8_MMA(1, 0, At, B0); PG8_MMA(1, 1, At, B1); PG8_BAR; PG8_SCHED;
            PG8_LDB(B0, 1, 0); PG8_LDB(B1, 1, 1); PG8_SCHED; PG8_LDA(At, 1, 0); PG8_STAGE(PG8_SA(0, 1), a2 + hstepA, voffA);
            PG8_WAIT_V(8); PG8_WAIT_L(0); PG8_BAR; PG8_MMA(0, 0, At, B0); PG8_MMA(0, 1, At, B1); PG8_BAR; PG8_SCHED;
            PG8_LDA(At, 1, 1); PG8_STAGE(PG8_SB(1, 0), b3, voffB); PG8_STAGE(PG8_SB(1, 1), b3 + hstepB, voffB); PG8_STAGE(PG8_SA(1, 0), a3, voffA);
            PG8_WAIT_V(8); PG8_WAIT_L(0); PG8_BAR; PG8_MMA(1, 0, At, B0); PG8_MMA(1, 1, At, B1); PG8_BAR; PG8_SCHED;
        }
        if constexpr (ALIGN_EPI) { if (wr == 0) PG8_BAR; }
        E(acc, cur, wr, wc, fr, fq);
        if (!has_next) break;
#pragma unroll
        for (int a = 0; a < 2; ++a)
#pragma unroll
            for (int b = 0; b < 2; ++b)
#pragma unroll
                for (int m = 0; m < 4; ++m)
#pragma unroll
                    for (int n = 0; n < 2; ++n) acc[a][b][m][n] = (f32x4){0.f, 0.f, 0.f, 0.f};
        cur = nxt; cA = nA; cB = nB; ++ui;
        if constexpr (ALIGN_EPI) { if (wr == 1) PG8_BAR; }
    }
    PG8_WAIT_V(0);
    if constexpr (!ALIGN_EPI) { if (wr == 0) PG8_BAR; }
    PG8_BAR;
#undef PG8_SA
#undef PG8_SB
#undef PG8_STAGE
#undef PG8_LDA
#undef PG8_LDB
#undef PG8_MMA
#undef PG8_WAIT_V
#undef PG8_WAIT_L
#undef PG8_BAR
#undef PG8_SCHED
}

struct EpiStore {
    static constexpr bool PERM = true;
    bf16_t* O; int ldc; const float* ss; int ss_lo, ss_n; float inv_dim;
    __device__ __forceinline__ void operator()(const f32x4 (&acc)[2][2][4][2], const Unit& u, int wr, int wc, int fr, int fq) const {
#pragma unroll
        for (int ai = 0; ai < 2; ++ai)
#pragma unroll
            for (int m = 0; m < 4; ++m) {
                const int row = u.pm * BM + ai * HALF + wr * 64 + m * 16 + fr;
                const float sc = ss ? rowscale(ss, row, ss_lo, ss_n, inv_dim) : 1.f;
#pragma unroll
                for (int bj = 0; bj < 2; ++bj) {
                    const int col = u.pn * BM + bj * HALF + wc * 32 + 8 * fq;
                    const f32x4 v0 = acc[ai][bj][m][0] * sc, v1 = acc[ai][bj][m][1] * sc;
                    u32x4 w; w.x = pk2(v0[0], v0[1]); w.y = pk2(v0[2], v0[3]); w.z = pk2(v1[0], v1[1]); w.w = pk2(v1[2], v1[3]);
                    *(u32x4*)(O + (size_t)row * ldc + col) = w;
                }
                asm volatile("" ::: "memory");
            }
    }
};
struct EpiDN {
    static constexpr bool PERM = true;
    bf16_t* QKV; bf16_t* Z; float* AB; bf16_t* HALO; const float* ss;
    __device__ __forceinline__ void operator()(const f32x4 (&acc)[2][2][4][2], const Unit& u, int wr, int wc, int fr, int fq) const {
#pragma unroll
        for (int ai = 0; ai < 2; ++ai)
#pragma unroll
            for (int m = 0; m < 4; ++m) {
                const int row = u.pm * BM + ai * HALF + wr * 64 + m * 16 + fr;
                const float sc = rowscale(ss, row, 0, 16, 1.0f / D);
#pragma unroll
                for (int bj = 0; bj < 2; ++bj) {
                    const int col = u.pn * BM + bj * HALF + wc * 32 + 8 * fq;
                    const f32x4 v0 = acc[ai][bj][m][0] * sc, v1 = acc[ai][bj][m][1] * sc;
                    u32x4 w; w.x = pk2(v0[0], v0[1]); w.y = pk2(v0[2], v0[3]); w.z = pk2(v1[0], v1[1]); w.w = pk2(v1[2], v1[3]);
                    if (u.pn < 12) {
                        *(u32x4*)(QKV + (size_t)row * 3072 + col) = w;
                        const int rl = row & 255;
                        if (rl >= 253 && u.pm + 1 < 64) *(u32x4*)(HALO + ((size_t)(u.pm + 1) * 3 + (rl - 253)) * 3072 + col) = w;
                    } else if (u.pn < 16) {
                        *(u32x4*)(Z + (size_t)row * 1024 + (col - 3072)) = w;
                    } else if (bj == 0 && wc == 0 && fq < 2) {
                        *(f32x4*)(AB + (size_t)row * 16 + 8 * fq) = v0; *(f32x4*)(AB + (size_t)row * 16 + 8 * fq + 4) = v1;
                    }
                }
                asm volatile("" ::: "memory");
            }
    }
};
struct EpiSwiglu {
    static constexpr bool PERM = true;
    bf16_t* H; const float* ss;
    __device__ __forceinline__ void operator()(const f32x4 (&acc)[2][2][4][2], const Unit& u, int wr, int wc, int fr, int fq) const {
#pragma unroll
        for (int ai = 0; ai < 2; ++ai)
#pragma unroll
            for (int m = 0; m < 4; ++m) {
                const int row = u.pm * BM + ai * HALF + wr * 64 + m * 16 + fr;
                const float sc = rowscale(ss, row, 0, 16, 1.0f / D);
                const int col = u.pn * HALF + wc * 32 + 8 * fq;
                float h[8];
#pragma unroll
                for (int n = 0; n < 2; ++n)
#pragma unroll
                    for (int i = 0; i < 4; ++i) { const float gt = acc[ai][0][m][n][i] * sc, up = acc[ai][1][m][n][i] * sc; h[4 * n + i] = silu_f(gt) * up; }
                u32x4 w; w.x = pk2(h[0], h[1]); w.y = pk2(h[2], h[3]); w.z = pk2(h[4], h[5]); w.w = pk2(h[6], h[7]);
                *(u32x4*)(H + (size_t)row * FH + col) = w;
                asm volatile("" ::: "memory");
            }
    }
};
struct EpiResidual {
    static constexpr bool PERM = false;
    const float* base; float* out; bf16_t* xb; float* ss;
    __device__ __forceinline__ void operator()(const f32x4 (&acc)[2][2][4][2], const Unit& u, int wr, int wc, int fr, int fq) const {
#pragma unroll
        for (int ai = 0; ai < 2; ++ai)
#pragma unroll
            for (int m = 0; m < 4; ++m) {
                const int row = u.pm * BM + ai * HALF + wr * 64 + m * 16 + fr;
                float s = 0.f;
#pragma unroll
                for (int bj = 0; bj < 2; ++bj)
#pragma unroll
                    for (int n = 0; n < 2; ++n) {
                        const int col = u.pn * BM + bj * HALF + wc * 32 + n * 16 + 4 * fq;
                        const size_t off = (size_t)row * D + col;
                        const f32x4 v = *(const f32x4*)(base + off) + acc[ai][bj][m][n];
                        *(f32x4*)(out + off) = v;
                        u32x2 w; w.x = pk2(v[0], v[1]); w.y = pk2(v[2], v[3]);
                        *(u32x2*)(xb + off) = w;
                        s += (v[0] * v[0] + v[1] * v[1]) + (v[2] * v[2] + v[3] * v[3]);
                    }
                s += __shfl_xor(s, 16); s += __shfl_xor(s, 32);
                if (fq == 0) ss[(size_t)row * 16 + u.pn * 4 + wc] = s;
                asm volatile("" ::: "memory");
            }
    }
};
struct EpiMlaDown {
    static constexpr bool PERM = true;
    bf16_t* C; float* ss2; const float* ss;
    __device__ __forceinline__ void operator()(const f32x4 (&acc)[2][2][4][2], const Unit& u, int wr, int wc, int fr, int fq) const {
#pragma unroll
        for (int ai = 0; ai < 2; ++ai)
#pragma unroll
            for (int m = 0; m < 4; ++m) {
                const int row = u.pm * BM + ai * HALF + wr * 64 + m * 16 + fr;
                const float sc = rowscale(ss, row, 0, 16, 1.0f / D);
#pragma unroll
                for (int bj = 0; bj < 2; ++bj) {
                    const int col = u.pn * BM + bj * HALF + wc * 32 + 8 * fq;
                    const f32x4 v0 = acc[ai][bj][m][0] * sc, v1 = acc[ai][bj][m][1] * sc;
                    u32x4 w; w.x = pk2(v0[0], v0[1]); w.y = pk2(v0[2], v0[3]); w.z = pk2(v1[0], v1[1]); w.w = pk2(v1[2], v1[3]);
                    *(u32x4*)(C + (size_t)row * 512 + col) = w;
                    float s = (v0[0] * v0[0] + v0[1] * v0[1]) + (v0[2] * v0[2] + v0[3] * v0[3]) + (v1[0] * v1[0] + v1[1] * v1[1]) + (v1[2] * v1[2] + v1[3] * v1[3]);
                    s += __shfl_xor(s, 16); s += __shfl_xor(s, 32);
                    if (fq == 0) ss2[(size_t)row * 16 + u.pn * 8 + bj * 4 + wc] = s;
                }
                asm volatile("" ::: "memory");
            }
    }
};
}

#define XB_TMO      128
#define XB_XCNT(j)  (256  + 64 * (j))
#define XB_XSUB(j)  (1280 + 64 * (j))
#define XB_XGEN(j)  (2304 + 64 * (j))
#define XB_TOP      3328
#define XB_TOPGEN   3392
#define XCD_BAR_WORDS 3456
#define XB_SPIN_CAP (1u << 20)
__device__ __forceinline__ unsigned xb_ld(unsigned* p)              { return __hip_atomic_load(p, __ATOMIC_RELAXED, __HIP_MEMORY_SCOPE_AGENT); }
__device__ __forceinline__ unsigned xb_add(unsigned* p, unsigned v) { return __hip_atomic_fetch_add(p, v, __ATOMIC_RELAXED, __HIP_MEMORY_SCOPE_AGENT); }
__device__ __forceinline__ unsigned xb_xcc_id() { return (unsigned)__builtin_amdgcn_s_getreg((3 << 11) | 20) & 0xFu; }
#define XB_SPIN(cond, bar) do { unsigned _sp = 0; while (cond) { __builtin_amdgcn_s_sleep(1); \
    if ((++_sp & 255u) == 0u) { if (xb_ld(&(bar)[XB_TMO])) break; if (_sp > XB_SPIN_CAP) { atomicAdd(&(bar)[XB_TMO], 1u); break; } } } } while (0)
struct XcdBarrier { unsigned* bar; unsigned x; volatile LAS unsigned* st; };
__device__ __forceinline__ XcdBarrier xcd_barrier_post(unsigned* bar, volatile LAS unsigned* st, int tid) {
    XcdBarrier b; b.bar = bar; b.x = xb_xcc_id(); b.st = st;
    if (tid == 0) (void)xb_add(&bar[XB_XCNT(b.x)], 1u);
    return b;
}
__device__ __forceinline__ void xcd_barrier_complete(unsigned* bar, unsigned x, unsigned& nloc, unsigned& nx) {
    const unsigned G = gridDim.x * gridDim.y * gridDim.z;
    unsigned sum, cnt, mine, sp = 0u;
    for (;;) {
        sum = 0u; cnt = 0u; mine = 0u;
#pragma unroll
        for (unsigned j = 0; j < 16; ++j) { const unsigned c = xb_ld(&bar[XB_XCNT(j)]); sum += c; cnt += (c > 0u) ? 1u : 0u; mine = (j == x) ? c : mine; }
        if (sum == G) break;
        __builtin_amdgcn_s_sleep(1);
        if ((++sp & 255u) == 0u) { if (xb_ld(&bar[XB_TMO])) break; if (sp > XB_SPIN_CAP) { atomicAdd(&bar[XB_TMO], 1u); break; } }
    }
    nloc = mine > 0u ? mine : 1u; nx = cnt > 0u ? cnt : 1u;
}
__device__ __forceinline__ void xcd_barrier(const XcdBarrier& b, int tid) {
    asm volatile("s_waitcnt vmcnt(0)" ::: "memory");
    __syncthreads();
    if (tid == 0) {
        unsigned* bar = b.bar;
        __builtin_amdgcn_s_waitcnt(0);
        unsigned nloc = b.st[0], nx = b.st[1];
        if (nloc == 0u) { xcd_barrier_complete(bar, b.x, nloc, nx); b.st[0] = nloc; b.st[1] = nx; }
        const unsigned old = xb_add(&bar[XB_XSUB(b.x)], 1u);
        const unsigned gen = old / nloc;
        if (old + 1u == (gen + 1u) * nloc) {
            __builtin_amdgcn_fence(__ATOMIC_RELEASE, "agent");
            asm volatile("s_waitcnt vmcnt(0)" ::: "memory");
            const unsigned og = xb_add(&bar[XB_TOP], 1u);
            const unsigned tg = og / nx;
            if (og + 1u == (tg + 1u) * nx) xb_add(&bar[XB_TOPGEN], 1u);
            else XB_SPIN(xb_ld(&bar[XB_TOPGEN]) == tg, bar);
            __builtin_amdgcn_fence(__ATOMIC_ACQUIRE, "agent");
            xb_add(&bar[XB_XGEN(b.x)], 1u);
            asm volatile("s_waitcnt vmcnt(0)" ::: "memory");
        } else {
            XB_SPIN(xb_ld(&bar[XB_XGEN(b.x)]) == gen, bar);
            __builtin_amdgcn_fence(__ATOMIC_ACQUIRE, "agent");
            asm volatile("s_waitcnt vmcnt(0)" ::: "memory");
        }
    }
    __syncthreads();
}

__device__ __forceinline__ void cvt_item(const float* W, int K, int N, bf16_t* WT, const float* gain, int swiglu, LAS float* scr, int item, int lane) {
    const int nblk = (N + 31) / 32, kb = item / nblk, nb = item % nblk, k0 = 64 * kb, n0 = 32 * nb;
    const int nn = n0 + (lane & 31);
#pragma unroll 8
    for (int i = 0; i < 32; ++i) { const int kk = 2 * i + (lane >> 5);
        float v = (nn < N) ? W[(size_t)(k0 + kk) * N + nn] : 0.f;
        if (gain) v *= gain[k0 + kk];
        scr[kk * 33 + (lane & 31)] = v; }
    asm volatile("s_waitcnt lgkmcnt(0)" ::: "memory");
    const int c = lane & 7;
#pragma unroll
    for (int j = 0; j < 4; ++j) { const int n = (lane >> 3) + 8 * j; const LAS float* s = scr + (8 * c) * 33 + n;
        u32x4 o; o.x = pk2(s[0 * 33], s[1 * 33]); o.y = pk2(s[2 * 33], s[3 * 33]); o.z = pk2(s[4 * 33], s[5 * 33]); o.w = pk2(s[6 * 33], s[7 * 33]);
        int dn = n0 + n;
        if (swiglu) { const int isup = dn >= FH; const int jj = isup ? dn - FH : dn; dn = (jj >> 7) * 256 + isup * 128 + (jj & 127); }
        *(u32x4*)(WT + (size_t)dn * K + k0 + 8 * c) = o; }
    asm volatile("s_waitcnt lgkmcnt(0)" ::: "memory");
}
__device__ __forceinline__ void cvt_weight(const float* W, int K, int N, int Npad, bf16_t* WT, const float* gain, int swiglu, LAS unsigned char* lds, int gw, int ngw, int wave, int lane) {
    LAS float* scr = (LAS float*)(lds + wave * 8704);
    const int nblk = (N + 31) / 32, nitems = (K / 64) * nblk;
    for (int it = gw; it < nitems; it += ngw) cvt_item(W, K, N, WT, gain, swiglu, scr, it, lane);
    const int zr0 = nblk * 32; const int nz = (Npad - zr0) * (K / 8);
    unsigned z0 = 0u; asm volatile("" : "+v"(z0));
    for (int i = gw * 64 + lane; i < nz; i += ngw * 64) *(u32x4*)(WT + (size_t)zr0 * K + (size_t)i * 8) = (u32x4){z0, z0, z0, z0};
}

struct Args { const float* in[43]; float* out; unsigned char* ws; int ph_lo, ph_hi; };

struct Ctx {
    LAS unsigned char* lds; unsigned char* ws; int tid, lane, wave, gw, ngw;
};

__device__ __forceinline__ void convert_mixer(const Args& a, const Ctx& c, int L) {
    unsigned char* ws = c.ws;
    if (L == 0 || L == 3) {
        const int b = (L == 0) ? 1 : 33;
        cvt_weight(a.in[b + 1], D, 4112, 4352, (bf16_t*)(ws + WS_WMIX), a.in[b], 0, c.lds, c.gw, c.ngw, c.wave, c.lane);
        cvt_weight(a.in[b + 6], D, D, D, (bf16_t*)(ws + WS_WMIX_OUT), nullptr, 0, c.lds, c.gw, c.ngw, c.wave, c.lane);
    } else if (L == 1) {
        cvt_weight(a.in[12], D, 3072, 3072, (bf16_t*)(ws + WS_WMIX), a.in[11], 0, c.lds, c.gw, c.ngw, c.wave, c.lane);
        cvt_weight(a.in[15], D, D, D, (bf16_t*)(ws + WS_WMIX_OUT), nullptr, 0, c.lds, c.gw, c.ngw, c.wave, c.lane);
    } else {
        cvt_weight(a.in[20], D, 448, 512, (bf16_t*)(ws + WS_WMIX), a.in[19], 0, c.lds, c.gw, c.ngw, c.wave, c.lane);
        cvt_weight(a.in[23], 256, 1536, 1536, (bf16_t*)(ws + WS_WMIX + 1 * MiB), a.in[21], 0, c.lds, c.gw, c.ngw, c.wave, c.lane);
        cvt_weight(a.in[24], 128, 2048, 2048, (bf16_t*)(ws + WS_WMIX + 2 * MiB), a.in[22], 0, c.lds, c.gw, c.ngw, c.wave, c.lane);
        cvt_weight(a.in[29], D, D, D, (bf16_t*)(ws + WS_WMIX_OUT), nullptr, 0, c.lds, c.gw, c.ngw, c.wave, c.lane);
    }
}
__device__ __forceinline__ void convert_ffn(const Args& a, const Ctx& c, int L) {
    const int b = (L == 0) ? 8 : (L == 1) ? 16 : (L == 2) ? 30 : 40;
    cvt_weight(a.in[b + 1], D, 2 * FH, 2 * FH, (bf16_t*)(c.ws + WS_WFFN), a.in[b], 1, c.lds, c.gw, c.ngw, c.wave, c.lane);
    cvt_weight(a.in[b + 2], FH, D, D, (bf16_t*)(c.ws + WS_WFFN_DN), nullptr, 0, c.lds, c.gw, c.ngw, c.wave, c.lane);
}

__device__ __forceinline__ void prologue_rows(const Args& a, const Ctx& c) {
    const float* x = a.in[0]; bf16_t* xb = (bf16_t*)(c.ws + WS_R1); float* ss = (float*)(c.ws + WS_SS);
    for (int m = c.gw; m < M; m += c.ngw) {
        const f32x4* xr = (const f32x4*)(x + (size_t)m * D) + c.lane;
        f32x4 v[4]; float s = 0.f;
#pragma unroll
        for (int j = 0; j < 4; ++j) { v[j] = xr[64 * j]; s += (v[j][0] * v[j][0] + v[j][1] * v[j][1]) + (v[j][2] * v[j][2] + v[j][3] * v[j][3]); }
        s = wave_sum(s);
        u32x2* o = (u32x2*)(xb + (size_t)m * D) + c.lane;
#pragma unroll
        for (int j = 0; j < 4; ++j) { u32x2 w; w.x = pk2(v[j][0], v[j][1]); w.y = pk2(v[j][2], v[j][3]); o[64 * j] = w; }
        if (c.lane < 16) ss[(size_t)m * 16 + c.lane] = (c.lane == 0) ? s : 0.f;
    }
}

__device__ __forceinline__ void dn_conv(const Args& a, const Ctx& c, const float* conv_w) {
    bf16_t* QKV = (bf16_t*)(c.ws + WS_R2); const bf16_t* HALO = (const bf16_t*)(c.ws + WS_HALO); float* RS = (float*)(c.ws + WS_RS);
    const int cg8 = c.tid & 15, seg = c.tid >> 4;
    for (int item = blockIdx.x; item < 64 * 24; item += gridDim.x) {
        const int pm = item / 24, slab = item % 24, which = slab >> 3, h = slab & 7;
        const int gcol = slab * 128 + cg8 * 8; const int row0 = pm * 256 + seg * 8;
        u32x4 raw[11];
#pragma unroll
        for (int i = 0; i < 3; ++i) {
            if (seg == 0) { raw[i] = ((pm & 15) == 0) ? (u32x4){0u, 0u, 0u, 0u} : *(const u32x4*)(HALO + ((size_t)pm * 3 + i) * 3072 + gcol); }
            else raw[i] = *(const u32x4*)(QKV + (size_t)(row0 - 3 + i) * 3072 + gcol);
        }
#pragma unroll
        for (int i = 0; i < 8; ++i) raw[3 + i] = *(const u32x4*)(QKV + (size_t)(row0 + i) * 3072 + gcol);
        float w[4][8];
#pragma unroll
        for (int j = 0; j < 4; ++j) { const f32x4 w0 = *(const f32x4*)(conv_w + j * 3072 + gcol), w1 = *(const f32x4*)(conv_w + j * 3072 + gcol + 4);
#pragma unroll
            for (int e = 0; e < 4; ++e) { w[j][e] = w0[e]; w[j][4 + e] = w1[e]; } }
        __syncthreads();
#pragma unroll
        for (int r = 0; r < 8; ++r) {
            u32x4 o; float ssq = 0.f;
#pragma unroll
            for (int e2 = 0; e2 < 4; ++e2) {
                float y0 = 0.f, y1 = 0.f;
#pragma unroll
                for (int j = 0; j < 4; ++j) { const unsigned wv = raw[r + j][e2]; y0 += w[j][2 * e2] * bflo(wv); y1 += w[j][2 * e2 + 1] * bfhi(wv); }
                const unsigned pk = pk2(silu_f(y0), silu_f(y1)); o[e2] = pk;
                const float s0 = bflo(pk), s1 = bfhi(pk); ssq += s0 * s0 + s1 * s1;
            }
            *(u32x4*)(QKV + (size_t)(row0 + r) * 3072 + gcol) = o;
            if (which < 2) {
                ssq += __shfl_xor(ssq, 1); ssq += __shfl_xor(ssq, 2); ssq += __shfl_xor(ssq, 4); ssq += __shfl_xor(ssq, 8);
                if (cg8 == 0) RS[(size_t)(row0 + r) * 16 + which * 8 + h] = (1.0f / sqrtf(ssq + EPS)) * (which == 0 ? 0.08838834764831845f : 1.f);
            }
        }
        __syncthreads();
    }
}

constexpr int DB_LM = 0, DB_GC = 17408, DB_BETA = 17664, DB_KB = 17920, DB_QB = 35328, DB_K32 = 52736, DB_V32 = 86528;
__device__ __forceinline__ void dn_chunk(const Args& a, const Ctx& c, const float* a_log, const float* dt_bias) {
    bf16_t* QKV = (bf16_t*)(c.ws + WS_R2); bf16_t* KT = (bf16_t*)(c.ws + WS_R1); bf16_t* ATT = (bf16_t*)(c.ws + WS_R5);
    const float* AB = (const float*)(c.ws + WS_AB); const float* RS = (const float*)(c.ws + WS_RS); float* GC = (float*)(c.ws + WS_GC);
    LAS bf16_t* kb = (LAS bf16_t*)(c.lds + DB_KB); LAS bf16_t* qb = (LAS bf16_t*)(c.lds + DB_QB);
    LAS float* K32 = (LAS float*)(c.lds + DB_K32); LAS float* V32 = (LAS float*)(c.lds + DB_V32); LAS float* Lm = (LAS float*)(c.lds + DB_LM);
    LAS float* gcs = (LAS float*)(c.lds + DB_GC); LAS float* betas = (LAS float*)(c.lds + DB_BETA);
    const int lane = c.lane, wave = c.wave, quad = lane >> 4, l15 = lane & 15;
    for (int item = blockIdx.x; item < BATCH * 64 * NH; item += gridDim.x) {
        const int h = item & 7, n = (item >> 3) & 63, b = item >> 9;
        const int t0 = b * SEQ + n * 64;
        if (wave == 0) {
            const float av = AB[(size_t)(t0 + lane) * 16 + h], bl = AB[(size_t)(t0 + lane) * 16 + 8 + h];
            float g = -fexp(a_log[h]) * softplus_f(av + dt_bias[h]);
#pragma unroll
            for (int o = 1; o < 64; o <<= 1) { const float t = __shfl_up(g, o); if (lane >= o) g += t; }
            gcs[lane] = g; betas[lane] = 1.f / (1.f + fexp(-bl));
            GC[(size_t)(t0 + lane) * 8 + h] = g;
        }
        __syncthreads();
        {
            const int r = c.tid >> 3, cc = (c.tid & 7) * 16;
            const size_t rowoff = (size_t)(t0 + r) * 3072 + h * 128 + cc;
            const float rsq = RS[(size_t)(t0 + r) * 16 + h], rsk = RS[(size_t)(t0 + r) * 16 + 8 + h];
            const float be = betas[r], eg = fexp(gcs[r]);
            u32x4 qw[2], kw[2], vw[2];
#pragma unroll
            for (int i = 0; i < 2; ++i) { qw[i] = *(const u32x4*)(QKV + rowoff + 8 * i); kw[i] = *(const u32x4*)(QKV + rowoff + 1024 + 8 * i); vw[i] = *(const u32x4*)(QKV + rowoff + 2048 + 8 * i); }
#pragma unroll
            for (int i = 0; i < 2; ++i) {
                u32x4 qo, ko;
#pragma unroll
                for (int j = 0; j < 4; ++j) {
                    const float q0 = bflo(qw[i][j]) * rsq, q1 = bfhi(qw[i][j]) * rsq;
                    const float k0 = bflo(kw[i][j]) * rsk, k1 = bfhi(kw[i][j]) * rsk;
                    const float v0 = bflo(vw[i][j]), v1 = bfhi(vw[i][j]);
                    qo[j] = pk2(q0, q1); ko[j] = pk2(k0, k1);
                    const int cidx = cc + 8 * i + 2 * j;
                    K32[r * 132 + cidx] = k0 * be * eg; K32[r * 132 + cidx + 1] = k1 * be * eg;
                    V32[r * 132 + cidx] = v0 * be; V32[r * 132 + cidx + 1] = v1 * be;
                }
                *(LAS u32x4*)(qb + r * 136 + cc + 8 * i) = qo; *(LAS u32x4*)(kb + r * 136 + cc + 8 * i) = ko;
            }
        }
        __syncthreads();
        {
            const int wm = wave & 3; const LAS bf16_t* Asrc = (wave < 4) ? kb : qb;
            f32x4 acc[4];
#pragma unroll
            for (int nt = 0; nt < 4; ++nt) acc[nt] = (f32x4){0.f, 0.f, 0.f, 0.f};
#pragma unroll
            for (int ks = 0; ks < 4; ++ks) {
                const bf16x8 af = *(const LAS bf16x8*)(Asrc + (16 * wm + l15) * 136 + 32 * ks + 8 * quad);
#pragma unroll
                for (int nt = 0; nt < 4; ++nt) {
                    const bf16x8 bfr = *(const LAS bf16x8*)(kb + (16 * nt + l15) * 136 + 32 * ks + 8 * quad);
                    acc[nt] = __builtin_amdgcn_mfma_f32_16x16x32_bf16(af, bfr, acc[nt], 0, 0, 0);
                }
            }
            bf16_t* att = ATT + (size_t)((b * NH + h) * 64 + n) * 4096;
#pragma unroll
            for (int nt = 0; nt < 4; ++nt)
#pragma unroll
                for (int r = 0; r < 4; ++r) {
                    const int cr = 16 * wm + 4 * quad + r, cs = 16 * nt + l15;
                    const float dec = fexp(fminf(gcs[cr] - gcs[cs], 0.f));
                    if (wave < 4) Lm[cr * 68 + cs] = (cr > cs) ? betas[cr] * acc[nt][r] * dec : 0.f;
                    else att[cr * 64 + cs] = (bf16_t)f2bf((cr >= cs) ? acc[nt][r] * dec : 0.f);
                }
        }
        __syncthreads();
        if (wave < 4) {
            const int j = wave * 64 + lane;
            const LAS float* rhs = (j < 128) ? (V32 + j) : (K32 + (j - 128));
            float sol[64];
#pragma unroll
            for (int i = 0; i < 64; ++i) {
                float a0 = rhs[i * 132], a1 = 0.f;
#pragma unroll
                for (int jb = 0; jb < i; jb += 4) {
                    const f32x4 lv = *(const LAS f32x4*)(Lm + i * 68 + jb);
                    a0 -= lv[0] * sol[jb];
                    if (jb + 1 < i) a1 -= lv[1] * sol[jb + 1];
                    if (jb + 2 < i) a0 -= lv[2] * sol[jb + 2];
                    if (jb + 3 < i) a1 -= lv[3] * sol[jb + 3];
                }
                sol[i] = a0 + a1;
            }
            bf16_t* dst = QKV + (size_t)t0 * 3072 + ((j < 128) ? (2048 + h * 128 + j) : (1024 + h * 128 + (j - 128)));
#pragma unroll
            for (int i = 0; i < 64; ++i) dst[(size_t)i * 3072] = (bf16_t)f2bf(sol[i]);
        } else {
            const int t = c.tid - 256, dk = t & 127, ch = t >> 7;
            bf16_t* kt = KT + (size_t)((b * NH + h) * 64 + n) * 8192 + dk * 64 + ch * 32;
#pragma unroll
            for (int g4 = 0; g4 < 4; ++g4) {
                u32x4 w;
#pragma unroll
                for (int e = 0; e < 4; ++e) { const int cc = ch * 32 + g4 * 8 + 2 * e; w[e] = (unsigned)kb[cc * 136 + dk] | ((unsigned)kb[(cc + 1) * 136 + dk] << 16); }
                *(u32x4*)(kt + g4 * 8) = w;
            }
            const int r = t >> 2, c0 = (t & 3) * 32;
#pragma unroll
            for (int i = 0; i < 4; ++i) *(u32x4*)(QKV + (size_t)(t0 + r) * 3072 + h * 128 + c0 + 8 * i) = *(const LAS u32x4*)(qb + r * 136 + c0 + 8 * i);
        }
        __syncthreads();
    }
}

__device__ __forceinline__ bf16x8 ld2x4(const bf16_t* p) {
    const u32x2 lo = *(const u32x2*)p, hi = *(const u32x2*)(p + 16);
    u32x4 w; w.x = lo.x; w.y = lo.y; w.z = hi.x; w.w = hi.y; return __builtin_bit_cast(bf16x8, w);
}
__device__ __forceinline__ bf16x8 pack8(const f32x4 a, const f32x4 b) {
    u32x4 w; w.x = pk2(a[0], a[1]); w.y = pk2(a[2], a[3]); w.z = pk2(b[0], b[1]); w.w = pk2(b[2], b[3]); return __builtin_bit_cast(bf16x8, w);
}
constexpr int SC_W = 0, SC_Q = 17408, SC_KT = 34816, SC_ATT = 53248, SC_U = 62464, SC_GC = 71680, SC_BUF = 71936;
__device__ __forceinline__ bf16x8 ld2x4_lds(const LAS bf16_t* p) {
    const u32x2 lo = *(const LAS u32x2*)p, hi = *(const LAS u32x2*)(p + 16);
    u32x4 w; w.x = lo.x; w.y = lo.y; w.z = hi.x; w.w = hi.y; return __builtin_bit_cast(bf16x8, w);
}
__device__ __forceinline__ void dn_scan(const Args& a, const Ctx& c) {
    const bf16_t* QKV = (const bf16_t*)(c.ws + WS_R2); const bf16_t* KT = (const bf16_t*)(c.ws + WS_R1); const bf16_t* ATT = (const bf16_t*)(c.ws + WS_R5);
    const float* GC = (const float*)(c.ws + WS_GC); bf16_t* O = (bf16_t*)(c.ws + WS_R4);
    const int lane = c.lane, wave = c.wave, quad = lane >> 4, l15 = lane & 15;
    for (int item = blockIdx.x; item < BATCH * NH * 2; item += gridDim.x) {
        const int half = item & 1, bh = item >> 1, b = bh >> 3, h = bh & 7;
        __syncthreads();
        const int pair = (wave >= 6) ? 1 : 0, lt = (c.tid - 256) & 127;
        u32x4 lv[32]; float lg = 0.f;
#define SCAN_LOAD(step) do { const int t0_ = b * SEQ + (step) * 64; const size_t ci_ = (size_t)(bh * 64 + (step)); \
            _Pragma("unroll") for (int i = 0; i < 8; ++i) { const int id = lt + 128 * i, row = id >> 4, ch = id & 15; \
                const bf16_t* p_ = QKV + (size_t)(t0_ + row) * 3072 + h * 128 + ch * 8; lv[i] = *(const u32x4*)(p_ + 1024); lv[8 + i] = *(const u32x4*)p_; } \
            _Pragma("unroll") for (int i = 0; i < 8; ++i) { const int id = lt + 128 * i; lv[16 + i] = *(const u32x4*)(KT + ci_ * 8192 + (size_t)id * 8); } \
            _Pragma("unroll") for (int i = 0; i < 4; ++i) { const int id = lt + 128 * i, row = id >> 3, ch = id & 7; \
                lv[24 + i] = *(const u32x4*)(ATT + ci_ * 4096 + (size_t)id * 8); \
                lv[28 + i] = *(const u32x4*)(QKV + (size_t)(t0_ + row) * 3072 + 2048 + h * 128 + half * 64 + ch * 8); } \
            if (lt < 64) lg = GC[(size_t)(t0_ + lt) * 8 + h]; } while (0)
        if (wave >= 4) { if (pair == 0) { SCAN_LOAD(0); } else { SCAN_LOAD(1); } }
        if (wave >= 4) {
            for (int n = -1; n < 64; ++n) {
                if (((n + 1) & 1) == pair) {
                    { const int nn = n + 1;
                      LAS unsigned char* buf = c.lds + (nn & 1) * SC_BUF;
#pragma unroll
                      for (int i = 0; i < 8; ++i) { const int id = lt + 128 * i, row = id >> 4, ch = id & 15;
                          *(LAS u32x4*)(buf + SC_W + (row * 136 + ch * 8) * 2) = lv[i]; *(LAS u32x4*)(buf + SC_Q + (row * 136 + ch * 8) * 2) = lv[8 + i]; }
#pragma unroll
                      for (int i = 0; i < 8; ++i) { const int id = lt + 128 * i, row = id >> 3, ch = id & 7; *(LAS u32x4*)(buf + SC_KT + (row * 72 + ch * 8) * 2) = lv[16 + i]; }
#pragma unroll
                      for (int i = 0; i < 4; ++i) { const int id = lt + 128 * i, row = id >> 3, ch = id & 7;
                          *(LAS u32x4*)(buf + SC_ATT + (row * 72 + ch * 8) * 2) = lv[24 + i]; *(LAS u32x4*)(buf + SC_U + (row * 72 + ch * 8) * 2) = lv[28 + i]; }
                      if (lt < 64) *(LAS float*)(buf + SC_GC + lt * 4) = lg; }
                    if (n + 3 < 64) { SCAN_LOAD(n + 3); }
                }
                LDS_BARRIER();
            }
        } else {
            f32x4 S[8];
#pragma unroll
            for (int mt = 0; mt < 8; ++mt) S[mt] = (f32x4){0.f, 0.f, 0.f, 0.f};
            LDS_BARRIER();
            for (int n = 0; n < 64; ++n) {
                const LAS unsigned char* buf = c.lds + (n & 1) * SC_BUF;
                const LAS bf16_t* Wl = (const LAS bf16_t*)(buf + SC_W); const LAS bf16_t* Ql = (const LAS bf16_t*)(buf + SC_Q);
                const LAS bf16_t* Kl = (const LAS bf16_t*)(buf + SC_KT); const LAS bf16_t* Al = (const LAS bf16_t*)(buf + SC_ATT);
                const LAS bf16_t* Ul = (const LAS bf16_t*)(buf + SC_U); const LAS float* gcl = (const LAS float*)(buf + SC_GC);
                const int t0 = b * SEQ + n * 64;
                bf16x8 Sb[4];
#pragma unroll
                for (int ks = 0; ks < 4; ++ks) Sb[ks] = pack8(S[2 * ks], S[2 * ks + 1]);
                bf16x8 Wf[4][4], Qf[4][4];
#pragma unroll
                for (int ct = 0; ct < 4; ++ct)
#pragma unroll
                    for (int ks = 0; ks < 4; ++ks) { const int off = (16 * ct + l15) * 136 + 32 * ks + 4 * quad; Wf[ct][ks] = ld2x4_lds(Wl + off); Qf[ct][ks] = ld2x4_lds(Ql + off); }
                __builtin_amdgcn_sched_barrier(0);
                f32x4 P[4], QS[4];
#pragma unroll
                for (int ct = 0; ct < 4; ++ct) { P[ct] = (f32x4){0.f, 0.f, 0.f, 0.f}; QS[ct] = (f32x4){0.f, 0.f, 0.f, 0.f}; }
#pragma unroll
                for (int ks = 0; ks < 4; ++ks)
#pragma unroll
                    for (int ct = 0; ct < 4; ++ct) {
                        P[ct] = __builtin_amdgcn_mfma_f32_16x16x32_bf16(Wf[ct][ks], Sb[ks], P[ct], 0, 0, 0);
                        QS[ct] = __builtin_amdgcn_mfma_f32_16x16x32_bf16(Qf[ct][ks], Sb[ks], QS[ct], 0, 0, 0);
                    }
                __builtin_amdgcn_sched_barrier(0);
                bf16x8 Af[4][2], Kf[8][2];
#pragma unroll
                for (int ct = 0; ct < 4; ++ct)
#pragma unroll
                    for (int k2 = 0; k2 < 2; ++k2) Af[ct][k2] = ld2x4_lds(Al + (16 * ct + l15) * 72 + 32 * k2 + 4 * quad);
#pragma unroll
                for (int mt = 0; mt < 8; ++mt)
#pragma unroll
                    for (int k2 = 0; k2 < 2; ++k2) Kf[mt][k2] = ld2x4_lds(Kl + (16 * mt + l15) * 72 + 32 * k2 + 4 * quad);
                float uu[4][4], gg[4][4];
#pragma unroll
                for (int ct = 0; ct < 4; ++ct)
#pragma unroll
                    for (int r = 0; r < 4; ++r) { const int cr = 16 * ct + 4 * quad + r; uu[ct][r] = bf2f(Ul[cr * 72 + 16 * wave + l15]); gg[ct][r] = gcl[cr]; }
                const float gL = gcl[63];
                __builtin_amdgcn_sched_barrier(0);
                f32x4 vn[4], vd[4], o[4];
#pragma unroll
                for (int ct = 0; ct < 4; ++ct)
#pragma unroll
                    for (int r = 0; r < 4; ++r) {
                        const float g = gg[ct][r];
                        const float v = uu[ct][r] - P[ct][r];
                        vn[ct][r] = v; vd[ct][r] = v * fexp(gL - g); o[ct][r] = QS[ct][r] * fexp(g);
                    }
                bf16x8 Vb[2], Vdb[2];
#pragma unroll
                for (int k2 = 0; k2 < 2; ++k2) { Vb[k2] = pack8(vn[2 * k2], vn[2 * k2 + 1]); Vdb[k2] = pack8(vd[2 * k2], vd[2 * k2 + 1]); }
                const float eL = fexp(gL);
#pragma unroll
                for (int mt = 0; mt < 8; ++mt) S[mt] = S[mt] * eL;
#pragma unroll
                for (int k2 = 0; k2 < 2; ++k2) {
#pragma unroll
                    for (int mt = 0; mt < 8; ++mt) S[mt] = __builtin_amdgcn_mfma_f32_16x16x32_bf16(Kf[mt][k2], Vdb[k2], S[mt], 0, 0, 0);
#pragma unroll
                    for (int ct = 0; ct < 4; ++ct) o[ct] = __builtin_amdgcn_mfma_f32_16x16x32_bf16(Af[ct][k2], Vb[k2], o[ct], 0, 0, 0);
                }
#pragma unroll
                for (int ct = 0; ct < 4; ++ct)
#pragma unroll
                    for (int r = 0; r < 4; ++r) O[(size_t)(t0 + 16 * ct + 4 * quad + r) * 1024 + h * 128 + (half * 4 + wave) * 16 + l15] = (bf16_t)f2bf(o[ct][r]);
                LDS_BARRIER();
            }
        }
    }
}

__device__ __forceinline__ void dn_post(const Args& a, const Ctx& c, const float* out_norm) {
    bf16_t* O = (bf16_t*)(c.ws + WS_R4); const bf16_t* Z = (const bf16_t*)(c.ws + WS_R3);
    const int cb = (c.lane & 7) * 16;
    float gn[16];
#pragma unroll
    for (int i = 0; i < 16; ++i) gn[i] = out_norm[cb + i];
    for (int m = c.gw; m < M; m += c.ngw) {
        u32x4 ow[2], zw[2];
#pragma unroll
        for (int i = 0; i < 2; ++i) { ow[i] = *(const u32x4*)(O + (size_t)m * D + c.lane * 16 + 8 * i); zw[i] = *(const u32x4*)(Z + (size_t)m * D + c.lane * 16 + 8 * i); }
        float ov[16], s = 0.f;
#pragma unroll
        for (int i = 0; i < 2; ++i)
#pragma unroll
            for (int j = 0; j < 4; ++j) { ov[8 * i + 2 * j] = bflo(ow[i][j]); ov[8 * i + 2 * j + 1] = bfhi(ow[i][j]); }
#pragma unroll
        for (int i = 0; i < 16; ++i) s += ov[i] * ov[i];
        s += __shfl_xor(s, 1); s += __shfl_xor(s, 2); s += __shfl_xor(s, 4);
        const float rs = 1.0f / sqrtf(s * (1.0f / 128.0f) + EPS);
        u32x4 res[2];
#pragma unroll
        for (int i = 0; i < 2; ++i)
#pragma unroll
            for (int j = 0; j < 4; ++j) {
                const float z0 = bflo(zw[i][j]), z1 = bfhi(zw[i][j]);
                res[i][j] = pk2(ov[8 * i + 2 * j] * rs * gn[8 * i + 2 * j] * silu_f(z0), ov[8 * i + 2 * j + 1] * rs * gn[8 * i + 2 * j + 1] * silu_f(z1));
            }
#pragma unroll
        for (int i = 0; i < 2; ++i) *(u32x4*)(O + (size_t)m * D + c.lane * 16 + 8 * i) = res[i];
    }
}

__device__ __forceinline__ void v_transpose(const Ctx& c, const bf16_t* src, int pitch, int head_stride, int col_base, bf16_t* Vt) {
    LAS bf16_t* tile = (LAS bf16_t*)c.lds;
    for (int item = blockIdx.x; item < BATCH * NH * 64; item += gridDim.x) {
        const int tb = item & 63, h = (item >> 6) & 7, b = item >> 9;
        const int t0 = b * SEQ + tb * 64;
        { const int r = c.tid >> 3, cc = (c.tid & 7) * 16;
          const bf16_t* p = src + (size_t)(t0 + r) * pitch + col_base + h * head_stride + cc;
          *(LAS u32x4*)(tile + r * 136 + cc) = *(const u32x4*)p; *(LAS u32x4*)(tile + r * 136 + cc + 8) = *(const u32x4*)(p + 8); }
        __syncthreads();
        { const int d = c.tid >> 2, tq = (c.tid & 3) * 16;
          u32x4 w[2];
#pragma unroll
          for (int i = 0; i < 2; ++i)
#pragma unroll
              for (int e = 0; e < 4; ++e) { const int t = tq + 8 * i + 2 * e; w[i][e] = (unsigned)tile[t * 136 + d] | ((unsigned)tile[(t + 1) * 136 + d] << 16); }
          bf16_t* dst = Vt + ((size_t)((b * NH + h) * 128 + d)) * SEQ + tb * 64 + tq;
          *(u32x4*)dst = w[0]; *(u32x4*)(dst + 8) = w[1]; }
        __syncthreads();
    }
}

__device__ __forceinline__ void sb_prep_rows(const Args& a, const Ctx& c, const float* qn, const float* kn) {
    bf16_t* QKV = (bf16_t*)(c.ws + WS_R2);
    const int cb = (c.lane & 7) * 16;
    float gq[16], gk[16];
#pragma unroll
    for (int i = 0; i < 16; ++i) { gq[i] = qn[cb + i] * 0.08838834764831845f; gk[i] = kn[cb + i]; }
    for (int m = c.gw; m < M; m += c.ngw) {
#pragma unroll
        for (int which = 0; which < 2; ++which) {
            bf16_t* p = QKV + (size_t)m * 3072 + which * 1024 + c.lane * 16;
            u32x4 w[2]; w[0] = *(const u32x4*)p; w[1] = *(const u32x4*)(p + 8);
            float v[16], s = 0.f;
#pragma unroll
            for (int i = 0; i < 2; ++i)
#pragma unroll
                for (int j = 0; j < 4; ++j) { v[8 * i + 2 * j] = bflo(w[i][j]); v[8 * i + 2 * j + 1] = bfhi(w[i][j]); }
#pragma unroll
            for (int i = 0; i < 16; ++i) s += v[i] * v[i];
            s += __shfl_xor(s, 1); s += __shfl_xor(s, 2); s += __shfl_xor(s, 4);
            const float rs = 1.0f / sqrtf(s * (1.0f / 128.0f) + EPS);
            u32x4 o[2];
#pragma unroll
            for (int i = 0; i < 2; ++i)
#pragma unroll
                for (int j = 0; j < 4; ++j) {
                    const float g0 = which ? gk[8 * i + 2 * j] : gq[8 * i + 2 * j], g1 = which ? gk[8 * i + 2 * j + 1] : gq[8 * i + 2 * j + 1];
                    o[i][j] = pk2(v[8 * i + 2 * j] * rs * g0, v[8 * i + 2 * j + 1] * rs * g1);
                }
            *(u32x4*)p = o[0]; *(u32x4*)(p + 8) = o[1];
        }
    }
}

__device__ __forceinline__ void mla_prep_rows(const Args& a, const Ctx& c) {
    bf16_t* Q = (bf16_t*)(c.ws + WS_R2); bf16_t* Kf = (bf16_t*)(c.ws + WS_R2 + 48 * MiB);
    const bf16_t* KV = (const bf16_t*)(c.ws + WS_R3); const bf16_t* C = (const bf16_t*)(c.ws + WS_R5);
    const float* gqn = a.in[25]; const float* gqr = a.in[26]; const float* gkn = a.in[27]; const float* gkr = a.in[28];
    const int lane = c.lane, h = lane >> 3, p = lane & 7;
    const float SC = 0.07216878364870322f;
    float g_qn[16], g_kn[16], g_qr[8], g_kr[8], invf[8];
#pragma unroll
    for (int i = 0; i < 16; ++i) { g_qn[i] = gqn[16 * p + i] * SC; g_kn[i] = gkn[16 * p + i]; }
#pragma unroll
    for (int i = 0; i < 8; ++i) { g_qr[i] = gqr[8 * p + i] * SC; g_kr[i] = gkr[8 * p + i];
        invf[i] = __builtin_amdgcn_exp2f(-(float)(2 * ((8 * p + i) & 31)) * (1.0f / 64.0f) * 13.287712379549449f); }
    const bool first = p < 4;
    for (int m = c.gw; m < M; m += c.ngw) {
        const int t = m & (SEQ - 1);
        const bf16_t* qp = Q + (size_t)m * 1536 + h * 192;
        const u32x4 qn0 = *(const u32x4*)(qp + 16 * p), qn1 = *(const u32x4*)(qp + 16 * p + 8), qr = *(const u32x4*)(qp + 128 + 8 * p);
        const bf16_t* kvp = KV + (size_t)m * 2048 + h * 256;
        const u32x4 kn0 = *(const u32x4*)(kvp + 16 * p), kn1 = *(const u32x4*)(kvp + 16 * p + 8);
        const u32x4 kr = *(const u32x4*)(C + (size_t)m * 512 + 384 + 8 * p);
        float cs[8], sn[8];
#pragma unroll
        for (int i = 0; i < 8; ++i) { const float ang = (float)t * invf[i]; const double rev = (double)ang * 0.15915494309189535; const float fr = (float)(rev - floor(rev));
            cs[i] = __builtin_amdgcn_cosf(fr); sn[i] = __builtin_amdgcn_sinf(fr); }
        float qv[16], kv[16], qrv[8], krv[8];
#pragma unroll
        for (int j = 0; j < 4; ++j) { qv[2 * j] = bflo(qn0[j]); qv[2 * j + 1] = bfhi(qn0[j]); qv[8 + 2 * j] = bflo(qn1[j]); qv[9 + 2 * j] = bfhi(qn1[j]);
            kv[2 * j] = bflo(kn0[j]); kv[2 * j + 1] = bfhi(kn0[j]); kv[8 + 2 * j] = bflo(kn1[j]); kv[9 + 2 * j] = bfhi(kn1[j]);
            qrv[2 * j] = bflo(qr[j]); qrv[2 * j + 1] = bfhi(qr[j]); krv[2 * j] = bflo(kr[j]); krv[2 * j + 1] = bfhi(kr[j]); }
        float sq = 0.f, sk = 0.f, sqr = 0.f, skr = 0.f;
#pragma unroll
        for (int i = 0; i < 16; ++i) { sq += qv[i] * qv[i]; sk += kv[i] * kv[i]; }
#pragma unroll
        for (int i = 0; i < 8; ++i) { sqr += qrv[i] * qrv[i]; skr += krv[i] * krv[i]; }
#pragma unroll
        for (int o = 1; o < 8; o <<= 1) { sq += __shfl_xor(sq, o); sk += __shfl_xor(sk, o); sqr += __shfl_xor(sqr, o); skr += __shfl_xor(skr, o); }
        const float rq = 1.0f / sqrtf(sq * (1.0f / 128.0f) + EPS), rk = 1.0f / sqrtf(sk * (1.0f / 128.0f) + EPS);
        const float rqr = 1.0f / sqrtf(sqr * (1.0f / 64.0f) + EPS), rkr = 1.0f / sqrtf(skr * (1.0f / 64.0f) + EPS);
        u32x4 oq0, oq1, ok0, ok1, oqr, okr;
#pragma unroll
        for (int j = 0; j < 4; ++j) { oq0[j] = pk2(qv[2 * j] * rq * g_qn[2 * j], qv[2 * j + 1] * rq * g_qn[2 * j + 1]); oq1[j] = pk2(qv[8 + 2 * j] * rq * g_qn[8 + 2 * j], qv[9 + 2 * j] * rq * g_qn[9 + 2 * j]);
            ok0[j] = pk2(kv[2 * j] * rk * g_kn[2 * j], kv[2 * j + 1] * rk * g_kn[2 * j + 1]); ok1[j] = pk2(kv[8 + 2 * j] * rk * g_kn[8 + 2 * j], kv[9 + 2 * j] * rk * g_kn[9 + 2 * j]); }
        float qo[8], ko[8];
#pragma unroll
        for (int i = 0; i < 8; ++i) {
            const float xq = qrv[i] * rqr * g_qr[i], xk = krv[i] * rkr * g_kr[i];
            const float yq = __shfl_xor(xq, 4), yk = __shfl_xor(xk, 4);
            qo[i] = first ? (xq * cs[i] - yq * sn[i]) : (xq * cs[i] + yq * sn[i]);
            ko[i] = first ? (xk * cs[i] - yk * sn[i]) : (xk * cs[i] + yk * sn[i]);
        }
#pragma unroll
        for (int j = 0; j < 4; ++j) { oqr[j] = pk2(qo[2 * j], qo[2 * j + 1]); okr[j] = pk2(ko[2 * j], ko[2 * j + 1]); }
        bf16_t* qw = Q + (size_t)m * 1536 + h * 192; bf16_t* kw = Kf + (size_t)m * 1536 + h * 192;
        *(u32x4*)(qw + 16 * p) = oq0; *(u32x4*)(qw + 16 * p + 8) = oq1; *(u32x4*)(qw + 128 + 8 * p) = oqr;
        *(u32x4*)(kw + 16 * p) = ok0; *(u32x4*)(kw + 16 * p + 8) = ok1; *(u32x4*)(kw + 128 + 8 * p) = okr;
    }
}

template <int DK, bool STICK>
__device__ __forceinline__ void attn_phase(const Ctx& c, const bf16_t* Q, int qpitch, const bf16_t* Kg, int kpitch, const bf16_t* Vt, bf16_t* O, int opitch) {
    constexpr int KP = DK + 8;
    constexpr int KS = DK / 32;
    constexpr int NKL = DK / 64;
    LAS bf16_t* Kt = (LAS bf16_t*)c.lds;
    LAS bf16_t* Vl = (LAS bf16_t*)(c.lds + 64 * KP * 2);
    LAS unsigned* flags = (LAS unsigned*)(c.lds + 64 * KP * 2 + 128 * 72 * 2);
    const int lane = c.lane, wave = c.wave, quad = lane >> 4, l15 = lane & 15;
    const int sr = c.tid >> 3, scc = (c.tid & 7) * (DK / 8);
    const int sd = c.tid >> 2, skq = (c.tid & 3) * 16;
    for (int pu = blockIdx.x; pu < 256; pu += gridDim.x) {
        const int bh = pu >> 3, s8 = pu & 7, b = bh >> 3, h = bh & 7;
        for (int half = 0; half < 2; ++half) {
            const int qb = half ? 15 - s8 : s8;
            const int q0 = qb * 256 + wave * 32;
            bf16x8 Qf[2][KS];
#pragma unroll
            for (int qt = 0; qt < 2; ++qt)
#pragma unroll
                for (int ks = 0; ks < KS; ++ks) Qf[qt][ks] = *(const bf16x8*)(Q + (size_t)(b * SEQ + q0 + 16 * qt + l15) * qpitch + h * DK + 32 * ks + 8 * quad);
            f32x4 Oa[8][2];
#pragma unroll
            for (int dt = 0; dt < 8; ++dt) { Oa[dt][0] = (f32x4){0.f, 0.f, 0.f, 0.f}; Oa[dt][1] = (f32x4){0.f, 0.f, 0.f, 0.f}; }
            float mrow[2] = {-1e30f, -1e30f}, lrow[2] = {0.f, 0.f}, Rrow[2] = {0.f, 0.f};
            const int ntile = 4 * (qb + 1);
            bool wdone = false;
            u32x4 kreg[NKL], vreg[2];
            const bf16_t* kbase = Kg + (size_t)(b * SEQ) * kpitch + h * DK;
            const bf16_t* vbase = Vt + (size_t)bh * 128 * SEQ;
            const unsigned koff = (unsigned)(sr * kpitch + scc), voff = (unsigned)(sd * SEQ + skq);
            { const int key0 = (STICK ? (ntile - 1) : 0) * 64;
              const bf16_t* p = kbase + (size_t)key0 * kpitch;
#pragma unroll
              for (int i = 0; i < NKL; ++i) kreg[i] = *(const u32x4*)(p + koff + 8 * i);
              const bf16_t* pv = vbase + key0;
              vreg[0] = *(const u32x4*)(pv + voff); vreg[1] = *(const u32x4*)(pv + voff + 8); }
            for (int it = 0; it < ntile; ++it) {
                const int kt = STICK ? (ntile - 1 - it) : it;
                const int key0 = kt * 64;
                if (STICK) { if (lane == 0) flags[wave] = wdone ? 1u : 0u; }
                LDS_BARRIER();
                if (STICK) { unsigned alld = 1u;
#pragma unroll
                    for (int w = 0; w < 8; ++w) alld &= flags[w];
                    if (alld) break; }
#pragma unroll
                for (int i = 0; i < NKL; ++i) *(LAS u32x4*)(Kt + sr * KP + scc + 8 * i) = kreg[i];
                *(LAS u32x4*)(Vl + sd * 72 + skq) = vreg[0]; *(LAS u32x4*)(Vl + sd * 72 + skq + 8) = vreg[1];
                if (it + 1 < ntile) {
                    const int key1 = (STICK ? (kt - 1) : (kt + 1)) * 64;
                    const bf16_t* p = kbase + (size_t)key1 * kpitch;
#pragma unroll
                    for (int i = 0; i < NKL; ++i) kreg[i] = *(const u32x4*)(p + koff + 8 * i);
                    const bf16_t* pv = vbase + key1;
                    vreg[0] = *(const u32x4*)(pv + voff); vreg[1] = *(const u32x4*)(pv + voff + 8);
                }
                LDS_BARRIER();
                if (key0 > q0 + 31) continue;
                if (STICK && wdone) continue;
                f32x4 St[4][2];
#pragma unroll
                for (int k4 = 0; k4 < 4; ++k4) { St[k4][0] = (f32x4){0.f, 0.f, 0.f, 0.f}; St[k4][1] = (f32x4){0.f, 0.f, 0.f, 0.f}; }
                bf16x8 kfr[2][4];
#pragma unroll
                for (int k4 = 0; k4 < 4; ++k4) kfr[0][k4] = *(const LAS bf16x8*)(Kt + (16 * k4 + l15) * KP + 8 * quad);
                __builtin_amdgcn_sched_barrier(0);
#pragma unroll
                for (int ks = 0; ks < KS; ++ks) {
                    if (ks + 1 < KS) {
#pragma unroll
                        for (int k4 = 0; k4 < 4; ++k4) kfr[(ks + 1) & 1][k4] = *(const LAS bf16x8*)(Kt + (16 * k4 + l15) * KP + 32 * (ks + 1) + 8 * quad);
                    }
#pragma unroll
                    for (int k4 = 0; k4 < 4; ++k4) {
                        St[k4][0] = __builtin_amdgcn_mfma_f32_16x16x32_bf16(kfr[ks & 1][k4], Qf[0][ks], St[k4][0], 0, 0, 0);
                        St[k4][1] = __builtin_amdgcn_mfma_f32_16x16x32_bf16(kfr[ks & 1][k4], Qf[1][ks], St[k4][1], 0, 0, 0);
                    }
                    __builtin_amdgcn_sched_barrier(0);
                }
                bf16x8 vfr[2][2][2];
                if constexpr (DK == 128) {
#pragma unroll
                    for (int d2 = 0; d2 < 2; ++d2)
#pragma unroll
                        for (int k2 = 0; k2 < 2; ++k2) vfr[0][d2][k2] = ld2x4_lds(Vl + (16 * d2 + l15) * 72 + 32 * k2 + 4 * quad);
                }
                bf16x8 Pb[2][2];
#pragma unroll
                for (int qt = 0; qt < 2; ++qt) {
                    const int tq = q0 + 16 * qt + l15;
                    if constexpr (!STICK) {
                        float mx = -1e30f;
#pragma unroll
                        for (int k4 = 0; k4 < 4; ++k4)
#pragma unroll
                            for (int r = 0; r < 4; ++r) { const int key = key0 + 16 * k4 + 4 * quad + r; const float z = (key <= tq) ? St[k4][qt][r] : -1e30f; St[k4][qt][r] = z; mx = fmaxf(mx, z); }
                        mx = fmaxf(mx, __shfl_xor(mx, 16)); mx = fmaxf(mx, __shfl_xor(mx, 32));
                        const float mnew = fmaxf(mrow[qt], mx);
                        const float alpha = fexp(mrow[qt] - mnew);
                        float ps = 0.f;
#pragma unroll
                        for (int k4 = 0; k4 < 4; ++k4)
#pragma unroll
                            for (int r = 0; r < 4; ++r) { const float p = (St[k4][qt][r] > -1e29f) ? fexp(St[k4][qt][r] - mnew) : 0.f; St[k4][qt][r] = p; ps += p; }
                        ps += __shfl_xor(ps, 16); ps += __shfl_xor(ps, 32);
                        lrow[qt] = lrow[qt] * alpha + ps; mrow[qt] = mnew;
#pragma unroll
                        for (int dt = 0; dt < 8; ++dt) Oa[dt][qt] = Oa[dt][qt] * alpha;
                    } else {
                        float G[4], ls[4][4];
#pragma unroll
                        for (int k4 = 0; k4 < 4; ++k4) {
                            G[k4] = 0.f;
#pragma unroll
                            for (int r = 0; r < 4; ++r) { const int key = key0 + 16 * k4 + 4 * quad + r; const float z = St[k4][qt][r];
                                const float sp = softplus_f(z); const bool valid = key < tq; ls[k4][r] = valid ? -sp : 0.f; G[k4] += ls[k4][r];
                                St[k4][qt][r] = valid ? (z - sp) : -1e30f; }
                        }
                        float run = Rrow[qt];
#pragma unroll
                        for (int k4 = 3; k4 >= 0; --k4) {
                            const float g = G[k4];
                            const float gb = __shfl_xor(g, 16), gc2 = __shfl_xor(g, 32), gd = __shfl_xor(gb, 32);
                            const float hi = (((quad ^ 1) > quad) ? gb : 0.f) + (((quad ^ 2) > quad) ? gc2 : 0.f) + (((quad ^ 3) > quad) ? gd : 0.f);
                            float aft = run + hi;
#pragma unroll
                            for (int r = 3; r >= 0; --r) { const float lz = St[k4][qt][r]; St[k4][qt][r] = (lz > -1e29f) ? fexp(lz + aft) : 0.f; aft += ls[k4][r]; }
                            run += (g + gb) + (gc2 + gd);
                        }
                        Rrow[qt] = run;
                    }
                    Pb[qt][0] = pack8(St[0][qt], St[1][qt]); Pb[qt][1] = pack8(St[2][qt], St[3][qt]);
                }
                if constexpr (DK != 128) {
#pragma unroll
                    for (int d2 = 0; d2 < 2; ++d2)
#pragma unroll
                        for (int k2 = 0; k2 < 2; ++k2) vfr[0][d2][k2] = ld2x4_lds(Vl + (16 * d2 + l15) * 72 + 32 * k2 + 4 * quad);
                }
                __builtin_amdgcn_sched_barrier(0);
#pragma unroll
                for (int gv = 0; gv < 4; ++gv) {
                    if (gv + 1 < 4) {
#pragma unroll
                        for (int d2 = 0; d2 < 2; ++d2)
#pragma unroll
                            for (int k2 = 0; k2 < 2; ++k2) vfr[(gv + 1) & 1][d2][k2] = ld2x4_lds(Vl + (16 * (2 * (gv + 1) + d2) + l15) * 72 + 32 * k2 + 4 * quad);
                    }
#pragma unroll
                    for (int d2 = 0; d2 < 2; ++d2)
#pragma unroll
                        for (int k2 = 0; k2 < 2; ++k2) {
                            Oa[2 * gv + d2][0] = __builtin_amdgcn_mfma_f32_16x16x32_bf16(vfr[gv & 1][d2][k2], Pb[0][k2], Oa[2 * gv + d2][0], 0, 0, 0);
                            Oa[2 * gv + d2][1] = __builtin_amdgcn_mfma_f32_16x16x32_bf16(vfr[gv & 1][d2][k2], Pb[1][k2], Oa[2 * gv + d2][1], 0, 0, 0);
                        }
                    __builtin_amdgcn_sched_barrier(0);
                }
                if (STICK) wdone = __all((Rrow[0] < -110.f) && (Rrow[1] < -110.f));
            }
#pragma unroll
            for (int qt = 0; qt < 2; ++qt) {
                const float inv = STICK ? 1.f : 1.f / lrow[qt];
                bf16_t* op = O + (size_t)(b * SEQ + q0 + 16 * qt + l15) * opitch + h * 128 + 4 * quad;
#pragma unroll
                for (int dt = 0; dt < 8; ++dt) { u32x2 w; w.x = pk2(Oa[dt][qt][0] * inv, Oa[dt][qt][1] * inv); w.y = pk2(Oa[dt][qt][2] * inv, Oa[dt][qt][3] * inv); *(u32x2*)(op + 16 * dt) = w; }
            }
        }
    }
}

constexpr int NPHASE = 30;
__device__ __forceinline__ int lane_id() { int l; asm volatile("v_mbcnt_lo_u32_b32 %0, -1, 0\n\tv_mbcnt_hi_u32_b32 %0, -1, %0" : "=v"(l)); return l; }
__device__ __forceinline__ Ctx mkctx(LAS unsigned char* lds, unsigned char* ws_, int wave_s) {
    int ln = lane_id(); asm volatile("" : "+v"(ln));
    int wv = wave_s; asm volatile("" : "+s"(wv));
    asm volatile("" : "+s"(ws_));
    Ctx c; c.lds = lds; c.ws = ws_; c.lane = ln; c.wave = wv; c.tid = wv * 64 + ln;
    c.gw = blockIdx.x * NWAVES + c.wave; c.ngw = gridDim.x * NWAVES; return c;
}
#define PH_BEGIN Ctx c = mkctx(ldsp, args.ws, wave_s); const Args& A = args; unsigned char* ws = c.ws; \
    bf16_t* XB = (bf16_t*)(ws + WS_R1); float* SS = (float*)(ws + WS_SS); bf16_t* R2 = (bf16_t*)(ws + WS_R2); bf16_t* R3 = (bf16_t*)(ws + WS_R3); \
    bf16_t* R4 = (bf16_t*)(ws + WS_R4); bf16_t* R5 = (bf16_t*)(ws + WS_R5); bf16_t* WMIX = (bf16_t*)(ws + WS_WMIX); bf16_t* WOUT = (bf16_t*)(ws + WS_WMIX_OUT); \
    (void)XB; (void)SS; (void)R2; (void)R3; (void)R4; (void)R5; (void)WMIX; (void)WOUT; (void)c;

__global__ void __launch_bounds__(NTHR, 2) trunk_fwd(Args args) {
    extern __shared__ __attribute__((aligned(16))) unsigned char lds_raw[];
    LAS unsigned char* ldsp = (LAS unsigned char*)lds_raw;
    const int wave_s = __builtin_amdgcn_readfirstlane((int)(threadIdx.x >> 6));
    const int lo = args.ph_lo, hi = args.ph_hi;
    const int G = gridDim.x, bid = blockIdx.x;
#if !MK_PER_PHASE
    cg::grid_group grid = cg::this_grid();
#if MK_XCD_BAR
    volatile LAS unsigned* misc = (volatile LAS unsigned*)(ldsp + LDS_MISC);
    if (threadIdx.x < 16) misc[threadIdx.x] = 0u;
    __syncthreads();
    XcdBarrier xbar = xcd_barrier_post((unsigned*)(args.ws + WS_BAR), misc + 8, (int)threadIdx.x);
    int nsync = 0;
#define SEAM() do { if (nsync == 0) grid.sync(); else xcd_barrier(xbar, wave_s * 64 + lane_id()); ++nsync; } while (0)
#else
#define SEAM() grid.sync()
#endif
#else
#define SEAM() do {} while (0)
#endif
#define IN(k) (lo <= (k) && (k) < hi)
#ifndef PROBE_MASK
#define PROBE_MASK 0ull
#endif
    unsigned long long tacc = 0ull, tph = (PROBE_MASK != 0ull) ? __builtin_amdgcn_s_memrealtime() : 0ull;
#define ENDPH(k) do { if (IN((k) + 1)) SEAM(); if (PROBE_MASK != 0ull) { const unsigned long long tn = __builtin_amdgcn_s_memrealtime(); if ((PROBE_MASK >> (k)) & 1ull) tacc += tn - tph; tph = tn; } } while (0)

    float* out = args.out;
    int ph = 0;

    if (IN(ph) && EN(0)) { PH_BEGIN; convert_mixer(A, c, 0); convert_ffn(A, c, 0); prologue_rows(A, c); }
    ENDPH(ph); ++ph;

#pragma unroll 1
    for (int L = 0; L < 4; ++L) {
        const float* resid_in = (L == 0) ? args.in[0] : out;
        if (L == 0 || L == 3) {
            const int ib = (L == 0) ? 1 : 33;
            if (IN(ph)) {
                PH_BEGIN;
                if (L > 0 && EN(0)) convert_ffn(A, c, L);
                __syncthreads();
                pg8::Gemm g{XB, WMIX, M, 4352, D, D}; pg8::StaticOrder S; S.init(M, 4352, G, bid);
                pg8::EpiDN E{R2, R3, (float*)(ws + WS_AB), (bf16_t*)(ws + WS_HALO), SS};
                if (EN(1)) pg8::gemm_phase<pg8::EpiDN>(c.lds, g, S, E, c.tid);
            }
            ENDPH(ph); ++ph;
            if (IN(ph) && EN(2)) { PH_BEGIN; dn_conv(A, c, A.in[ib + 2]); }
            ENDPH(ph); ++ph;
            if (IN(ph) && EN(3)) { PH_BEGIN; dn_chunk(A, c, A.in[ib + 3], A.in[ib + 4]); }
            ENDPH(ph); ++ph;
            if (IN(ph) && EN(4)) { PH_BEGIN; dn_scan(A, c); }
            ENDPH(ph); ++ph;
            if (IN(ph) && EN(5)) { PH_BEGIN; dn_post(A, c, A.in[ib + 5]); }
            ENDPH(ph); ++ph;
            if (IN(ph)) {
                PH_BEGIN;
                pg8::Gemm g{R4, WOUT, M, D, D, D}; pg8::StaticOrder S; S.init(M, D, G, bid);
                pg8::EpiResidual E{resid_in, out, XB, SS};
                if (EN(10)) pg8::gemm_phase<pg8::EpiResidual>(c.lds, g, S, E, c.tid);
            }
            ENDPH(ph); ++ph;
        } else if (L == 1) {
            if (IN(ph)) {
                PH_BEGIN;
                if (EN(0)) convert_ffn(A, c, L);
                __syncthreads();
                pg8::Gemm g{XB, WMIX, M, 3072, D, D}; pg8::StaticOrder S; S.init(M, 3072, G, bid);
                pg8::EpiStore E{R2, 3072, SS, 0, 16, 1.0f / D};
                if (EN(11)) pg8::gemm_phase<pg8::EpiStore>(c.lds, g, S, E, c.tid);
            }
            ENDPH(ph); ++ph;
            if (IN(ph) && EN(6)) { PH_BEGIN; sb_prep_rows(A, c, A.in[13], A.in[14]); v_transpose(c, R2, 3072, 128, 2048, (bf16_t*)(ws + WS_R1)); }
            ENDPH(ph); ++ph;
            if (IN(ph) && EN(7)) { PH_BEGIN; attn_phase<128, true>(c, R2, 3072, R2 + 1024, 3072, (const bf16_t*)(ws + WS_R1), R3, 1024); }
            ENDPH(ph); ++ph;
            if (IN(ph)) {
                PH_BEGIN;
                pg8::Gemm g{R3, WOUT, M, D, D, D}; pg8::StaticOrder S; S.init(M, D, G, bid);
                pg8::EpiResidual E{resid_in, out, XB, SS};
                if (EN(10)) pg8::gemm_phase<pg8::EpiResidual>(c.lds, g, S, E, c.tid);
            }
            ENDPH(ph); ++ph;
        } else {
            if (IN(ph)) {
                PH_BEGIN;
                if (EN(0)) convert_ffn(A, c, L);
                __syncthreads();
                pg8::Gemm g{XB, WMIX, M, 512, D, D}; pg8::StaticOrder S; S.init(M, 512, G, bid);
                pg8::EpiMlaDown E{R5, (float*)(ws + WS_SS2), SS};
                if (EN(12)) pg8::gemm_phase<pg8::EpiMlaDown>(c.lds, g, S, E, c.tid);
            }
            ENDPH(ph); ++ph;
            if (IN(ph)) {
                PH_BEGIN;
                { pg8::Gemm g{R5, (bf16_t*)(ws + WS_WMIX + 1 * MiB), M, 1536, 256, 512}; pg8::StaticOrder S; S.init(M, 1536, G, bid);
                  pg8::EpiStore E{R2, 1536, (const float*)(ws + WS_SS2), 0, 8, 1.0f / 256.0f};
                  if (EN(11)) pg8::gemm_phase<pg8::EpiStore>(c.lds, g, S, E, c.tid); }
                { pg8::Gemm g{R5 + 256, (bf16_t*)(ws + WS_WMIX + 2 * MiB), M, 2048, 128, 512}; pg8::StaticOrder S; S.init(M, 2048, G, bid);
                  pg8::EpiStore E{R3, 2048, (const float*)(ws + WS_SS2), 8, 4, 1.0f / 128.0f};
                  if (EN(11)) pg8::gemm_phase<pg8::EpiStore>(c.lds, g, S, E, c.tid); }
            }
            ENDPH(ph); ++ph;
            if (IN(ph) && EN(8)) { PH_BEGIN; mla_prep_rows(A, c); v_transpose(c, R3, 2048, 256, 128, (bf16_t*)(ws + WS_R1)); }
            ENDPH(ph); ++ph;
            if (IN(ph) && EN(9)) { PH_BEGIN; attn_phase<192, false>(c, R2, 1536, (const bf16_t*)(ws + WS_R2 + 48 * MiB), 1536, (const bf16_t*)(ws + WS_R1), R3, 1024); }
            ENDPH(ph); ++ph;
            if (IN(ph)) {
                PH_BEGIN;
                pg8::Gemm g{R3, WOUT, M, D, D, D}; pg8::StaticOrder S; S.init(M, D, G, bid);
                pg8::EpiResidual E{resid_in, out, XB, SS};
                if (EN(10)) pg8::gemm_phase<pg8::EpiResidual>(c.lds, g, S, E, c.tid);
            }
            ENDPH(ph); ++ph;
        }
        if (IN(ph)) {
            PH_BEGIN;
            if (L < 3 && EN(0)) convert_mixer(A, c, L + 1);
            __syncthreads();
            pg8::Gemm g{XB, (bf16_t*)(ws + WS_WFFN), M, 2 * FH, D, D}; pg8::StaticOrder S; S.init(M, 2 * FH, G, bid);
            pg8::EpiSwiglu E{R2, SS};
            if (EN(13)) pg8::gemm_phase<pg8::EpiSwiglu>(c.lds, g, S, E, c.tid);
        }
        ENDPH(ph); ++ph;
        if (IN(ph)) {
            PH_BEGIN;
            pg8::Gemm g{R2, (bf16_t*)(ws + WS_WFFN_DN), M, D, FH, FH}; pg8::StaticOrder S; S.init(M, D, G, bid);
            pg8::EpiResidual E{out, out, XB, SS};
            if (EN(10)) pg8::gemm_phase<pg8::EpiResidual>(c.lds, g, S, E, c.tid);
        }
        ENDPH(ph); ++ph;
    }
    if (PROBE_MASK != 0ull) { const unsigned long long te = __builtin_amdgcn_s_memrealtime(); while (__builtin_amdgcn_s_memrealtime() - te < tacc) __builtin_amdgcn_s_sleep(8); }
}

extern "C" void kernel_launch(void* const* d_in, const int* in_sizes, int n_in, void* d_out, int out_size, void* d_ws, size_t ws_size, hipStream_t stream) {
    static int grid = 0;
    if (grid == 0) {
        if (n_in != 43 || out_size != M * D || ws_size < WS_END) { fprintf(stderr, "kernel_launch: unexpected shapes (n_in %d out %d ws %zu)\n", n_in, out_size, ws_size); grid = -1; return; }
        int dev = 0, cus = 0, per_cu = 0;
        hipGetDevice(&dev); hipDeviceGetAttribute(&cus, hipDeviceAttributeMultiprocessorCount, dev);
        if (hipFuncSetAttribute((const void*)trunk_fwd, hipFuncAttributeMaxDynamicSharedMemorySize, LDS_BYTES) != hipSuccess) { fprintf(stderr, "kernel_launch: hipFuncSetAttribute failed\n"); grid = -1; return; }
        if (hipOccupancyMaxActiveBlocksPerMultiprocessor(&per_cu, (const void*)trunk_fwd, NTHR, LDS_BYTES) != hipSuccess || per_cu < 1) { fprintf(stderr, "kernel_launch: occupancy query says %d\n", per_cu); per_cu = 1; }
        (void)hipGetLastError();
        grid = cus * 1;
    }
    if (grid < 0) return;
    Args a{};
    for (int i = 0; i < 43; ++i) a.in[i] = (const float*)d_in[i];
    a.out = (float*)d_out; a.ws = (unsigned char*)d_ws;
#if MK_PER_PHASE
    for (int p = 0; p < NPHASE; ++p) {
        a.ph_lo = p; a.ph_hi = p + 1;
        hipLaunchKernelGGL(trunk_fwd, dim3(grid), dim3(NTHR), LDS_BYTES, stream, a);
    }
#else
    hipMemsetAsync((char*)d_ws + WS_BAR, 0, 65536, stream);
    a.ph_lo = 0; a.ph_hi = NPHASE;
    void* kargs[] = {&a};
    hipError_t e = hipLaunchCooperativeKernel((const void*)trunk_fwd, dim3(grid), dim3(NTHR), kargs, LDS_BYTES, stream);
    if (e != hipSuccess) fprintf(stderr, "cooperative launch failed: %s (grid %d)\n", hipGetErrorString(e), grid);
#endif
}
```

```cpp
#include <hip/hip_runtime.h>
#include <hip/hip_cooperative_groups.h>
#include <cstdio>
#include <cstdint>
namespace cg = cooperative_groups;

#ifndef MK_PER_PHASE
#define MK_PER_PHASE 0
#endif
#ifndef MK_XCD_BAR
#define MK_XCD_BAR 1
#endif

#ifndef EN_MASK
#define EN_MASK 0xFFFFFFFFu
#endif
#define EN(b) ((EN_MASK >> (b)) & 1u)
#define LAS __attribute__((address_space(3)))
typedef unsigned short bf16_t;
typedef short bf16x8 __attribute__((ext_vector_type(8)));
typedef short bf16x4 __attribute__((ext_vector_type(4)));
typedef float f32x4 __attribute__((ext_vector_type(4)));
typedef float f32x2 __attribute__((ext_vector_type(2)));
typedef unsigned u32x4 __attribute__((ext_vector_type(4)));
typedef unsigned u32x2 __attribute__((ext_vector_type(2)));

constexpr int BATCH = 4, SEQ = 4096, D = 1024, M = BATCH * SEQ, FH = 2816, NH = 8;
constexpr float EPS = 1e-6f;
constexpr int NWAVES = 8, NTHR = 512;

constexpr size_t MiB = 1u << 20;
constexpr size_t WS_BAR = 0;
constexpr size_t WS_SS = 1 * MiB;
constexpr size_t WS_SS2 = 2 * MiB;
constexpr size_t WS_AB = 3 * MiB;
constexpr size_t WS_RS = 4 * MiB;
constexpr size_t WS_GC = 5 * MiB;
constexpr size_t WS_HALO = 6 * MiB;
constexpr size_t WS_WMIX = 8 * MiB;
constexpr size_t WS_WMIX_OUT = WS_WMIX + 9 * MiB;
constexpr size_t WS_WFFN = 22 * MiB;
constexpr size_t WS_WFFN_DN = WS_WFFN + 11 * MiB;
constexpr size_t WS_R1 = 40 * MiB;
constexpr size_t WS_R2 = 72 * MiB;
constexpr size_t WS_R3 = 168 * MiB;
constexpr size_t WS_R4 = 200 * MiB;
constexpr size_t WS_R5 = 232 * MiB;
constexpr size_t WS_END = 248 * MiB;

constexpr int LDS_BYTES = 147456;
constexpr int LDS_MISC = 147200;

__device__ __forceinline__ unsigned f2bf(float f) { unsigned u = __builtin_bit_cast(unsigned, f); return (u + 0x7fffu + ((u >> 16) & 1u)) >> 16; }
__device__ __forceinline__ unsigned pk2(float lo, float hi) { unsigned r; asm volatile("v_cvt_pk_bf16_f32 %0, %1, %2" : "=v"(r) : "v"(lo), "v"(hi)); return r; }
__device__ __forceinline__ float bf2f(unsigned b) { return __builtin_bit_cast(float, b << 16); }
__device__ __forceinline__ float bflo(unsigned w) { return __builtin_bit_cast(float, w << 16); }
__device__ __forceinline__ float bfhi(unsigned w) { return __builtin_bit_cast(float, w & 0xffff0000u); }
__device__ __forceinline__ float wave_sum(float v) {
#pragma unroll
    for (int o = 1; o < 64; o <<= 1) v += __shfl_xor(v, o);
    return v;
}
#define LDS_BARRIER() do { asm volatile("s_waitcnt lgkmcnt(0)" ::: "memory"); __builtin_amdgcn_s_barrier(); asm volatile("" ::: "memory"); } while (0)
__device__ __forceinline__ float fexp(float x) { return __builtin_amdgcn_exp2f(x * 1.4426950408889634f); }
__device__ __forceinline__ float flog(float x) { return __builtin_amdgcn_logf(x) * 0.6931471805599453f; }
__device__ __forceinline__ float softplus_f(float z) { return fmaxf(z, 0.f) + flog(1.f + fexp(-fabsf(z))); }
__device__ __forceinline__ float silu_f(float y) { return y / (1.f + fexp(-y)); }
__device__ __forceinline__ float rowscale(const float* ss, int row, int lo, int n, float inv_dim) {
    float s = 0.f;
    for (int i = 0; i < n; i += 4) { const f32x4 v = *(const f32x4*)(ss + (size_t)row * 16 + lo + i); s += (v[0] + v[1]) + (v[2] + v[3]); }
    return 1.0f / sqrtf(s * inv_dim + EPS);
}

namespace pg8 {
#define PG8_LAS __attribute__((address_space(3)))
constexpr int BM = 256, BK = 64, HALF = 128, HTB = HALF * BK * 2, STAGE_BYTES = 8 * HTB, NXCD = 8, WGM = 8;
__host__ __device__ __forceinline__ int lds_byte(int r, int c) { const int st = (r >> 4) * 2 + (c >> 5), rr = r & 15, cc = c & 31, ob = rr * 64 + cc * 2; return st * 1024 + (ob ^ (((ob >> 9) & 1) << 5)); }
__host__ __device__ __forceinline__ void stage_rc(int b, int& R, int& C) { const int st = b / 1024, sb = b % 1024, swz = sb ^ (((sb >> 9) & 1) << 5); R = (st >> 1) * 16 + swz / 64; C = (st & 1) * 32 + (swz % 64) / 2; }
__host__ __device__ __forceinline__ int perm32(int rho) { const int n = rho >> 4, i = rho & 15; return 8 * (i >> 2) + 4 * n + (i & 3); }
struct Unit { int pm, pn; };
struct Gemm { const bf16_t* A; const bf16_t* Bt; int M, N, K, lda; };
struct StaticOrder {
    int nM, nN, nwg, G, c;
    __host__ __device__ void init(int M_, int N_, int G_, int c_) { nM = M_ / BM; nN = N_ / BM; nwg = nM * nN; G = G_; c = c_; }
    __host__ __device__ bool next(int i, Unit& u) const {
        const long L = (long)i * G + c; if (L >= nwg) return false;
        int wgid = (int)L; { const int q = nwg / NXCD, r = nwg % NXCD, xcd = wgid % NXCD, off = wgid / NXCD; wgid = (xcd < r ? xcd * (q + 1) : r * (q + 1) + (xcd - r) * q) + off; }
        const int nig = WGM * nN, gid = wgid / nig, fm = gid * WGM, gsz = (nM - fm) < WGM ? (nM - fm) : WGM;
        u.pm = fm + ((wgid % nig) % gsz); u.pn = (wgid % nig) / gsz; return true;
    }
};
template <class Epi, bool ALIGN_EPI = true>
__device__ __forceinline__ void gemm_phase(PG8_LAS unsigned char* lds, const Gemm g, const StaticOrder& S, const Epi& E, int tid_in) {
    int tid_ = tid_in; asm volatile("" : "+v"(tid_));
    const int tid = tid_, wid = __builtin_amdgcn_readfirstlane(tid >> 6), lane = tid & 63, wr = wid >> 2, wc = wid & 3, fr = lane & 15, fq = lane >> 4;
    const int K = g.K, nt = K / BK, lda = g.lda;
    unsigned voffA[2], voffB[2];
#pragma unroll
    for (int i = 0; i < 2; ++i) { int R, C; stage_rc(tid * 16 + i * 8192, R, C); const int Rb = Epi::PERM ? ((R & ~31) + perm32(R & 31)) : R;
        voffA[i] = (unsigned)(R * lda + C) * 2u; voffB[i] = (unsigned)(Rb * K + C) * 2u; }
    const size_t kstep = (size_t)(BK * 2);
    const size_t hstepA = (size_t)HALF * lda * 2, hstepB = (size_t)HALF * K * 2;
    const size_t tstepA = 2 * hstepA, tstepB = 2 * hstepB;
    const unsigned ldsw = (unsigned)wid * 1024u;
    const int aoff = lds_byte(wr * 64 + fr, fq * 8), boff = lds_byte(wc * 32 + fr, fq * 8);
#define PG8_SA(b, h) (((b) * 2 + (h)) * HTB)
#define PG8_SB(b, h) ((4 + (b) * 2 + (h)) * HTB)
#define PG8_STAGE(bufoff, gbase, voff) do { _Pragma("unroll") for (int _i = 0; _i < 2; ++_i) \
        __builtin_amdgcn_global_load_lds((const unsigned*)((const char*)(gbase) + (voff)[_i]), (PG8_LAS unsigned*)(lds + (bufoff) + ldsw + _i * 8192), 16, 0, 0); } while (0)
#define PG8_LDA(dst, b, h) do { _Pragma("unroll") for (int m = 0; m < 4; ++m) _Pragma("unroll") for (int k = 0; k < 2; ++k) dst[m][k] = *(const PG8_LAS bf16x8*)(lds + PG8_SA(b, h) + aoff + m * 2048 + k * 1024); } while (0)
#define PG8_LDB(dst, b, h) do { _Pragma("unroll") for (int n = 0; n < 2; ++n) _Pragma("unroll") for (int k = 0; k < 2; ++k) dst[n][k] = *(const PG8_LAS bf16x8*)(lds + PG8_SB(b, h) + boff + n * 2048 + k * 1024); } while (0)
#define PG8_MMA(ai, bj, At, Bt) do { __builtin_amdgcn_s_setprio(1); _Pragma("unroll") for (int m = 0; m < 4; ++m) _Pragma("unroll") for (int n = 0; n < 2; ++n) _Pragma("unroll") for (int k = 0; k < 2; ++k) \
        acc[ai][bj][m][n] = __builtin_amdgcn_mfma_f32_16x16x32_bf16(Bt[n][k], At[m][k], acc[ai][bj][m][n], 0, 0, 0); __builtin_amdgcn_s_setprio(0); } while (0)
#define PG8_WAIT_V(n) asm volatile("s_waitcnt vmcnt(" #n ")" ::: "memory")
#define PG8_WAIT_L(n) asm volatile("s_waitcnt lgkmcnt(" #n ")" ::: "memory")
#define PG8_BAR __builtin_amdgcn_s_barrier()
#define PG8_SCHED __builtin_amdgcn_sched_barrier(0)
    Unit cur, nxt; int ui = 0;
    if (!S.next(0, cur)) return;
    f32x4 acc[2][2][4][2];
#pragma unroll
    for (int a = 0; a < 2; ++a)
#pragma unroll
        for (int b = 0; b < 2; ++b)
#pragma unroll
            for (int m = 0; m < 4; ++m)
#pragma unroll
                for (int n = 0; n < 2; ++n) acc[a][b][m][n] = (f32x4){0.f, 0.f, 0.f, 0.f};
    bf16x8 At[4][2], B0[2][2], B1[2][2];
    const char* cA = (const char*)g.A + (size_t)cur.pm * tstepA; const char* cB = (const char*)g.Bt + (size_t)cur.pn * tstepB;
    PG8_STAGE(PG8_SB(0, 0), cB, voffB); PG8_STAGE(PG8_SB(0, 1), cB + hstepB, voffB); PG8_STAGE(PG8_SA(0, 0), cA, voffA); PG8_STAGE(PG8_SA(0, 1), cA + hstepA, voffA);
    if (wr == 1) PG8_BAR;
    PG8_WAIT_V(2); PG8_BAR;
    PG8_STAGE(PG8_SB(1, 0), cB + kstep, voffB); PG8_STAGE(PG8_SA(1, 0), cA + kstep, voffA); PG8_STAGE(PG8_SB(1, 1), cB + hstepB + kstep, voffB);
    PG8_WAIT_V(6); PG8_BAR;
    for (;;) {
        const bool has_next = S.next(ui + 1, nxt);
        const char* nA = has_next ? (const char*)g.A + (size_t)nxt.pm * tstepA : cA; const char* nB = has_next ? (const char*)g.Bt + (size_t)nxt.pn * tstepB : cB;
        for (int t = 0; t < nt; t += 2) {
            const bool last = (t == nt - 2);
            const char* a1 = cA + (size_t)(t + 1) * kstep;
            const char* a2 = last ? nA : cA + (size_t)(t + 2) * kstep; const char* b2 = last ? nB : cB + (size_t)(t + 2) * kstep;
            const char* a3 = a2 + kstep; const char* b3 = b2 + kstep;
            PG8_LDB(B0, 0, 0); PG8_LDB(B1, 0, 1); PG8_SCHED; PG8_LDA(At, 0, 0); PG8_STAGE(PG8_SA(1, 1), a1 + hstepA, voffA);
            PG8_WAIT_V(8); PG8_WAIT_L(0); PG8_BAR; PG8_MMA(0, 0, At, B0); PG8_MMA(0, 1, At, B1); PG8_BAR; PG8_SCHED;
            PG8_LDA(At, 0, 1); PG8_STAGE(PG8_SB(0, 0), b2, voffB); PG8_STAGE(PG8_SB(0, 1), b2 + hstepB, voffB); PG8_STAGE(PG8_SA(0, 0), a2, voffA);
            PG8_WAIT_V(8); PG8_WAIT_L(0); PG8_BAR; PG8_MMA(1, 0, At, B0); PG8_MMA(1, 1, At, B1); PG8_BAR; PG8_SCHED;
            PG8_LDB(B0, 1, 0); PG8_LDB(B1, 1, 1); PG8_SCHED; PG8_LDA(At, 1, 0); PG8_STAGE(PG8_SA(0, 1), a2 + hstepA, voffA);
            PG8_WAIT_V(8); PG8_WAIT_L(0); PG8_BAR; PG8_MMA(0, 0, At, B0); PG8_MMA(0, 1, At, B1); PG8_BAR; PG8_SCHED;
            PG8_LDA(At, 1, 1); PG8_STAGE(PG8_SB(1, 0), b3, voffB); PG8_STAGE(PG8_SB(1, 1), b3 + hstepB, voffB); PG8_STAGE(PG8_SA(1, 0), a3, voffA);
            PG8_WAIT_V(8); PG8_WAIT_L(0); PG8_BAR; PG8_MMA(1, 0, At, B0); PG8_MMA(1, 1, At, B1); PG8_BAR; PG8_SCHED;
        }
        if constexpr (ALIGN_EPI) { if (wr == 0) PG8_BAR; }
        E(acc, cur, wr, wc, fr, fq);
        if (!has_next) break;
#pragma unroll
        for (int a = 0; a < 2; ++a)
#pragma unroll
            for (int b = 0; b < 2; ++b)
#pragma unroll
                for (int m = 0; m < 4; ++m)
#pragma unroll
                    for (int n = 0; n < 2; ++n) acc[a][b][m][n] = (f32x4){0.f, 0.f, 0.f, 0.f};
        cur = nxt; cA = nA; cB = nB; ++ui;
        if constexpr (ALIGN_EPI) { if (wr == 1) PG8_BAR; }
    }
    PG8_WAIT_V(0);
    if constexpr (!ALIGN_EPI) { if (wr == 0) PG8_BAR; }
    PG8_BAR;
#undef PG8_SA
#undef PG8_SB
#undef PG8_STAGE
#undef PG8_LDA
#undef PG8_LDB
#undef PG8_MMA
#undef PG8_WAIT_V
#undef PG8_WAIT_L
#undef PG8_BAR
#undef PG8_SCHED
}

struct EpiStore {
    static constexpr bool PERM = true;
    bf16_t* O; int ldc; const float* ss; int ss_lo, ss_n; float inv_dim;
    __device__ __forceinline__ void operator()(const f32x4 (&acc)[2][2][4][2], const Unit& u, int wr, int wc, int fr, int fq) const {
#pragma unroll
        for (int ai = 0; ai < 2; ++ai)
#pragma unroll
            for (int m = 0; m < 4; ++m) {
                const int row = u.pm * BM + ai * HALF + wr * 64 + m * 16 + fr;
                const float sc = ss ? rowscale(ss, row, ss_lo, ss_n, inv_dim) : 1.f;
#pragma unroll
                for (int bj = 0; bj < 2; ++bj) {
                    const int col = u.pn * BM + bj * HALF + wc * 32 + 8 * fq;
                    const f32x4 v0 = acc[ai][bj][m][0] * sc, v1 = acc[ai][bj][m][1] * sc;
                    u32x4 w; w.x = pk2(v0[0], v0[1]); w.y = pk2(v0[2], v0[3]); w.z = pk2(v1[0], v1[1]); w.w = pk2(v1[2], v1[3]);
                    *(u32x4*)(O + (size_t)row * ldc + col) = w;
                }
                asm volatile("" ::: "memory");
            }
    }
};
struct EpiDN {
    static constexpr bool PERM = true;
    bf16_t* QKV; bf16_t* Z; float* AB; bf16_t* HALO; const float* ss;
    __device__ __forceinline__ void operator()(const f32x4 (&acc)[2][2][4][2], const Unit& u, int wr, int wc, int fr, int fq) const {
#pragma unroll
        for (int ai = 0; ai < 2; ++ai)
#pragma unroll
            for (int m = 0; m < 4; ++m) {
                const int row = u.pm * BM + ai * HALF + wr * 64 + m * 16 + fr;
                const float sc = rowscale(ss, row, 0, 16, 1.0f / D);
#pragma unroll
                for (int bj = 0; bj < 2; ++bj) {
                    const int col = u.pn * BM + bj * HALF + wc * 32 + 8 * fq;
                    const f32x4 v0 = acc[ai][bj][m][0] * sc, v1 = acc[ai][bj][m][1] * sc;
                    u32x4 w; w.x = pk2(v0[0], v0[1]); w.y = pk2(v0[2], v0[3]); w.z = pk2(v1[0], v1[1]); w.w = pk2(v1[2], v1[3]);
                    if (u.pn < 12) {
                        *(u32x4*)(QKV + (size_t)row * 3072 + col) = w;
                        const int rl = row & 255;
                        if (rl >= 253 && u.pm + 1 < 64) *(u32x4*)(HALO + ((size_t)(u.pm + 1) * 3 + (rl - 253)) * 3072 + col) = w;
                    } else if (u.pn < 16) {
                        *(u32x4*)(Z + (size_t)row * 1024 + (col - 3072)) = w;
                    } else if (bj == 0 && wc == 0 && fq < 2) {
                        *(f32x4*)(AB + (size_t)row * 16 + 8 * fq) = v0; *(f32x4*)(AB + (size_t)row * 16 + 8 * fq + 4) = v1;
                    }
                }
                asm volatile("" ::: "memory");
            }
    }
};
struct EpiSwiglu {
    static constexpr bool PERM = true;
    bf16_t* H; const float* ss;
    __device__ __forceinline__ void operator()(const f32x4 (&acc)[2][2][4][2], const Unit& u, int wr, int wc, int fr, int fq) const {
#pragma unroll
        for (int ai = 0; ai < 2; ++ai)
#pragma unroll
            for (int m = 0; m < 4; ++m) {
                const int row = u.pm * BM + ai * HALF + wr * 64 + m * 16 + fr;
                const float sc = rowscale(ss, row, 0, 16, 1.0f / D);
                const int col = u.pn * HALF + wc * 32 + 8 * fq;
                float h[8];
#pragma unroll
                for (int n = 0; n < 2; ++n)
#pragma unroll
                    for (int i = 0; i < 4; ++i) { const float gt = acc[ai][0][m][n][i] * sc, up = acc[ai][1][m][n][i] * sc; h[4 * n + i] = silu_f(gt) * up; }
                u32x4 w; w.x = pk2(h[0], h[1]); w.y = pk2(h[2], h[3]); w.z = pk2(h[4], h[5]); w.w = pk2(h[6], h[7]);
                *(u32x4*)(H + (size_t)row * FH + col) = w;
                asm volatile("" ::: "memory");
            }
    }
};
struct EpiResidual {
    static constexpr bool PERM = false;
    const float* base; float* out; bf16_t* xb; float* ss;
    __device__ __forceinline__ void operator()(const f32x4 (&acc)[2][2][4][2], const Unit& u, int wr, int wc, int fr, int fq) const {
#pragma unroll
        for (int ai = 0; ai < 2; ++ai)
#pragma unroll
            for (int m = 0; m < 4; ++m) {
                const int row = u.pm * BM + ai * HALF + wr * 64 + m * 16 + fr;
                float s = 0.f;
#pragma unroll
                for (int bj = 0; bj < 2; ++bj)
#pragma unroll
                    for (int n = 0; n < 2; ++n) {
                        const int col = u.pn * BM + bj * HALF + wc * 32 + n * 16 + 4 * fq;
                        const size_t off = (size_t)row * D + col;
                        const f32x4 v = *(const f32x4*)(base + off) + acc[ai][bj][m][n];
                        *(f32x4*)(out + off) = v;
                        u32x2 w; w.x = pk2(v[0], v[1]); w.y = pk2(v[2], v[3]);
                        *(u32x2*)(xb + off) = w;
                        s += (v[0] * v[0] + v[1] * v[1]) + (v[2] * v[2] + v[3] * v[3]);
                    }
                s += __shfl_xor(s, 16); s += __shfl_xor(s, 32);
                if (fq == 0) ss[(size_t)row * 16 + u.pn * 4 + wc] = s;
                asm volatile("" ::: "memory");
            }
    }
};
struct EpiMlaDown {
    static constexpr bool PERM = true;
    bf16_t* C; float* ss2; const float* ss;
    __device__ __forceinline__ void operator()(const f32x4 (&acc)[2][2][4][2], const Unit& u, int wr, int wc, int fr, int fq) const {
#pragma unroll
        for (int ai = 0; ai < 2; ++ai)
#pragma unroll
            for (int m = 0; m < 4; ++m) {
                const int row = u.pm * BM + ai * HALF + wr * 64 + m * 16 + fr;
                const float sc = rowscale(ss, row, 0, 16, 1.0f / D);
#pragma unroll
                for (int bj = 0; bj < 2; ++bj) {
                    const int col = u.pn * BM + bj * HALF + wc * 32 + 8 * fq;
                    const f32x4 v0 = acc[ai][bj][m][0] * sc, v1 = acc[ai][bj][m][1] * sc;
                    u32x4 w; w.x = pk2(v0[0], v0[1]); w.y = pk2(v0[2], v0[3]); w.z = pk2(v1[0], v1[1]); w.w = pk2(v1[2], v1[3]);
                    *(u32x4*)(C + (size_t)row * 512 + col) = w;
                    float s = (v0[0] * v0[0] + v0[1] * v0[1]) + (v0[2] * v0[2] + v0[3] * v0[3]) + (v1[0] * v1[0] + v1[1] * v1[1]) + (v1[2] * v1[2] + v1[3] * v1[3]);
                    s += __shfl_xor(s, 16); s += __shfl_xor(s, 32);
                    if (fq == 0) ss2[(size_t)row * 16 + u.pn * 8 + bj * 4 + wc] = s;
                }
                asm volatile("" ::: "memory");
            }
    }
};
}

#define XB_TMO      128
#define XB_XCNT(j)  (256  + 64 * (j))
#define XB_XSUB(j)  (1280 + 64 * (j))
#define XB_XGEN(j)  (2304 + 64 * (j))
#define XB_TOP      3328
#define XB_TOPGEN   3392
#define XCD_BAR_WORDS 3456
#define XB_SPIN_CAP (1u << 20)
__device__ __forceinline__ unsigned xb_ld(unsigned* p)              { return __hip_atomic_load(p, __ATOMIC_RELAXED, __HIP_MEMORY_SCOPE_AGENT); }
__device__ __forceinline__ unsigned xb_add(unsigned* p, unsigned v) { return __hip_atomic_fetch_add(p, v, __ATOMIC_RELAXED, __HIP_MEMORY_SCOPE_AGENT); }
__device__ __forceinline__ unsigned xb_xcc_id() { return (unsigned)__builtin_amdgcn_s_getreg((3 << 11) | 20) & 0xFu; }
#define XB_SPIN(cond, bar) do { unsigned _sp = 0; while (cond) { __builtin_amdgcn_s_sleep(1); \
    if ((++_sp & 255u) == 0u) { if (xb_ld(&(bar)[XB_TMO])) break; if (_sp > XB_SPIN_CAP) { atomicAdd(&(bar)[XB_TMO], 1u); break; } } } } while (0)
struct XcdBarrier { unsigned* bar; unsigned x; volatile LAS unsigned* st; };
__device__ __forceinline__ XcdBarrier xcd_barrier_post(unsigned* bar, volatile LAS unsigned* st, int tid) {
    XcdBarrier b; b.bar = bar; b.x = xb_xcc_id(); b.st = st;
    if (tid == 0) (void)xb_add(&bar[XB_XCNT(b.x)], 1u);
    return b;
}
__device__ __forceinline__ void xcd_barrier_complete(unsigned* bar, unsigned x, unsigned& nloc, unsigned& nx) {
    const unsigned G = gridDim.x * gridDim.y * gridDim.z;
    unsigned sum, cnt, mine, sp = 0u;
    for (;;) {
        sum = 0u; cnt = 0u; mine = 0u;
#pragma unroll
        for (unsigned j = 0; j < 16; ++j) { const unsigned c = xb_ld(&bar[XB_XCNT(j)]); sum += c; cnt += (c > 0u) ? 1u : 0u; mine = (j == x) ? c : mine; }
        if (sum == G) break;
        __builtin_amdgcn_s_sleep(1);
        if ((++sp & 255u) == 0u) { if (xb_ld(&bar[XB_TMO])) break; if (sp > XB_SPIN_CAP) { atomicAdd(&bar[XB_TMO], 1u); break; } }
    }
    nloc = mine > 0u ? mine : 1u; nx = cnt > 0u ? cnt : 1u;
}
__device__ __forceinline__ void xcd_barrier(const XcdBarrier& b, int tid) {
    asm volatile("s_waitcnt vmcnt(0)" ::: "memory");
    __syncthreads();
    if (tid == 0) {
        unsigned* bar = b.bar;
        __builtin_amdgcn_s_waitcnt(0);
        unsigned nloc = b.st[0], nx = b.st[1];
        if (nloc == 0u) { xcd_barrier_complete(bar, b.x, nloc, nx); b.st[0] = nloc; b.st[1] = nx; }
        const unsigned old = xb_add(&bar[XB_XSUB(b.x)], 1u);
        const unsigned gen = old / nloc;
        if (old + 1u == (gen + 1u) * nloc) {
            __builtin_amdgcn_fence(__ATOMIC_RELEASE, "agent");
            asm volatile("s_waitcnt vmcnt(0)" ::: "memory");
            const unsigned og = xb_add(&bar[XB_TOP], 1u);
            const unsigned tg = og / nx;
            if (og + 1u == (tg + 1u) * nx) xb_add(&bar[XB_TOPGEN], 1u);
            else XB_SPIN(xb_ld(&bar[XB_TOPGEN]) == tg, bar);
            __builtin_amdgcn_fence(__ATOMIC_ACQUIRE, "agent");
            xb_add(&bar[XB_XGEN(b.x)], 1u);
            asm volatile("s_waitcnt vmcnt(0)" ::: "memory");
        } else {
            XB_SPIN(xb_ld(&bar[XB_XGEN(b.x)]) == gen, bar);
            __builtin_amdgcn_fence(__ATOMIC_ACQUIRE, "agent");
            asm volatile("s_waitcnt vmcnt(0)" ::: "memory");
        }
    }
    __syncthreads();
}

__device__ __forceinline__ void cvt_item(const float* W, int K, int N, bf16_t* WT, const float* gain, int swiglu, LAS float* scr, int item, int lane) {
    const int nblk = (N + 31) / 32, kb = item / nblk, nb = item % nblk, k0 = 64 * kb, n0 = 32 * nb;
    const int nn = n0 + (lane & 31);
    float v[32];
#pragma unroll
    for (int i = 0; i < 32; ++i) { const int kk = 2 * i + (lane >> 5); v[i] = (nn < N) ? W[(size_t)(k0 + kk) * N + nn] : 0.f; }
    const int c = lane & 7;
    f32x4 g0 = (f32x4){1.f, 1.f, 1.f, 1.f}, g1 = g0;
    if (gain) { g0 = *(const f32x4*)(gain + k0 + 8 * c); g1 = *(const f32x4*)(gain + k0 + 8 * c + 4); }
#pragma unroll
    for (int i = 0; i < 32; ++i) { const int kk = 2 * i + (lane >> 5); scr[kk * 33 + (lane & 31)] = v[i]; }
    asm volatile("s_waitcnt lgkmcnt(0)" ::: "memory");
#pragma unroll
    for (int j = 0; j < 4; ++j) { const int n = (lane >> 3) + 8 * j; const LAS float* s = scr + (8 * c) * 33 + n;
        u32x4 o; o.x = pk2(s[0 * 33] * g0[0], s[1 * 33] * g0[1]); o.y = pk2(s[2 * 33] * g0[2], s[3 * 33] * g0[3]); o.z = pk2(s[4 * 33] * g1[0], s[5 * 33] * g1[1]); o.w = pk2(s[6 * 33] * g1[2], s[7 * 33] * g1[3]);
        int dn = n0 + n;
        if (swiglu) { const int isup = dn >= FH; const int jj = isup ? dn - FH : dn; dn = (jj >> 7) * 256 + isup * 128 + (jj & 127); }
        *(u32x4*)(WT + (size_t)dn * K + k0 + 8 * c) = o; }
    asm volatile("s_waitcnt lgkmcnt(0)" ::: "memory");
}
__device__ __forceinline__ void cvt_weight(const float* W, int K, int N, int Npad, bf16_t* WT, const float* gain, int swiglu, LAS unsigned char* lds, int gw, int ngw, int wave, int lane) {
    LAS float* scr = (LAS float*)(lds + wave * 8704);
    const int nblk = (N + 31) / 32, nitems = (K / 64) * nblk;
    for (int it = gw; it < nitems; it += ngw) cvt_item(W, K, N, WT, gain, swiglu, scr, it, lane);
    const int zr0 = nblk * 32; const int nz = (Npad - zr0) * (K / 8);
    unsigned z0 = 0u; asm volatile("" : "+v"(z0));
    for (int i = gw * 64 + lane; i < nz; i += ngw * 64) *(u32x4*)(WT + (size_t)zr0 * K + (size_t)i * 8) = (u32x4){z0, z0, z0, z0};
}

struct Args { const float* in[43]; float* out; unsigned char* ws; int ph_lo, ph_hi; };

struct Ctx {
    LAS unsigned char* lds; unsigned char* ws; int tid, lane, wave, gw, ngw;
};

__device__ __forceinline__ void convert_mixer(const Args& a, const Ctx& c, int L, int gw, int ngw) {
    unsigned char* ws = c.ws;
    bf16_t* wout = (bf16_t*)(ws + WS_WMIX_OUT + (size_t)(L & 1) * 2 * MiB);
    if (L == 0 || L == 3) {
        const int b = (L == 0) ? 1 : 33;
        cvt_weight(a.in[b + 1], D, 4112, 4352, (bf16_t*)(ws + WS_WMIX), a.in[b], 0, c.lds, gw, ngw, c.wave, c.lane);
        cvt_weight(a.in[b + 6], D, D, D, wout, nullptr, 0, c.lds, gw, ngw, c.wave, c.lane);
    } else if (L == 1) {
        cvt_weight(a.in[12], D, 3072, 3072, (bf16_t*)(ws + WS_WMIX), a.in[11], 0, c.lds, gw, ngw, c.wave, c.lane);
        cvt_weight(a.in[15], D, D, D, wout, nullptr, 0, c.lds, gw, ngw, c.wave, c.lane);
    } else {
        cvt_weight(a.in[20], D, 448, 512, (bf16_t*)(ws + WS_WMIX), a.in[19], 0, c.lds, gw, ngw, c.wave, c.lane);
        cvt_weight(a.in[23], 256, 1536, 1536, (bf16_t*)(ws + WS_WMIX + 1 * MiB), a.in[21], 0, c.lds, gw, ngw, c.wave, c.lane);
        cvt_weight(a.in[24], 128, 2048, 2048, (bf16_t*)(ws + WS_WMIX + 2 * MiB), a.in[22], 0, c.lds, gw, ngw, c.wave, c.lane);
        cvt_weight(a.in[29], D, D, D, wout, nullptr, 0, c.lds, gw, ngw, c.wave, c.lane);
    }
}
__device__ __forceinline__ void convert_ffn(const Args& a, const Ctx& c, int L, int gw, int ngw) {
    const int b = (L == 0) ? 8 : (L == 1) ? 16 : (L == 2) ? 30 : 40;
    cvt_weight(a.in[b + 1], D, 2 * FH, 2 * FH, (bf16_t*)(c.ws + WS_WFFN), a.in[b], 1, c.lds, gw, ngw, c.wave, c.lane);
    cvt_weight(a.in[b + 2], FH, D, D, (bf16_t*)(c.ws + WS_WFFN_DN), nullptr, 0, c.lds, gw, ngw, c.wave, c.lane);
}

__device__ __forceinline__ void prologue_rows(const Args& a, const Ctx& c) {
    const float* x = a.in[0]; bf16_t* xb = (bf16_t*)(c.ws + WS_R1); float* ss = (float*)(c.ws + WS_SS);
    for (int m = c.gw; m < M; m += c.ngw) {
        const f32x4* xr = (const f32x4*)(x + (size_t)m * D) + c.lane;
        f32x4 v[4]; float s = 0.f;
#pragma unroll
        for (int j = 0; j < 4; ++j) { v[j] = xr[64 * j]; s += (v[j][0] * v[j][0] + v[j][1] * v[j][1]) + (v[j][2] * v[j][2] + v[j][3] * v[j][3]); }
        s = wave_sum(s);
        u32x2* o = (u32x2*)(xb + (size_t)m * D) + c.lane;
#pragma unroll
        for (int j = 0; j < 4; ++j) { u32x2 w; w.x = pk2(v[j][0], v[j][1]); w.y = pk2(v[j][2], v[j][3]); o[64 * j] = w; }
        if (c.lane < 16) ss[(size_t)m * 16 + c.lane] = (c.lane == 0) ? s : 0.f;
    }
}

__device__ __forceinline__ void dn_conv(const Args& a, const Ctx& c, const float* conv_w) {
    bf16_t* QKV = (bf16_t*)(c.ws + WS_R2); const bf16_t* HALO = (const bf16_t*)(c.ws + WS_HALO); float* RS = (float*)(c.ws + WS_RS);
    const int cg8 = c.tid & 15, seg = c.tid >> 4;
    for (int item = blockIdx.x; item < 64 * 24; item += gridDim.x) {
        const int pm = item / 24, slab = item % 24, which = slab >> 3, h = slab & 7;
        const int gcol = slab * 128 + cg8 * 8; const int row0 = pm * 256 + seg * 8;
        u32x4 raw[11];
#pragma unroll
        for (int i = 0; i < 3; ++i) {
            if (seg == 0) { raw[i] = ((pm & 15) == 0) ? (u32x4){0u, 0u, 0u, 0u} : *(const u32x4*)(HALO + ((size_t)pm * 3 + i) * 3072 + gcol); }
            else raw[i] = *(const u32x4*)(QKV + (size_t)(row0 - 3 + i) * 3072 + gcol);
        }
#pragma unroll
        for (int i = 0; i < 8; ++i) raw[3 + i] = *(const u32x4*)(QKV + (size_t)(row0 + i) * 3072 + gcol);
        float w[4][8];
#pragma unroll
        for (int j = 0; j < 4; ++j) { const f32x4 w0 = *(const f32x4*)(conv_w + j * 3072 + gcol), w1 = *(const f32x4*)(conv_w + j * 3072 + gcol + 4);
#pragma unroll
            for (int e = 0; e < 4; ++e) { w[j][e] = w0[e]; w[j][4 + e] = w1[e]; } }
        __syncthreads();
#pragma unroll
        for (int r = 0; r < 8; ++r) {
            u32x4 o; float ssq = 0.f;
#pragma unroll
            for (int e2 = 0; e2 < 4; ++e2) {
                float y0 = 0.f, y1 = 0.f;
#pragma unroll
                for (int j = 0; j < 4; ++j) { const unsigned wv = raw[r + j][e2]; y0 += w[j][2 * e2] * bflo(wv); y1 += w[j][2 * e2 + 1] * bfhi(wv); }
                const unsigned pk = pk2(silu_f(y0), silu_f(y1)); o[e2] = pk;
                const float s0 = bflo(pk), s1 = bfhi(pk); ssq += s0 * s0 + s1 * s1;
            }
            *(u32x4*)(QKV + (size_t)(row0 + r) * 3072 + gcol) = o;
            if (which < 2) {
                ssq += __shfl_xor(ssq, 1); ssq += __shfl_xor(ssq, 2); ssq += __shfl_xor(ssq, 4); ssq += __shfl_xor(ssq, 8);
                if (cg8 == 0) RS[(size_t)(row0 + r) * 16 + which * 8 + h] = (1.0f / sqrtf(ssq + EPS)) * (which == 0 ? 0.08838834764831845f : 1.f);
            }
        }
        __syncthreads();
    }
}

constexpr int DB_LM = 0, DB_GC = 17408, DB_BETA = 17664, DB_KB = 17920, DB_QB = 35328, DB_K32 = 52736, DB_V32 = 86528;
__device__ __forceinline__ void dn_chunk(const Args& a, const Ctx& c, const float* a_log, const float* dt_bias) {
    bf16_t* QKV = (bf16_t*)(c.ws + WS_R2); bf16_t* KT = (bf16_t*)(c.ws + WS_R1); bf16_t* ATT = (bf16_t*)(c.ws + WS_R5);
    const float* AB = (const float*)(c.ws + WS_AB); const float* RS = (const float*)(c.ws + WS_RS); float* GC = (float*)(c.ws + WS_GC);
    LAS bf16_t* kb = (LAS bf16_t*)(c.lds + DB_KB); LAS bf16_t* qb = (LAS bf16_t*)(c.lds + DB_QB);
    LAS float* K32 = (LAS float*)(c.lds + DB_K32); LAS float* V32 = (LAS float*)(c.lds + DB_V32); LAS float* Lm = (LAS float*)(c.lds + DB_LM);
    LAS float* gcs = (LAS float*)(c.lds + DB_GC); LAS float* betas = (LAS float*)(c.lds + DB_BETA);
    const int lane = c.lane, wave = c.wave, quad = lane >> 4, l15 = lane & 15;
    for (int item = blockIdx.x; item < BATCH * 64 * NH; item += gridDim.x) {
        const int h = item & 7, n = (item >> 3) & 63, b = item >> 9;
        const int t0 = b * SEQ + n * 64;
        if (wave == 0) {
            const float av = AB[(size_t)(t0 + lane) * 16 + h], bl = AB[(size_t)(t0 + lane) * 16 + 8 + h];
            float g = -fexp(a_log[h]) * softplus_f(av + dt_bias[h]);
#pragma unroll
            for (int o = 1; o < 64; o <<= 1) { const float t = __shfl_up(g, o); if (lane >= o) g += t; }
            gcs[lane] = g; betas[lane] = 1.f / (1.f + fexp(-bl));
            GC[(size_t)(t0 + lane) * 8 + h] = g;
        }
        __syncthreads();
        {
            const int r = c.tid >> 3, cc = (c.tid & 7) * 16;
            const size_t rowoff = (size_t)(t0 + r) * 3072 + h * 128 + cc;
            const float rsq = RS[(size_t)(t0 + r) * 16 + h], rsk = RS[(size_t)(t0 + r) * 16 + 8 + h];
            const float be = betas[r], eg = fexp(gcs[r]);
            u32x4 qw[2], kw[2], vw[2];
#pragma unroll
            for (int i = 0; i < 2; ++i) { qw[i] = *(const u32x4*)(QKV + rowoff + 8 * i); kw[i] = *(const u32x4*)(QKV + rowoff + 1024 + 8 * i); vw[i] = *(const u32x4*)(QKV + rowoff + 2048 + 8 * i); }
#pragma unroll
            for (int i = 0; i < 2; ++i) {
                u32x4 qo, ko;
#pragma unroll
                for (int j = 0; j < 4; ++j) {
                    const float q0 = bflo(qw[i][j]) * rsq, q1 = bfhi(qw[i][j]) * rsq;
                    const float k0 = bflo(kw[i][j]) * rsk, k1 = bfhi(kw[i][j]) * rsk;
                    const float v0 = bflo(vw[i][j]), v1 = bfhi(vw[i][j]);
                    qo[j] = pk2(q0, q1); ko[j] = pk2(k0, k1);
                    const int cidx = cc + 8 * i + 2 * j;
                    K32[r * 132 + cidx] = k0 * be * eg; K32[r * 132 + cidx + 1] = k1 * be * eg;
                    V32[r * 132 + cidx] = v0 * be; V32[r * 132 + cidx + 1] = v1 * be;
                }
                *(LAS u32x4*)(qb + r * 136 + cc + 8 * i) = qo; *(LAS u32x4*)(kb + r * 136 + cc + 8 * i) = ko;
            }
        }
        __syncthreads();
        {
            const int wm = wave & 3; const LAS bf16_t* Asrc = (wave < 4) ? kb : qb;
            f32x4 acc[4];
#pragma unroll
            for (int nt = 0; nt < 4; ++nt) acc[nt] = (f32x4){0.f, 0.f, 0.f, 0.f};
#pragma unroll
            for (int ks = 0; ks < 4; ++ks) {
                const bf16x8 af = *(const LAS bf16x8*)(Asrc + (16 * wm + l15) * 136 + 32 * ks + 8 * quad);
#pragma unroll
                for (int nt = 0; nt < 4; ++nt) {
                    const bf16x8 bfr = *(const LAS bf16x8*)(kb + (16 * nt + l15) * 136 + 32 * ks + 8 * quad);
                    acc[nt] = __builtin_amdgcn_mfma_f32_16x16x32_bf16(af, bfr, acc[nt], 0, 0, 0);
                }
            }
            bf16_t* att = ATT + (size_t)((b * NH + h) * 64 + n) * 4096;
#pragma unroll
            for (int nt = 0; nt < 4; ++nt)
#pragma unroll
                for (int r = 0; r < 4; ++r) {
                    const int cr = 16 * wm + 4 * quad + r, cs = 16 * nt + l15;
                    const float dec = fexp(fminf(gcs[cr] - gcs[cs], 0.f));
                    if (wave < 4) Lm[cr * 68 + cs] = (cr > cs) ? betas[cr] * acc[nt][r] * dec : 0.f;
                    else att[cr * 64 + cs] = (bf16_t)f2bf((cr >= cs) ? acc[nt][r] * dec : 0.f);
                }
        }
        __syncthreads();
        if (wave < 4) {
            const int j = wave * 64 + lane;
            const LAS float* rhs = (j < 128) ? (V32 + j) : (K32 + (j - 128));
            float sol[64];
#pragma unroll
            for (int i = 0; i < 64; ++i) {
                float a0 = rhs[i * 132], a1 = 0.f;
#pragma unroll
                for (int jb = 0; jb < i; jb += 4) {
                    const f32x4 lv = *(const LAS f32x4*)(Lm + i * 68 + jb);
                    a0 -= lv[0] * sol[jb];
                    if (jb + 1 < i) a1 -= lv[1] * sol[jb + 1];
                    if (jb + 2 < i) a0 -= lv[2] * sol[jb + 2];
                    if (jb + 3 < i) a1 -= lv[3] * sol[jb + 3];
                }
                sol[i] = a0 + a1;
            }
            bf16_t* dst = QKV + (size_t)t0 * 3072 + ((j < 128) ? (2048 + h * 128 + j) : (1024 + h * 128 + (j - 128)));
#pragma unroll
            for (int i = 0; i < 64; ++i) dst[(size_t)i * 3072] = (bf16_t)f2bf(sol[i]);
        } else {
            const int t = c.tid - 256, dk = t & 127, ch = t >> 7;
            bf16_t* kt = KT + (size_t)((b * NH + h) * 64 + n) * 8192 + dk * 64 + ch * 32;
#pragma unroll
            for (int g4 = 0; g4 < 4; ++g4) {
                u32x4 w;
#pragma unroll
                for (int e = 0; e < 4; ++e) { const int cc = ch * 32 + g4 * 8 + 2 * e; w[e] = (unsigned)kb[cc * 136 + dk] | ((unsigned)kb[(cc + 1) * 136 + dk] << 16); }
                *(u32x4*)(kt + g4 * 8) = w;
            }
            const int r = t >> 2, c0 = (t & 3) * 32;
#pragma unroll
            for (int i = 0; i < 4; ++i) *(u32x4*)(QKV + (size_t)(t0 + r) * 3072 + h * 128 + c0 + 8 * i) = *(const LAS u32x4*)(qb + r * 136 + c0 + 8 * i);
        }
        __syncthreads();
    }
}

__device__ __forceinline__ bf16x8 ld2x4(const bf16_t* p) {
    const u32x2 lo = *(const u32x2*)p, hi = *(const u32x2*)(p + 16);
    u32x4 w; w.x = lo.x; w.y = lo.y; w.z = hi.x; w.w = hi.y; return __builtin_bit_cast(bf16x8, w);
}
__device__ __forceinline__ bf16x8 pack8(const f32x4 a, const f32x4 b) {
    u32x4 w; w.x = pk2(a[0], a[1]); w.y = pk2(a[2], a[3]); w.z = pk2(b[0], b[1]); w.w = pk2(b[2], b[3]); return __builtin_bit_cast(bf16x8, w);
}
constexpr int SC_W = 0, SC_Q = 17408, SC_KT = 34816, SC_ATT = 53248, SC_U = 62464, SC_GC = 71680, SC_BUF = 71936;
__device__ __forceinline__ bf16x8 ld2x4_lds(const LAS bf16_t* p) {
    const u32x2 lo = *(const LAS u32x2*)p, hi = *(const LAS u32x2*)(p + 16);
    u32x4 w; w.x = lo.x; w.y = lo.y; w.z = hi.x; w.w = hi.y; return __builtin_bit_cast(bf16x8, w);
}
__device__ __forceinline__ void dn_scan(const Args& a, const Ctx& c) {
    const bf16_t* QKV = (const bf16_t*)(c.ws + WS_R2); const bf16_t* KT = (const bf16_t*)(c.ws + WS_R1); const bf16_t* ATT = (const bf16_t*)(c.ws + WS_R5);
    const float* GC = (const float*)(c.ws + WS_GC); bf16_t* O = (bf16_t*)(c.ws + WS_R4);
    const int lane = c.lane, wave = c.wave, quad = lane >> 4, l15 = lane & 15;
    for (int item = blockIdx.x; item < BATCH * NH * 2; item += gridDim.x) {
        const int half = item & 1, bh = item >> 1, b = bh >> 3, h = bh & 7;
        __syncthreads();
        const int pair = (wave >= 6) ? 1 : 0, lt = (c.tid - 256) & 127;
        u32x4 lv[32]; float lg = 0.f;
#define SCAN_LOAD(step) do { const int t0_ = b * SEQ + (step) * 64; const size_t ci_ = (size_t)(bh * 64 + (step)); \
            _Pragma("unroll") for (int i = 0; i < 8; ++i) { const int id = lt + 128 * i, row = id >> 4, ch = id & 15; \
                const bf16_t* p_ = QKV + (size_t)(t0_ + row) * 3072 + h * 128 + ch * 8; lv[i] = *(const u32x4*)(p_ + 1024); lv[8 + i] = *(const u32x4*)p_; } \
            _Pragma("unroll") for (int i = 0; i < 8; ++i) { const int id = lt + 128 * i; lv[16 + i] = *(const u32x4*)(KT + ci_ * 8192 + (size_t)id * 8); } \
            _Pragma("unroll") for (int i = 0; i < 4; ++i) { const int id = lt + 128 * i, row = id >> 3, ch = id & 7; \
                lv[24 + i] = *(const u32x4*)(ATT + ci_ * 4096 + (size_t)id * 8); \
                lv[28 + i] = *(const u32x4*)(QKV + (size_t)(t0_ + row) * 3072 + 2048 + h * 128 + half * 64 + ch * 8); } \
            if (lt < 64) lg = GC[(size_t)(t0_ + lt) * 8 + h]; } while (0)
        if (wave >= 4) { if (pair == 0) { SCAN_LOAD(0); } else { SCAN_LOAD(1); } }
        if (wave >= 4) {
            for (int n = -1; n < 64; ++n) {
                if (((n + 1) & 1) == pair) {
                    { const int nn = n + 1;
                      LAS unsigned char* buf = c.lds + (nn & 1) * SC_BUF;
#pragma unroll
                      for (int i = 0; i < 8; ++i) { const int id = lt + 128 * i, row = id >> 4, ch = id & 15;
                          *(LAS u32x4*)(buf + SC_W + (row * 136 + ch * 8) * 2) = lv[i]; *(LAS u32x4*)(buf + SC_Q + (row * 136 + ch * 8) * 2) = lv[8 + i]; }
#pragma unroll
                      for (int i = 0; i < 8; ++i) { const int id = lt + 128 * i, row = id >> 3, ch = id & 7; *(LAS u32x4*)(buf + SC_KT + (row * 72 + ch * 8) * 2) = lv[16 + i]; }
#pragma unroll
                      for (int i = 0; i < 4; ++i) { const int id = lt + 128 * i, row = id >> 3, ch = id & 7;
                          *(LAS u32x4*)(buf + SC_ATT + (row * 72 + ch * 8) * 2) = lv[24 + i]; *(LAS u32x4*)(buf + SC_U + (row * 72 + ch * 8) * 2) = lv[28 + i]; }
                      if (lt < 64) *(LAS float*)(buf + SC_GC + lt * 4) = lg; }
                    if (n + 3 < 64) { SCAN_LOAD(n + 3); }
                }
                LDS_BARRIER();
            }
        } else {
            f32x4 S[8];
#pragma unroll
            for (int mt = 0; mt < 8; ++mt) S[mt] = (f32x4){0.f, 0.f, 0.f, 0.f};
            LDS_BARRIER();
            for (int n = 0; n < 64; ++n) {
                const LAS unsigned char* buf = c.lds + (n & 1) * SC_BUF;
                const LAS bf16_t* Wl = (const LAS bf16_t*)(buf + SC_W); const LAS bf16_t* Ql = (const LAS bf16_t*)(buf + SC_Q);
                const LAS bf16_t* Kl = (const LAS bf16_t*)(buf + SC_KT); const LAS bf16_t* Al = (const LAS bf16_t*)(buf + SC_ATT);
                const LAS bf16_t* Ul = (const LAS bf16_t*)(buf + SC_U); const LAS float* gcl = (const LAS float*)(buf + SC_GC);
                const int t0 = b * SEQ + n * 64;
                bf16x8 Sb[4];
#pragma unroll
                for (int ks = 0; ks < 4; ++ks) Sb[ks] = pack8(S[2 * ks], S[2 * ks + 1]);
                bf16x8 Wf[4][4], Qf[4][4];
#pragma unroll
                for (int ct = 0; ct < 4; ++ct)
#pragma unroll
                    for (int ks = 0; ks < 4; ++ks) { const int off = (16 * ct + l15) * 136 + 32 * ks + 4 * quad; Wf[ct][ks] = ld2x4_lds(Wl + off); Qf[ct][ks] = ld2x4_lds(Ql + off); }
                __builtin_amdgcn_sched_barrier(0);
                f32x4 P[4], QS[4];
#pragma unroll
                for (int ct = 0; ct < 4; ++ct) { P[ct] = (f32x4){0.f, 0.f, 0.f, 0.f}; QS[ct] = (f32x4){0.f, 0.f, 0.f, 0.f}; }
#pragma unroll
                for (int ks = 0; ks < 4; ++ks)
#pragma unroll
                    for (int ct = 0; ct < 4; ++ct) {
                        P[ct] = __builtin_amdgcn_mfma_f32_16x16x32_bf16(Wf[ct][ks], Sb[ks], P[ct], 0, 0, 0);
                        QS[ct] = __builtin_amdgcn_mfma_f32_16x16x32_bf16(Qf[ct][ks], Sb[ks], QS[ct], 0, 0, 0);
                    }
                __builtin_amdgcn_sched_barrier(0);
                bf16x8 Af[4][2], Kf[8][2];
#pragma unroll
                for (int ct = 0; ct < 4; ++ct)
#pragma unroll
                    for (int k2 = 0; k2 < 2; ++k2) Af[ct][k2] = ld2x4_lds(Al + (16 * ct + l15) * 72 + 32 * k2 + 4 * quad);
#pragma unroll
                for (int mt = 0; mt < 8; ++mt)
#pragma unroll
                    for (int k2 = 0; k2 < 2; ++k2) Kf[mt][k2] = ld2x4_lds(Kl + (16 * mt + l15) * 72 + 32 * k2 + 4 * quad);
                float uu[4][4], gg[4][4];
#pragma unroll
                for (int ct = 0; ct < 4; ++ct)
#pragma unroll
                    for (int r = 0; r < 4; ++r) { const int cr = 16 * ct + 4 * quad + r; uu[ct][r] = bf2f(Ul[cr * 72 + 16 * wave + l15]); gg[ct][r] = gcl[cr]; }
                const float gL = gcl[63];
                __builtin_amdgcn_sched_barrier(0);
                f32x4 vn[4], vd[4], o[4];
#pragma unroll
                for (int ct = 0; ct < 4; ++ct)
#pragma unroll
                    for (int r = 0; r < 4; ++r) {
                        const float g = gg[ct][r];
                        const float v = uu[ct][r] - P[ct][r];
                        vn[ct][r] = v; vd[ct][r] = v * fexp(gL - g); o[ct][r] = QS[ct][r] * fexp(g);
                    }
                bf16x8 Vb[2], Vdb[2];
#pragma unroll
                for (int k2 = 0; k2 < 2; ++k2) { Vb[k2] = pack8(vn[2 * k2], vn[2 * k2 + 1]); Vdb[k2] = pack8(vd[2 * k2], vd[2 * k2 + 1]); }
                const float eL = fexp(gL);
#pragma unroll
                for (int mt = 0; mt < 8; ++mt) S[mt] = S[mt] * eL;
#pragma unroll
                for (int k2 = 0; k2 < 2; ++k2) {
#pragma unroll
                    for (int mt = 0; mt < 8; ++mt) S[mt] = __builtin_amdgcn_mfma_f32_16x16x32_bf16(Kf[mt][k2], Vdb[k2], S[mt], 0, 0, 0);
#pragma unroll
                    for (int ct = 0; ct < 4; ++ct) o[ct] = __builtin_amdgcn_mfma_f32_16x16x32_bf16(Af[ct][k2], Vb[k2], o[ct], 0, 0, 0);
                }
#pragma unroll
                for (int ct = 0; ct < 4; ++ct)
#pragma unroll
                    for (int r = 0; r < 4; ++r) O[(size_t)(t0 + 16 * ct + 4 * quad + r) * 1024 + h * 128 + (half * 4 + wave) * 16 + l15] = (bf16_t)f2bf(o[ct][r]);
                LDS_BARRIER();
            }
        }
    }
}

__device__ __forceinline__ void dn_post(const Args& a, const Ctx& c, const float* out_norm) {
    bf16_t* O = (bf16_t*)(c.ws + WS_R4); const bf16_t* Z = (const bf16_t*)(c.ws + WS_R3);
    const int cb = (c.lane & 7) * 16;
    float gn[16];
#pragma unroll
    for (int i = 0; i < 16; ++i) gn[i] = out_norm[cb + i];
    for (int m = c.gw; m < M; m += c.ngw) {
        u32x4 ow[2], zw[2];
#pragma unroll
        for (int i = 0; i < 2; ++i) { ow[i] = *(const u32x4*)(O + (size_t)m * D + c.lane * 16 + 8 * i); zw[i] = *(const u32x4*)(Z + (size_t)m * D + c.lane * 16 + 8 * i); }
        float ov[16], s = 0.f;
#pragma unroll
        for (int i = 0; i < 2; ++i)
#pragma unroll
            for (int j = 0; j < 4; ++j) { ov[8 * i + 2 * j] = bflo(ow[i][j]); ov[8 * i + 2 * j + 1] = bfhi(ow[i][j]); }
#pragma unroll
        for (int i = 0; i < 16; ++i) s += ov[i] * ov[i];
        s += __shfl_xor(s, 1); s += __shfl_xor(s, 2); s += __shfl_xor(s, 4);
        const float rs = 1.0f / sqrtf(s * (1.0f / 128.0f) + EPS);
        u32x4 res[2];
#pragma unroll
        for (int i = 0; i < 2; ++i)
#pragma unroll
            for (int j = 0; j < 4; ++j) {
                const float z0 = bflo(zw[i][j]), z1 = bfhi(zw[i][j]);
                res[i][j] = pk2(ov[8 * i + 2 * j] * rs * gn[8 * i + 2 * j] * silu_f(z0), ov[8 * i + 2 * j + 1] * rs * gn[8 * i + 2 * j + 1] * silu_f(z1));
            }
#pragma unroll
        for (int i = 0; i < 2; ++i) *(u32x4*)(O + (size_t)m * D + c.lane * 16 + 8 * i) = res[i];
    }
}

__device__ __forceinline__ void v_transpose(const Ctx& c, const bf16_t* src, int pitch, int head_stride, int col_base, bf16_t* Vt) {
    LAS bf16_t* tile = (LAS bf16_t*)c.lds;
    for (int item = blockIdx.x; item < BATCH * NH * 64; item += gridDim.x) {
        const int tb = item & 63, h = (item >> 6) & 7, b = item >> 9;
        const int t0 = b * SEQ + tb * 64;
        { const int r = c.tid >> 3, cc = (c.tid & 7) * 16;
          const bf16_t* p = src + (size_t)(t0 + r) * pitch + col_base + h * head_stride + cc;
          *(LAS u32x4*)(tile + r * 136 + cc) = *(const u32x4*)p; *(LAS u32x4*)(tile + r * 136 + cc + 8) = *(const u32x4*)(p + 8); }
        __syncthreads();
        { const int d = c.tid >> 2, tq = (c.tid & 3) * 16;
          u32x4 w[2];
#pragma unroll
          for (int i = 0; i < 2; ++i)
#pragma unroll
              for (int e = 0; e < 4; ++e) { const int t = tq + 8 * i + 2 * e; w[i][e] = (unsigned)tile[t * 136 + d] | ((unsigned)tile[(t + 1) * 136 + d] << 16); }
          bf16_t* dst = Vt + ((size_t)((b * NH + h) * 128 + d)) * SEQ + tb * 64 + tq;
          *(u32x4*)dst = w[0]; *(u32x4*)(dst + 8) = w[1]; }
        __syncthreads();
    }
}

__device__ __forceinline__ void sb_prep_rows(const Args& a, const Ctx& c, const float* qn, const float* kn) {
    bf16_t* QKV = (bf16_t*)(c.ws + WS_R2);
    const int cb = (c.lane & 7) * 16;
    float gq[16], gk[16];
#pragma unroll
    for (int i = 0; i < 16; ++i) { gq[i] = qn[cb + i] * 0.08838834764831845f; gk[i] = kn[cb + i]; }
    for (int m = c.gw; m < M; m += c.ngw) {
#pragma unroll
        for (int which = 0; which < 2; ++which) {
            bf16_t* p = QKV + (size_t)m * 3072 + which * 1024 + c.lane * 16;
            u32x4 w[2]; w[0] = *(const u32x4*)p; w[1] = *(const u32x4*)(p + 8);
            float v[16], s = 0.f;
#pragma unroll
            for (int i = 0; i < 2; ++i)
#pragma unroll
                for (int j = 0; j < 4; ++j) { v[8 * i + 2 * j] = bflo(w[i][j]); v[8 * i + 2 * j + 1] = bfhi(w[i][j]); }
#pragma unroll
            for (int i = 0; i < 16; ++i) s += v[i] * v[i];
            s += __shfl_xor(s, 1); s += __shfl_xor(s, 2); s += __shfl_xor(s, 4);
            const float rs = 1.0f / sqrtf(s * (1.0f / 128.0f) + EPS);
            u32x4 o[2];
#pragma unroll
            for (int i = 0; i < 2; ++i)
#pragma unroll
                for (int j = 0; j < 4; ++j) {
                    const float g0 = which ? gk[8 * i + 2 * j] : gq[8 * i + 2 * j], g1 = which ? gk[8 * i + 2 * j + 1] : gq[8 * i + 2 * j + 1];
                    o[i][j] = pk2(v[8 * i + 2 * j] * rs * g0, v[8 * i + 2 * j + 1] * rs * g1);
                }
            *(u32x4*)p = o[0]; *(u32x4*)(p + 8) = o[1];
        }
    }
}

__device__ __forceinline__ void mla_prep_rows(const Args& a, const Ctx& c) {
    bf16_t* Q = (bf16_t*)(c.ws + WS_R2); bf16_t* Kf = (bf16_t*)(c.ws + WS_R2 + 48 * MiB);
    const bf16_t* KV = (const bf16_t*)(c.ws + WS_R3); const bf16_t* C = (const bf16_t*)(c.ws + WS_R5);
    const float* gqn = a.in[25]; const float* gqr = a.in[26]; const float* gkn = a.in[27]; const float* gkr = a.in[28];
    const int lane = c.lane, h = lane >> 3, p = lane & 7;
    const float SC = 0.07216878364870322f;
    float g_qn[16], g_kn[16], g_qr[8], g_kr[8], invf[8];
#pragma unroll
    for (int i = 0; i < 16; ++i) { g_qn[i] = gqn[16 * p + i] * SC; g_kn[i] = gkn[16 * p + i]; }
#pragma unroll
    for (int i = 0; i < 8; ++i) { g_qr[i] = gqr[8 * p + i] * SC; g_kr[i] = gkr[8 * p + i];
        invf[i] = __builtin_amdgcn_exp2f(-(float)(2 * ((8 * p + i) & 31)) * (1.0f / 64.0f) * 13.287712379549449f); }
    const bool first = p < 4;
    for (int m = c.gw; m < M; m += c.ngw) {
        const int t = m & (SEQ - 1);
        const bf16_t* qp = Q + (size_t)m * 1536 + h * 192;
        const u32x4 qn0 = *(const u32x4*)(qp + 16 * p), qn1 = *(const u32x4*)(qp + 16 * p + 8), qr = *(const u32x4*)(qp + 128 + 8 * p);
        const bf16_t* kvp = KV + (size_t)m * 2048 + h * 256;
        const u32x4 kn0 = *(const u32x4*)(kvp + 16 * p), kn1 = *(const u32x4*)(kvp + 16 * p + 8);
        const u32x4 kr = *(const u32x4*)(C + (size_t)m * 512 + 384 + 8 * p);
        float cs[8], sn[8];
#pragma unroll
        for (int i = 0; i < 8; ++i) { const float ang = (float)t * invf[i]; const double rev = (double)ang * 0.15915494309189535; const float fr = (float)(rev - floor(rev));
            cs[i] = __builtin_amdgcn_cosf(fr); sn[i] = __builtin_amdgcn_sinf(fr); }
        float qv[16], kv[16], qrv[8], krv[8];
#pragma unroll
        for (int j = 0; j < 4; ++j) { qv[2 * j] = bflo(qn0[j]); qv[2 * j + 1] = bfhi(qn0[j]); qv[8 + 2 * j] = bflo(qn1[j]); qv[9 + 2 * j] = bfhi(qn1[j]);
            kv[2 * j] = bflo(kn0[j]); kv[2 * j + 1] = bfhi(kn0[j]); kv[8 + 2 * j] = bflo(kn1[j]); kv[9 + 2 * j] = bfhi(kn1[j]);
            qrv[2 * j] = bflo(qr[j]); qrv[2 * j + 1] = bfhi(qr[j]); krv[2 * j] = bflo(kr[j]); krv[2 * j + 1] = bfhi(kr[j]); }
        float sq = 0.f, sk = 0.f, sqr = 0.f, skr = 0.f;
#pragma unroll
        for (int i = 0; i < 16; ++i) { sq += qv[i] * qv[i]; sk += kv[i] * kv[i]; }
#pragma unroll
        for (int i = 0; i < 8; ++i) { sqr += qrv[i] * qrv[i]; skr += krv[i] * krv[i]; }
#pragma unroll
        for (int o = 1; o < 8; o <<= 1) { sq += __shfl_xor(sq, o); sk += __shfl_xor(sk, o); sqr += __shfl_xor(sqr, o); skr += __shfl_xor(skr, o); }
        const float rq = 1.0f / sqrtf(sq * (1.0f / 128.0f) + EPS), rk = 1.0f / sqrtf(sk * (1.0f / 128.0f) + EPS);
        const float rqr = 1.0f / sqrtf(sqr * (1.0f / 64.0f) + EPS), rkr = 1.0f / sqrtf(skr * (1.0f / 64.0f) + EPS);
        u32x4 oq0, oq1, ok0, ok1, oqr, okr;
#pragma unroll
        for (int j = 0; j < 4; ++j) { oq0[j] = pk2(qv[2 * j] * rq * g_qn[2 * j], qv[2 * j + 1] * rq * g_qn[2 * j + 1]); oq1[j] = pk2(qv[8 + 2 * j] * rq * g_qn[8 + 2 * j], qv[9 + 2 * j] * rq * g_qn[9 + 2 * j]);
            ok0[j] = pk2(kv[2 * j] * rk * g_kn[2 * j], kv[2 * j + 1] * rk * g_kn[2 * j + 1]); ok1[j] = pk2(kv[8 + 2 * j] * rk * g_kn[8 + 2 * j], kv[9 + 2 * j] * rk * g_kn[9 + 2 * j]); }
        float qo[8], ko[8];
#pragma unroll
        for (int i = 0; i < 8; ++i) {
            const float xq = qrv[i] * rqr * g_qr[i], xk = krv[i] * rkr * g_kr[i];
            const float yq = __shfl_xor(xq, 4), yk = __shfl_xor(xk, 4);
            qo[i] = first ? (xq * cs[i] - yq * sn[i]) : (xq * cs[i] + yq * sn[i]);
            ko[i] = first ? (xk * cs[i] - yk * sn[i]) : (xk * cs[i] + yk * sn[i]);
        }
#pragma unroll
        for (int j = 0; j < 4; ++j) { oqr[j] = pk2(qo[2 * j], qo[2 * j + 1]); okr[j] = pk2(ko[2 * j], ko[2 * j + 1]); }
        bf16_t* qw = Q + (size_t)m * 1536 + h * 192; bf16_t* kw = Kf + (size_t)m * 1536 + h * 192;
        *(u32x4*)(qw + 16 * p) = oq0; *(u32x4*)(qw + 16 * p + 8) = oq1; *(u32x4*)(qw + 128 + 8 * p) = oqr;
        *(u32x4*)(kw + 16 * p) = ok0; *(u32x4*)(kw + 16 * p + 8) = ok1; *(u32x4*)(kw + 128 + 8 * p) = okr;
    }
}

template <int DK, bool STICK>
__device__ __forceinline__ void attn_phase(const Ctx& c, const bf16_t* Q, int qpitch, const bf16_t* Kg, int kpitch, const bf16_t* Vt, bf16_t* O, int opitch) {
    constexpr int KP = DK + 8;
    constexpr int KS = DK / 32;
    constexpr int NKL = DK / 64;
    LAS bf16_t* Kt = (LAS bf16_t*)c.lds;
    LAS bf16_t* Vl = (LAS bf16_t*)(c.lds + 64 * KP * 2);
    LAS unsigned* flags = (LAS unsigned*)(c.lds + 64 * KP * 2 + 128 * 72 * 2);
    const int lane = c.lane, wave = c.wave, quad = lane >> 4, l15 = lane & 15;
    const int sr = c.tid >> 3, scc = (c.tid & 7) * (DK / 8);
    const int sd = c.tid >> 2, skq = (c.tid & 3) * 16;
    for (int pu = blockIdx.x; pu < 256; pu += gridDim.x) {
        const int bh = pu >> 3, s8 = pu & 7, b = bh >> 3, h = bh & 7;
        for (int half = 0; half < 2; ++half) {
            const int qb = half ? 15 - s8 : s8;
            const int q0 = qb * 256 + wave * 32;
            bf16x8 Qf[2][KS];
#pragma unroll
            for (int qt = 0; qt < 2; ++qt)
#pragma unroll
                for (int ks = 0; ks < KS; ++ks) Qf[qt][ks] = *(const bf16x8*)(Q + (size_t)(b * SEQ + q0 + 16 * qt + l15) * qpitch + h * DK + 32 * ks + 8 * quad);
            f32x4 Oa[8][2];
#pragma unroll
            for (int dt = 0; dt < 8; ++dt) { Oa[dt][0] = (f32x4){0.f, 0.f, 0.f, 0.f}; Oa[dt][1] = (f32x4){0.f, 0.f, 0.f, 0.f}; }
            float mrow[2] = {-1e30f, -1e30f}, lrow[2] = {0.f, 0.f}, Rrow[2] = {0.f, 0.f};
            const int ntile = 4 * (qb + 1);
            bool wdone = false;
            u32x4 kreg[NKL], vreg[2];
            const bf16_t* kbase = Kg + (size_t)(b * SEQ) * kpitch + h * DK;
            const bf16_t* vbase = Vt + (size_t)bh * 128 * SEQ;
            const unsigned koff = (unsigned)(sr * kpitch + scc), voff = (unsigned)(sd * SEQ + skq);
            { const int key0 = (STICK ? (ntile - 1) : 0) * 64;
              const bf16_t* p = kbase + (size_t)key0 * kpitch;
#pragma unroll
              for (int i = 0; i < NKL; ++i) kreg[i] = *(const u32x4*)(p + koff + 8 * i);
              const bf16_t* pv = vbase + key0;
              vreg[0] = *(const u32x4*)(pv + voff); vreg[1] = *(const u32x4*)(pv + voff + 8); }
            for (int it = 0; it < ntile; ++it) {
                const int kt = STICK ? (ntile - 1 - it) : it;
                const int key0 = kt * 64;
                if (STICK) { if (lane == 0) flags[wave] = wdone ? 1u : 0u; }
                LDS_BARRIER();
                if (STICK) { unsigned alld = 1u;
#pragma unroll
                    for (int w = 0; w < 8; ++w) alld &= flags[w];
                    if (alld) break; }
#pragma unroll
                for (int i = 0; i < NKL; ++i) *(LAS u32x4*)(Kt + sr * KP + scc + 8 * i) = kreg[i];
                *(LAS u32x4*)(Vl + sd * 72 + skq) = vreg[0]; *(LAS u32x4*)(Vl + sd * 72 + skq + 8) = vreg[1];
                if (it + 1 < ntile) {
                    const int key1 = (STICK ? (kt - 1) : (kt + 1)) * 64;
                    const bf16_t* p = kbase + (size_t)key1 * kpitch;
#pragma unroll
                    for (int i = 0; i < NKL; ++i) kreg[i] = *(const u32x4*)(p + koff + 8 * i);
                    const bf16_t* pv = vbase + key1;
                    vreg[0] = *(const u32x4*)(pv + voff); vreg[1] = *(const u32x4*)(pv + voff + 8);
                }
                LDS_BARRIER();
                if (key0 > q0 + 31) continue;
                if (STICK && wdone) continue;
                f32x4 St[4][2];
#pragma unroll
                for (int k4 = 0; k4 < 4; ++k4) { St[k4][0] = (f32x4){0.f, 0.f, 0.f, 0.f}; St[k4][1] = (f32x4){0.f, 0.f, 0.f, 0.f}; }
                bf16x8 kfr[2][4];
#pragma unroll
                for (int k4 = 0; k4 < 4; ++k4) kfr[0][k4] = *(const LAS bf16x8*)(Kt + (16 * k4 + l15) * KP + 8 * quad);
                __builtin_amdgcn_sched_barrier(0);
#pragma unroll
                for (int ks = 0; ks < KS; ++ks) {
                    if (ks + 1 < KS) {
#pragma unroll
                        for (int k4 = 0; k4 < 4; ++k4) kfr[(ks + 1) & 1][k4] = *(const LAS bf16x8*)(Kt + (16 * k4 + l15) * KP + 32 * (ks + 1) + 8 * quad);
                    }
#pragma unroll
                    for (int k4 = 0; k4 < 4; ++k4) {
                        St[k4][0] = __builtin_amdgcn_mfma_f32_16x16x32_bf16(kfr[ks & 1][k4], Qf[0][ks], St[k4][0], 0, 0, 0);
                        St[k4][1] = __builtin_amdgcn_mfma_f32_16x16x32_bf16(kfr[ks & 1][k4], Qf[1][ks], St[k4][1], 0, 0, 0);
                    }
                    __builtin_amdgcn_sched_barrier(0);
                }
                bf16x8 vfr[2][2][2];
                if constexpr (DK == 128) {
#pragma unroll
                    for (int d2 = 0; d2 < 2; ++d2)
#pragma unroll
                        for (int k2 = 0; k2 < 2; ++k2) vfr[0][d2][k2] = ld2x4_lds(Vl + (16 * d2 + l15) * 72 + 32 * k2 + 4 * quad);
                }
                bf16x8 Pb[2][2];
#pragma unroll
                for (int qt = 0; qt < 2; ++qt) {
                    const int tq = q0 + 16 * qt + l15;
                    if constexpr (!STICK) {
                        float mx = -1e30f;
#pragma unroll
                        for (int k4 = 0; k4 < 4; ++k4)
#pragma unroll
                            for (int r = 0; r < 4; ++r) { const int key = key0 + 16 * k4 + 4 * quad + r; const float z = (key <= tq) ? St[k4][qt][r] : -1e30f; St[k4][qt][r] = z; mx = fmaxf(mx, z); }
                        mx = fmaxf(mx, __shfl_xor(mx, 16)); mx = fmaxf(mx, __shfl_xor(mx, 32));
                        const float mnew = fmaxf(mrow[qt], mx);
                        const float alpha = fexp(mrow[qt] - mnew);
                        float ps = 0.f;
#pragma unroll
                        for (int k4 = 0; k4 < 4; ++k4)
#pragma unroll
                            for (int r = 0; r < 4; ++r) { const float p = (St[k4][qt][r] > -1e29f) ? fexp(St[k4][qt][r] - mnew) : 0.f; St[k4][qt][r] = p; ps += p; }
                        ps += __shfl_xor(ps, 16); ps += __shfl_xor(ps, 32);
                        lrow[qt] = lrow[qt] * alpha + ps; mrow[qt] = mnew;
#pragma unroll
                        for (int dt = 0; dt < 8; ++dt) Oa[dt][qt] = Oa[dt][qt] * alpha;
                    } else {
                        float G[4], ls[4][4];
#pragma unroll
                        for (int k4 = 0; k4 < 4; ++k4) {
                            G[k4] = 0.f;
#pragma unroll
                            for (int r = 0; r < 4; ++r) { const int key = key0 + 16 * k4 + 4 * quad + r; const float z = St[k4][qt][r];
                                const float sp = softplus_f(z); const bool valid = key < tq; ls[k4][r] = valid ? -sp : 0.f; G[k4] += ls[k4][r];
                                St[k4][qt][r] = valid ? (z - sp) : -1e30f; }
                        }
                        float run = Rrow[qt];
#pragma unroll
                        for (int k4 = 3; k4 >= 0; --k4) {
                            const float g = G[k4];
                            const float gb = __shfl_xor(g, 16), gc2 = __shfl_xor(g, 32), gd = __shfl_xor(gb, 32);
                            const float hi = (((quad ^ 1) > quad) ? gb : 0.f) + (((quad ^ 2) > quad) ? gc2 : 0.f) + (((quad ^ 3) > quad) ? gd : 0.f);
                            float aft = run + hi;
#pragma unroll
                            for (int r = 3; r >= 0; --r) { const float lz = St[k4][qt][r]; St[k4][qt][r] = (lz > -1e29f) ? fexp(lz + aft) : 0.f; aft += ls[k4][r]; }
                            run += (g + gb) + (gc2 + gd);
                        }
                        Rrow[qt] = run;
                    }
                    Pb[qt][0] = pack8(St[0][qt], St[1][qt]); Pb[qt][1] = pack8(St[2][qt], St[3][qt]);
                }
                if constexpr (DK != 128) {
#pragma unroll
                    for (int d2 = 0; d2 < 2; ++d2)
#pragma unroll
                        for (int k2 = 0; k2 < 2; ++k2) vfr[0][d2][k2] = ld2x4_lds(Vl + (16 * d2 + l15) * 72 + 32 * k2 + 4 * quad);
                }
                __builtin_amdgcn_sched_barrier(0);
#pragma unroll
                for (int gv = 0; gv < 4; ++gv) {
                    if (gv + 1 < 4) {
#pragma unroll
                        for (int d2 = 0; d2 < 2; ++d2)
#pragma unroll
                            for (int k2 = 0; k2 < 2; ++k2) vfr[(gv + 1) & 1][d2][k2] = ld2x4_lds(Vl + (16 * (2 * (gv + 1) + d2) + l15) * 72 + 32 * k2 + 4 * quad);
                    }
#pragma unroll
                    for (int d2 = 0; d2 < 2; ++d2)
#pragma unroll
                        for (int k2 = 0; k2 < 2; ++k2) {
                            Oa[2 * gv + d2][0] = __builtin_amdgcn_mfma_f32_16x16x32_bf16(vfr[gv & 1][d2][k2], Pb[0][k2], Oa[2 * gv + d2][0], 0, 0, 0);
                            Oa[2 * gv + d2][1] = __builtin_amdgcn_mfma_f32_16x16x32_bf16(vfr[gv & 1][d2][k2], Pb[1][k2], Oa[2 * gv + d2][1], 0, 0, 0);
                        }
                    __builtin_amdgcn_sched_barrier(0);
                }
                if (STICK) wdone = __all((Rrow[0] < -110.f) && (Rrow[1] < -110.f));
            }
#pragma unroll
            for (int qt = 0; qt < 2; ++qt) {
                const float inv = STICK ? 1.f : 1.f / lrow[qt];
                bf16_t* op = O + (size_t)(b * SEQ + q0 + 16 * qt + l15) * opitch + h * 128 + 4 * quad;
#pragma unroll
                for (int dt = 0; dt < 8; ++dt) { u32x2 w; w.x = pk2(Oa[dt][qt][0] * inv, Oa[dt][qt][1] * inv); w.y = pk2(Oa[dt][qt][2] * inv, Oa[dt][qt][3] * inv); *(u32x2*)(op + 16 * dt) = w; }
            }
        }
    }
}

constexpr int NPHASE = 30;
__device__ __forceinline__ int lane_id() { int l; asm volatile("v_mbcnt_lo_u32_b32 %0, -1, 0\n\tv_mbcnt_hi_u32_b32 %0, -1, %0" : "=v"(l)); return l; }
__device__ __forceinline__ Ctx mkctx(LAS unsigned char* lds, unsigned char* ws_, int wave_s) {
    int ln = lane_id(); asm volatile("" : "+v"(ln));
    int wv = wave_s; asm volatile("" : "+s"(wv));
    asm volatile("" : "+s"(ws_));
    Ctx c; c.lds = lds; c.ws = ws_; c.lane = ln; c.wave = wv; c.tid = wv * 64 + ln;
    c.gw = blockIdx.x * NWAVES + c.wave; c.ngw = gridDim.x * NWAVES; return c;
}
#define PH_BEGIN Ctx c = mkctx(ldsp, args.ws, wave_s); const Args& A = args; unsigned char* ws = c.ws; \
    bf16_t* XB = (bf16_t*)(ws + WS_R1); float* SS = (float*)(ws + WS_SS); bf16_t* R2 = (bf16_t*)(ws + WS_R2); bf16_t* R3 = (bf16_t*)(ws + WS_R3); \
    bf16_t* R4 = (bf16_t*)(ws + WS_R4); bf16_t* R5 = (bf16_t*)(ws + WS_R5); bf16_t* WMIX = (bf16_t*)(ws + WS_WMIX); bf16_t* WOUT = (bf16_t*)(ws + WS_WMIX_OUT + (size_t)(Lcur & 1) * 2 * MiB); \
    (void)XB; (void)SS; (void)R2; (void)R3; (void)R4; (void)R5; (void)WMIX; (void)WOUT; (void)c;

__global__ void __launch_bounds__(NTHR, 2) trunk_fwd(Args args) {
    extern __shared__ __attribute__((aligned(16))) unsigned char lds_raw[];
    LAS unsigned char* ldsp = (LAS unsigned char*)lds_raw;
    const int wave_s = __builtin_amdgcn_readfirstlane((int)(threadIdx.x >> 6));
    const int lo = args.ph_lo, hi = args.ph_hi;
    const int G = gridDim.x, bid = blockIdx.x;
#if !MK_PER_PHASE
    cg::grid_group grid = cg::this_grid();
#if MK_XCD_BAR
    volatile LAS unsigned* misc = (volatile LAS unsigned*)(ldsp + LDS_MISC);
    if (threadIdx.x < 16) misc[threadIdx.x] = 0u;
    __syncthreads();
    XcdBarrier xbar = xcd_barrier_post((unsigned*)(args.ws + WS_BAR), misc + 8, (int)threadIdx.x);
    int nsync = 0;
#define SEAM() do { if (nsync == 0) grid.sync(); else xcd_barrier(xbar, wave_s * 64 + lane_id()); ++nsync; } while (0)
#else
#define SEAM() grid.sync()
#endif
#else
#define SEAM() do {} while (0)
#endif
#define IN(k) (lo <= (k) && (k) < hi)
#ifndef PROBE_MASK
#define PROBE_MASK 0ull
#endif
    unsigned long long tacc = 0ull, tph = (PROBE_MASK != 0ull) ? __builtin_amdgcn_s_memrealtime() : 0ull;
#define ENDPH(k) do { if (IN((k) + 1)) SEAM(); if (PROBE_MASK != 0ull) { const unsigned long long tn = __builtin_amdgcn_s_memrealtime(); if ((PROBE_MASK >> (k)) & 1ull) tacc += tn - tph; tph = tn; } } while (0)

    float* out = args.out;
    int ph = 0;
    int Lcur = 0;

    if (IN(ph) && EN(0)) { PH_BEGIN; convert_mixer(A, c, 0, c.gw, c.ngw); prologue_rows(A, c); }
    ENDPH(ph); ++ph;

#pragma unroll 1
    for (int L = 0; L < 4; ++L) {
        Lcur = L;
        const float* resid_in = (L == 0) ? args.in[0] : out;
        if (L == 0 || L == 3) {
            const int ib = (L == 0) ? 1 : 33;
            if (IN(ph)) {
                PH_BEGIN;
                __syncthreads();
                pg8::Gemm g{XB, WMIX, M, 4352, D, D}; pg8::StaticOrder S; S.init(M, 4352, G, bid);
                pg8::EpiDN E{R2, R3, (float*)(ws + WS_AB), (bf16_t*)(ws + WS_HALO), SS};
                if (EN(1)) pg8::gemm_phase<pg8::EpiDN>(c.lds, g, S, E, c.tid);
            }
            ENDPH(ph); ++ph;
            if (IN(ph) && EN(2)) { PH_BEGIN; dn_conv(A, c, A.in[ib + 2]); }
            ENDPH(ph); ++ph;
            if (IN(ph) && EN(3)) { PH_BEGIN; dn_chunk(A, c, A.in[ib + 3], A.in[ib + 4]); }
            ENDPH(ph); ++ph;
            if (IN(ph) && EN(4)) { PH_BEGIN; dn_scan(A, c);
                if ((int)blockIdx.x >= 64 && (int)gridDim.x > 64) { const int gw2 = ((int)blockIdx.x - 64) * NWAVES + c.wave, ngw2 = ((int)gridDim.x - 64) * NWAVES;
                    convert_ffn(A, c, L, gw2, ngw2); if (L == 0) convert_mixer(A, c, 1, gw2, ngw2); }
                else if ((int)gridDim.x <= 64) { convert_ffn(A, c, L, c.gw, c.ngw); if (L == 0) convert_mixer(A, c, 1, c.gw, c.ngw); } }
            ENDPH(ph); ++ph;
            if (IN(ph) && EN(5)) { PH_BEGIN; dn_post(A, c, A.in[ib + 5]); }
            ENDPH(ph); ++ph;
            if (IN(ph)) {
                PH_BEGIN;
                pg8::Gemm g{R4, WOUT, M, D, D, D}; pg8::StaticOrder S; S.init(M, D, G, bid);
                pg8::EpiResidual E{resid_in, out, XB, SS};
                if (EN(10)) pg8::gemm_phase<pg8::EpiResidual>(c.lds, g, S, E, c.tid);
            }
            ENDPH(ph); ++ph;
        } else if (L == 1) {
            if (IN(ph)) {
                PH_BEGIN;
                if (EN(0)) convert_ffn(A, c, L, c.gw, c.ngw);
                __syncthreads();
                pg8::Gemm g{XB, WMIX, M, 3072, D, D}; pg8::StaticOrder S; S.init(M, 3072, G, bid);
                pg8::EpiStore E{R2, 3072, SS, 0, 16, 1.0f / D};
                if (EN(11)) pg8::gemm_phase<pg8::EpiStore>(c.lds, g, S, E, c.tid);
            }
            ENDPH(ph); ++ph;
            if (IN(ph) && EN(6)) { PH_BEGIN; sb_prep_rows(A, c, A.in[13], A.in[14]); v_transpose(c, R2, 3072, 128, 2048, (bf16_t*)(ws + WS_R1)); }
            ENDPH(ph); ++ph;
            if (IN(ph) && EN(7)) { PH_BEGIN; attn_phase<128, true>(c, R2, 3072, R2 + 1024, 3072, (const bf16_t*)(ws + WS_R1), R3, 1024); }
            ENDPH(ph); ++ph;
            if (IN(ph)) {
                PH_BEGIN;
                pg8::Gemm g{R3, WOUT, M, D, D, D}; pg8::StaticOrder S; S.init(M, D, G, bid);
                pg8::EpiResidual E{resid_in, out, XB, SS};
                if (EN(10)) pg8::gemm_phase<pg8::EpiResidual>(c.lds, g, S, E, c.tid);
            }
            ENDPH(ph); ++ph;
        } else {
            if (IN(ph)) {
                PH_BEGIN;
                if (EN(0)) convert_ffn(A, c, L, c.gw, c.ngw);
                __syncthreads();
                pg8::Gemm g{XB, WMIX, M, 512, D, D}; pg8::StaticOrder S; S.init(M, 512, G, bid);
                pg8::EpiMlaDown E{R5, (float*)(ws + WS_SS2), SS};
                if (EN(12)) pg8::gemm_phase<pg8::EpiMlaDown>(c.lds, g, S, E, c.tid);
            }
            ENDPH(ph); ++ph;
            if (IN(ph)) {
                PH_BEGIN;
                { pg8::Gemm g{R5, (bf16_t*)(ws + WS_WMIX + 1 * MiB), M, 1536, 256, 512}; pg8::StaticOrder S; S.init(M, 1536, G, bid);
                  pg8::EpiStore E{R2, 1536, (const float*)(ws + WS_SS2), 0, 8, 1.0f / 256.0f};
                  if (EN(11)) pg8::gemm_phase<pg8::EpiStore>(c.lds, g, S, E, c.tid); }
                { pg8::Gemm g{R5 + 256, (bf16_t*)(ws + WS_WMIX + 2 * MiB), M, 2048, 128, 512}; pg8::StaticOrder S; S.init(M, 2048, G, bid);
                  pg8::EpiStore E{R3, 2048, (const float*)(ws + WS_SS2), 8, 4, 1.0f / 128.0f};
                  if (EN(11)) pg8::gemm_phase<pg8::EpiStore>(c.lds, g, S, E, c.tid); }
            }
            ENDPH(ph); ++ph;
            if (IN(ph) && EN(8)) { PH_BEGIN; mla_prep_rows(A, c); v_transpose(c, R3, 2048, 256, 128, (bf16_t*)(ws + WS_R1)); }
            ENDPH(ph); ++ph;
            if (IN(ph) && EN(9)) { PH_BEGIN; attn_phase<192, false>(c, R2, 1536, (const bf16_t*)(ws + WS_R2 + 48 * MiB), 1536, (const bf16_t*)(ws + WS_R1), R3, 1024); }
            ENDPH(ph); ++ph;
            if (IN(ph)) {
                PH_BEGIN;
                pg8::Gemm g{R3, WOUT, M, D, D, D}; pg8::StaticOrder S; S.init(M, D, G, bid);
                pg8::EpiResidual E{resid_in, out, XB, SS};
                if (EN(10)) pg8::gemm_phase<pg8::EpiResidual>(c.lds, g, S, E, c.tid);
            }
            ENDPH(ph); ++ph;
        }
        if (IN(ph)) {
            PH_BEGIN;
            if (L >= 1 && L < 3 && EN(0)) convert_mixer(A, c, L + 1, c.gw, c.ngw);
            __syncthreads();
            pg8::Gemm g{XB, (bf16_t*)(ws + WS_WFFN), M, 2 * FH, D, D}; pg8::StaticOrder S; S.init(M, 2 * FH, G, bid);
            pg8::EpiSwiglu E{R2, SS};
            if (EN(13)) pg8::gemm_phase<pg8::EpiSwiglu>(c.lds, g, S, E, c.tid);
        }
        ENDPH(ph); ++ph;
        if (IN(ph)) {
            PH_BEGIN;
            pg8::Gemm g{R2, (bf16_t*)(ws + WS_WFFN_DN), M, D, FH, FH}; pg8::StaticOrder S; S.init(M, D, G, bid);
            pg8::EpiResidual E{out, out, XB, SS};
            if (EN(10)) pg8::gemm_phase<pg8::EpiResidual>(c.lds, g, S, E, c.tid);
        }
        ENDPH(ph); ++ph;
    }
    if (PROBE_MASK != 0ull) { const unsigned long long te = __builtin_amdgcn_s_memrealtime(); while (__builtin_amdgcn_s_memrealtime() - te < tacc) __builtin_amdgcn_s_sleep(8); }
}

extern "C" void kernel_launch(void* const* d_in, const int* in_sizes, int n_in, void* d_out, int out_size, void* d_ws, size_t ws_size, hipStream_t stream) {
    static int grid = 0;
    if (grid == 0) {
        if (n_in != 43 || out_size != M * D || ws_size < WS_END) { fprintf(stderr, "kernel_launch: unexpected shapes (n_in %d out %d ws %zu)\n", n_in, out_size, ws_size); grid = -1; return; }
        int dev = 0, cus = 0, per_cu = 0;
        hipGetDevice(&dev); hipDeviceGetAttribute(&cus, hipDeviceAttributeMultiprocessorCount, dev);
        if (hipFuncSetAttribute((const void*)trunk_fwd, hipFuncAttributeMaxDynamicSharedMemorySize, LDS_BYTES) != hipSuccess) { fprintf(stderr, "kernel_launch: hipFuncSetAttribute failed\n"); grid = -1; return; }
        if (hipOccupancyMaxActiveBlocksPerMultiprocessor(&per_cu, (const void*)trunk_fwd, NTHR, LDS_BYTES) != hipSuccess || per_cu < 1) { fprintf(stderr, "kernel_launch: occupancy query says %d\n", per_cu); per_cu = 1; }
        (void)hipGetLastError();
        grid = cus * 1;
    }
    if (grid < 0) return;
    Args a{};
    for (int i = 0; i < 43; ++i) a.in[i] = (const float*)d_in[i];
    a.out = (float*)d_out; a.ws = (unsigned char*)d_ws;
#if MK_PER_PHASE
    for (int p = 0; p < NPHASE; ++p) {
        a.ph_lo = p; a.ph_hi = p + 1;
        hipLaunchKernelGGL(trunk_fwd, dim3(grid), dim3(NTHR), LDS_BYTES, stream, a);
    }
#else
    hipMemsetAsync((char*)d_ws + WS_BAR, 0, 65536, stream);
    a.ph_lo = 0; a.ph_hi = NPHASE;
    void* kargs[] = {&a};
    hipError_t e = hipLaunchCooperativeKernel((const void*)trunk_fwd, dim3(grid), dim3(NTHR), kargs, LDS_BYTES, stream);
    if (e != hipSuccess) fprintf(stderr, "cooperative launch failed: %s (grid %d)\n", hipGetErrorString(e), grid);
#endif
}
```
